# Optimizing an MI355X kernel written in HIP

```python
import jax, jax.numpy as jnp
from jax import lax
import numpy as np

D_MODEL = 1024
BATCH = 2
SEQ = 8192
DEPTH = 4

HEAD_DIM = 64
RET_HEADS = (3 * D_MODEL // 8) // HEAD_DIM
MOBA_HEADS = (3 * D_MODEL // 8) // HEAD_DIM
CONV_GROUPS = (D_MODEL // 4) // HEAD_DIM
RET_WIDTH = RET_HEADS * HEAD_DIM
MOBA_WIDTH = MOBA_HEADS * HEAD_DIM
CONV_WIDTH = CONV_GROUPS * HEAD_DIM
MIX_WIDTH = RET_WIDTH + MOBA_WIDTH + CONV_WIDTH
IN_WIDTH = 4 * RET_WIDTH + 3 * MOBA_WIDTH + 2 * CONV_WIDTH
D_FF = ((8 * D_MODEL // 3 + 255) // 256) * 256
RET_CHUNK = 256
RET_ROT_BASE = 10000.0
MOBA_BLOCK = 256
MOBA_TOPK = 3
MOBA_QBLOCK = 128
ROPE_THETA = 500000.0
ROPE_DIMS = HEAD_DIM // 4
CONV_KERNEL = 31
FFN_RES_WEIGHT = 0.5
EPS = 1e-6
PAD_MULT = 256

kernel_name = "hybrid_retention_moba_conformer_macaron"


def rms_norm(x, g):
    xf = x.astype(jnp.float32)
    y = xf * lax.rsqrt(jnp.mean(xf * xf, -1, keepdims=True) + EPS)
    return (y * g.astype(jnp.float32)).astype(x.dtype)


def swiglu(h, wg, wu, wd):
    return (jax.nn.silu(h @ wg) * (h @ wu)) @ wd


def to_heads(t, n_heads):
    b, s, _ = t.shape
    return t.reshape(b, s, n_heads, HEAD_DIM).transpose(0, 2, 1, 3)


def from_heads(t):
    b, h, s, d = t.shape
    return t.transpose(0, 2, 1, 3).reshape(b, s, h * d)


def rotary(x, pos, inv_freq):
    half = inv_freq.shape[0]
    n_rot = 2 * half
    ang = pos.astype(jnp.float32)[:, None, :, None] * inv_freq
    cos, sin = jnp.cos(ang), jnp.sin(ang)
    xr = x[..., :n_rot].astype(jnp.float32)
    x1, x2 = xr[..., :half], xr[..., half:]
    rot = jnp.concatenate([x1 * cos - x2 * sin, x2 * cos + x1 * sin], -1).astype(x.dtype)
    return jnp.concatenate([rot, x[..., n_rot:]], -1)


def retention(q, k, v):
    b, h, s, d = q.shape
    c = RET_CHUNK
    n = s // c
    log_gamma = jnp.log1p(-jnp.exp2(-5.0 - jnp.arange(h, dtype=jnp.float32)))
    lg = log_gamma[:, None]
    qc = q.reshape(b, h, n, c, d)
    kc = (k * (d ** -0.5)).reshape(b, h, n, c, d)
    vc = v.reshape(b, h, n, c, d)
    idx = jnp.arange(c, dtype=jnp.float32)
    rel = idx[:, None] - idx[None, :]
    decay_in = jnp.where(rel >= 0, jnp.exp(lg[:, :, None] * jnp.maximum(rel, 0.0)), 0.0)
    scores = jnp.einsum('bhncd,bhnmd->bhncm', qc, kc) * decay_in[None, :, None]
    inner = jnp.einsum('bhncm,bhnme->bhnce', scores, vc)
    w_state = jnp.exp(lg * (c - 1 - idx))
    kv = jnp.einsum('bhncd,hc,bhnce->bhnde', kc, w_state, vc)
    chunk_decay = jnp.exp(log_gamma * c).astype(kv.dtype)[None, :, None, None]

    def step(state, kv_i):
        return state * chunk_decay + kv_i, state

    _, prev = lax.scan(step, jnp.zeros((b, h, d, d), kv.dtype), jnp.moveaxis(kv, 2, 0))
    prev = jnp.moveaxis(prev, 0, 2)
    w_cross = jnp.exp(lg * (idx + 1.0))
    cross = jnp.einsum('bhncd,bhnde->bhnce', qc, prev) * w_cross[None, :, None, :, None]
    return (inner + cross).reshape(b, h, s, d)


def moba_attention(q, k, v):
    b, h, s, d = q.shape
    bs = MOBA_BLOCK
    nb = s // bs
    qb = MOBA_QBLOCK
    nq = s // qb
    topk = min(MOBA_TOPK, nb)
    scale = d ** -0.5
    kb = k.reshape(b, h, nb, bs, d)
    vb = v.reshape(b, h, nb, bs, d)
    kmean = jnp.mean(kb.astype(jnp.float32), axis=3)
    b_i = jnp.arange(b)[:, None, None]
    h_i = jnp.arange(h)[None, :, None]
    klocal = jnp.arange(bs)

    def one_qblock(args):
        qblk, qi = args
        qpos = qi * qb + jnp.arange(qb)
        own = (qi * qb) // bs
        gate = jnp.einsum('bhqd,bhnd->bhqn', qblk.astype(jnp.float32), kmean)
        gate = jnp.where(jnp.arange(nb) < own, gate, -jnp.inf)
        _, sel = lax.top_k(gate, topk)
        valid = sel < own
        k_own = lax.dynamic_index_in_dim(kb, own, axis=2, keepdims=False)
        v_own = lax.dynamic_index_in_dim(vb, own, axis=2, keepdims=False)
        s_own = jnp.einsum('bhqd,bhkd->bhqk', qblk, k_own).astype(jnp.float32) * scale
        causal = (own * bs + klocal)[None, :] <= qpos[:, None]
        s_list = [jnp.where(causal, s_own, -jnp.inf)]
        for j in range(topk):
            k_j = kb[b_i, h_i, sel[..., j]]
            s_j = jnp.einsum('bhqd,bhqkd->bhqk', qblk, k_j).astype(jnp.float32) * scale
            s_list.append(jnp.where(valid[..., j, None], s_j, -jnp.inf))
        p = jax.nn.softmax(jnp.concatenate(s_list, -1), axis=-1).astype(v.dtype)
        out = jnp.einsum('bhqk,bhkd->bhqd', p[..., :bs], v_own)
        for j in range(topk):
            v_j = vb[b_i, h_i, sel[..., j]]
            out = out + jnp.einsum('bhqk,bhqkd->bhqd', p[..., (j + 1) * bs:(j + 2) * bs], v_j)
        return out

    qs = jnp.moveaxis(q.reshape(b, h, nq, qb, d), 2, 0)
    outs = lax.map(one_qblock, (qs, jnp.arange(nq)))
    return jnp.moveaxis(outs, 0, 2).reshape(b, h, s, d)


def conv_module(a, gate, w, bias, ln_g, ln_b):
    bsz, s, c = a.shape
    u = a * jax.nn.sigmoid(gate)
    y = lax.conv_general_dilated(u, w[:, None, :], window_strides=(1,), padding=[(CONV_KERNEL - 1, 0)],
                                 dimension_numbers=('NWC', 'WIO', 'NWC'), feature_group_count=c) + bias
    yg = y.reshape(bsz, s, CONV_GROUPS, c // CONV_GROUPS).astype(jnp.float32)
    mu = jnp.mean(yg, -1, keepdims=True)
    var = jnp.mean(jnp.square(yg - mu), -1, keepdims=True)
    yn = ((yg - mu) * lax.rsqrt(var + EPS)).reshape(bsz, s, c) * ln_g.astype(jnp.float32) + ln_b.astype(jnp.float32)
    return jax.nn.silu(yn).astype(a.dtype)


def setup_inputs(seed: int = 0) -> dict:
    key = jax.random.key(seed)
    ks = jax.random.split(key, 20)
    f32 = jnp.float32

    def w(k, shape, fan_in):
        return jax.random.normal(k, shape, f32) * (fan_in ** -0.5)

    def gain(k, shape):
        return 1.0 + 0.02 * jax.random.normal(k, shape, f32)

    return {
        "x": jax.random.normal(ks[0], (BATCH, SEQ, D_MODEL), f32),
        "positions": jnp.broadcast_to(jnp.arange(SEQ, dtype=jnp.int32), (BATCH, SEQ)),
        "ffn1_norm": gain(ks[1], (DEPTH, D_MODEL)),
        "ffn1_wg": w(ks[2], (DEPTH, D_MODEL, D_FF), D_MODEL),
        "ffn1_wu": w(ks[3], (DEPTH, D_MODEL, D_FF), D_MODEL),
        "ffn1_wd": w(ks[4], (DEPTH, D_FF, D_MODEL), D_FF),
        "mix_norm": gain(ks[5], (DEPTH, D_MODEL)),
        "w_in": w(ks[6], (DEPTH, D_MODEL, IN_WIDTH), D_MODEL),
        "conv_w": w(ks[7], (DEPTH, CONV_KERNEL, CONV_WIDTH), CONV_KERNEL),
        "conv_b": 0.02 * jax.random.normal(ks[8], (DEPTH, CONV_WIDTH), f32),
        "conv_ln_g": gain(ks[9], (DEPTH, CONV_WIDTH)),
        "conv_ln_b": 0.02 * jax.random.normal(ks[10], (DEPTH, CONV_WIDTH), f32),
        "w_out": w(ks[11], (DEPTH, MIX_WIDTH, D_MODEL), MIX_WIDTH),
        "ffn2_norm": gain(ks[12], (DEPTH, D_MODEL)),
        "ffn2_wg": w(ks[13], (DEPTH, D_MODEL, D_FF), D_MODEL),
        "ffn2_wu": w(ks[14], (DEPTH, D_MODEL, D_FF), D_MODEL),
        "ffn2_wd": w(ks[15], (DEPTH, D_FF, D_MODEL), D_FF),
        "final_norm": gain(ks[16], (D_MODEL,)),
    }


def reference(x, positions, ffn1_norm, ffn1_wg, ffn1_wu, ffn1_wd, mix_norm, w_in, conv_w, conv_b,
              conv_ln_g, conv_ln_b, w_out, ffn2_norm, ffn2_wg, ffn2_wu, ffn2_wd, final_norm):
    s = x.shape[1]
    s_pad = ((s + PAD_MULT - 1) // PAD_MULT) * PAD_MULT
    pad = s_pad - s
    pos = jnp.pad(positions, ((0, 0), (0, pad)))
    half_ret = HEAD_DIM // 2
    ret_inv = RET_ROT_BASE ** (-jnp.linspace(0.0, 1.0, half_ret, dtype=jnp.float32))
    half_rope = ROPE_DIMS // 2
    rope_inv = ROPE_THETA ** (-jnp.arange(half_rope, dtype=jnp.float32) / half_rope)
    sizes = [RET_WIDTH] * 4 + [MOBA_WIDTH] * 3 + [CONV_WIDTH] * 2
    cuts = [int(c) for c in np.cumsum(sizes)[:-1]]

    for l in range(DEPTH):
        h = rms_norm(x, ffn1_norm[l])
        x = x + FFN_RES_WEIGHT * swiglu(h, ffn1_wg[l], ffn1_wu[l], ffn1_wd[l])

        h = rms_norm(x, mix_norm[l])
        z = jnp.pad(h @ w_in[l], ((0, 0), (0, pad), (0, 0)))
        rq, rk, rv, rg, mq, mk, mv, ca, cg = jnp.split(z, cuts, axis=-1)

        rq = rotary(to_heads(rq, RET_HEADS), pos, ret_inv)
        rk = rotary(to_heads(rk, RET_HEADS), pos, ret_inv)
        y_ret = retention(rq, rk, to_heads(rv, RET_HEADS)).astype(jnp.float32)
        y_ret = y_ret * lax.rsqrt(jnp.mean(y_ret * y_ret, -1, keepdims=True) + EPS)
        y_ret = jax.nn.silu(rg) * from_heads(y_ret).astype(rg.dtype)

        mq = rotary(to_heads(mq, MOBA_HEADS), pos, rope_inv)
        mk = rotary(to_heads(mk, MOBA_HEADS), pos, rope_inv)
        y_moba = from_heads(moba_attention(mq, mk, to_heads(mv, MOBA_HEADS)))

        y_conv = conv_module(ca, cg, conv_w[l], conv_b[l], conv_ln_g[l], conv_ln_b[l])

        mix = jnp.concatenate([y_ret, y_moba, y_conv], axis=-1)[:, :s]
        x = x + mix @ w_out[l]

        h = rms_norm(x, ffn2_norm[l])
        x = x + FFN_RES_WEIGHT * swiglu(h, ffn2_wg[l], ffn2_wu[l], ffn2_wd[l])

    return rms_norm(x, final_norm)
```

```cpp
#include <hip/hip_runtime.h>
#include <cstdio>
#include <cstdint>
#include <cmath>

constexpr int BATCH = 2, SEQ = 8192, DM = 1024, DEPTH = 4, HD = 64, NHM = 6;
constexpr int M = BATCH * SEQ, FF = 2816, NGU = 2 * FF, ZN = 3200, ZNP = 3328, ZP = ZNP, NCH = SEQ / 256, NBH = BATCH * NHM;
constexpr float RMS_EPS = 1e-6f;
constexpr float C2 = 0.125f * 1.4426950408889634f;
constexpr int Z_RQ = 0, Z_RK = 384, Z_MQ = 768, Z_MK = 1152, Z_RV = 1536, Z_MV = 1920, Z_CA = 2304, Z_CG = 2560, Z_RG = 2816;
constexpr int ZN1 = 3072;
constexpr int X_RET = 0, X_MOBA = 384, X_CONV = 768;

namespace pg8 {
#define PG8_LAS __attribute__((address_space(3)))
typedef unsigned short bf16_t;
typedef short bf16x8 __attribute__((ext_vector_type(8)));
typedef float f32x4 __attribute__((ext_vector_type(4)));
typedef unsigned u32x4 __attribute__((ext_vector_type(4)));
constexpr int BM = 256, BK = 64, HALF = 128, HTB = HALF * BK * 2  , STAGE_BYTES = 8 * HTB, NXCD = 8, WGM = 8;

__host__ __device__ __forceinline__ int lds_byte(int r, int c) { const int st = (r >> 4) * 2 + (c >> 5), rr = r & 15, cc = c & 31, ob = rr * 64 + cc * 2; return st * 1024 + (ob ^ (((ob >> 9) & 1) << 5)); }
__host__ __device__ __forceinline__ void stage_rc(int b, int& R, int& C) { const int st = b / 1024, sb = b % 1024, swz = sb ^ (((sb >> 9) & 1) << 5); R = (st >> 1) * 16 + swz / 64; C = (st & 1) * 32 + (swz % 64) / 2; }
__host__ __device__ __forceinline__ int perm32(int rho) { const int n = rho >> 4, i = rho & 15; return 8 * (i >> 2) + 4 * n + (i & 3); }

struct Unit { int pm, pn, ord; };
struct Gemm { const bf16_t* A; const bf16_t* Bt; int M, N, K; };

struct StaticOrder {
    int nM, nN, nwg, G, c;
    __host__ __device__ __forceinline__ void init(int M, int N, int G_, int c_) { nM = M / BM; nN = N / BM; nwg = nM * nN; G = G_; c = c_; }
    __host__ __device__ __forceinline__ bool next(int i, Unit& u) const {
        const long L = (long)i * G + c; if (L >= nwg) return false;
        int wgid = (int)L; { const int q = nwg / NXCD, r = nwg % NXCD, xcd = wgid % NXCD, off = wgid / NXCD; wgid = (xcd < r ? xcd * (q + 1) : r * (q + 1) + (xcd - r) * q) + off; }
        const int nig = WGM * nN, gid = wgid / nig, fm = gid * WGM, gsz = (nM - fm) < WGM ? (nM - fm) : WGM;
        u.pm = fm + ((wgid % nig) % gsz); u.pn = (wgid % nig) / gsz; u.ord = i; return true;
    }
    __device__ __forceinline__ void a_ready(const Unit&) const {}
    __device__ __forceinline__ void done(const Unit&) const {}
};

struct OneUnit { int pm, pn;
    __device__ __forceinline__ bool next(int i, Unit& u) const { if (i) return false; u.pm = pm; u.pn = pn; u.ord = 0; return true; }
    __device__ __forceinline__ void a_ready(const Unit&) const {}
    __device__ __forceinline__ void done(const Unit&) const {} };
__device__ __forceinline__ unsigned cvt_pk_bf16(float lo, float hi) { unsigned r; asm volatile("v_cvt_pk_bf16_f32 %0, %1, %2" : "=v"(r) : "v"(lo), "v"(hi)); return r; }
typedef float f32x2 __attribute__((ext_vector_type(2)));
typedef unsigned u32x2 __attribute__((ext_vector_type(2)));
typedef __bf16 bf16x2v __attribute__((ext_vector_type(2)));
__device__ __forceinline__ unsigned pkb(float lo, float hi) { const f32x2 v = {lo, hi}; const bf16x2v b = __builtin_convertvector(v, bf16x2v); return __builtin_bit_cast(unsigned, b); }
__device__ __forceinline__ float silu_f(float x) { return x * __builtin_amdgcn_rcpf(1.0f + __builtin_amdgcn_exp2f(-1.4426950408889634f * x)); }
__device__ __forceinline__ float row_rstd(const float* ssq, int row) { const f32x4 s = *(const f32x4*)(ssq + (size_t)row * 4); return __builtin_amdgcn_rsqf(((s[0] + s[1]) + (s[2] + s[3])) * (1.0f / 1024.0f) + RMS_EPS); }
struct EpiGU {
    static constexpr bool PERM = true, AFTER_DRAIN = false;
    bf16_t* act; const PG8_LAS float* rstab;
    __device__ __forceinline__ void operator()(const f32x4 (&acc)[2][2][4][2], const Unit& u, int wr, int wc, int fr, int fq) const {
        const int row0 = u.pm * BM + wr * 64 + fr, col0 = u.pn * HALF + wc * 32 + 8 * fq; const PG8_LAS float* T = rstab + u.ord * 256 + wr * 64 + fr;
#pragma unroll
        for (int ai = 0; ai < 2; ++ai)
#pragma unroll
            for (int m = 0; m < 4; ++m) { const int row = row0 + ai * HALF + m * 16; const float rs = T[ai * HALF + m * 16];
                const f32x4 g0 = acc[ai][0][m][0] * rs, g1 = acc[ai][0][m][1] * rs, u0 = acc[ai][1][m][0] * rs, u1 = acc[ai][1][m][1] * rs;
                u32x4 w; w.x = pkb(silu_f(g0[0]) * u0[0], silu_f(g0[1]) * u0[1]); w.y = pkb(silu_f(g0[2]) * u0[2], silu_f(g0[3]) * u0[3]);
                w.z = pkb(silu_f(g1[0]) * u1[0], silu_f(g1[1]) * u1[1]); w.w = pkb(silu_f(g1[2]) * u1[2], silu_f(g1[3]) * u1[3]);
                *(u32x4*)(act + (size_t)row * FF + col0) = w; }
    }
};
typedef int i32x4e __attribute__((ext_vector_type(4)));
__device__ __forceinline__ f32x4 cvt_i4(const f32x4 a) { const i32x4e v = __builtin_bit_cast(i32x4e, a); return __builtin_convertvector(v, f32x4); }
struct EpiGU8 {
    static constexpr bool PERM = true, AFTER_DRAIN = false;
    bf16_t* act; const PG8_LAS float* rstab; const PG8_LAS float* ctab;
    __device__ __forceinline__ void operator()(const f32x4 (&acc)[2][2][4][2], const Unit& u, int wr, int wc, int fr, int fq) const {
        const int row0 = u.pm * BM + wr * 64 + fr, col0 = u.pn * HALF + wc * 32 + 8 * fq; const PG8_LAS float* T = rstab + u.ord * 256 + wr * 64 + fr;
        const PG8_LAS float* C = ctab + u.ord * 256 + wc * 32 + 8 * fq;
        const f32x4 sg0 = *(const PG8_LAS f32x4*)C, sg1 = *(const PG8_LAS f32x4*)(C + 4), su0 = *(const PG8_LAS f32x4*)(C + HALF), su1 = *(const PG8_LAS f32x4*)(C + HALF + 4);
#pragma unroll
        for (int ai = 0; ai < 2; ++ai)
#pragma unroll
            for (int m = 0; m < 4; ++m) { const int row = row0 + ai * HALF + m * 16; const float rs = T[ai * HALF + m * 16];
                const f32x4 g0 = cvt_i4(acc[ai][0][m][0]) * (sg0 * rs), g1 = cvt_i4(acc[ai][0][m][1]) * (sg1 * rs), u0 = cvt_i4(acc[ai][1][m][0]) * (su0 * rs), u1 = cvt_i4(acc[ai][1][m][1]) * (su1 * rs);
                u32x4 w; w.x = pkb(silu_f(g0[0]) * u0[0], silu_f(g0[1]) * u0[1]); w.y = pkb(silu_f(g0[2]) * u0[2], silu_f(g0[3]) * u0[3]);
                w.z = pkb(silu_f(g1[0]) * u1[0], silu_f(g1[1]) * u1[1]); w.w = pkb(silu_f(g1[2]) * u1[2], silu_f(g1[3]) * u1[3]);
                *(u32x4*)(act + (size_t)row * FF + col0) = w; }
    }
};
struct EpiWin {
    static constexpr bool PERM = true, AFTER_DRAIN = false;
    bf16_t* z; const PG8_LAS float* rstab; const float* RT; const float* MT;
    __device__ __forceinline__ void operator()(const f32x4 (&acc)[2][2][4][2], const Unit& u, int wr, int wc, int fr, int fq) const {
        const int row0 = u.pm * BM + wr * 64 + fr; const PG8_LAS float* T = rstab + u.ord * 256 + wr * 64 + fr;
        const int hc = (wc * 32 + 8 * fq) & 63;
        const bool rot_tile = u.pn < 6, use = (u.pn < 3) || (hc < 16);
        const float* tbase = (u.pn < 3) ? RT + hc : MT + (hc & 8); const int tpitch = (u.pn < 3) ? 64 : 16;
#pragma unroll
        for (int ai = 0; ai < 2; ++ai) {
            f32x4 t0[4], t1[4];
#pragma unroll
            for (int m = 0; m < 4; ++m) { t0[m] = (f32x4){1.f, 0.f, 1.f, 0.f}; t1[m] = t0[m]; }
            if (rot_tile) {
#pragma unroll
                for (int m = 0; m < 4; ++m) { const float* tb = tbase + (size_t)(row0 + ai * HALF + m * 16) * tpitch; t0[m] = *(const f32x4*)tb; t1[m] = *(const f32x4*)(tb + 4); }
#pragma unroll
                for (int m = 0; m < 4; ++m) { asm volatile("" : "+v"(t0[m]), "+v"(t1[m]));
                    t0[m] = use ? t0[m] : (f32x4){1.f, 0.f, 1.f, 0.f}; t1[m] = use ? t1[m] : (f32x4){1.f, 0.f, 1.f, 0.f}; } }
#pragma unroll
            for (int m = 0; m < 4; ++m) { const int row = row0 + ai * HALF + m * 16; const float rs = T[ai * HALF + m * 16];
#pragma unroll
                for (int bj = 0; bj < 2; ++bj) { const int colb = (2 * u.pn + bj) * HALF + wc * 32 + 8 * fq;
                    const f32x4 a = acc[ai][bj][m][0] * rs, b = acc[ai][bj][m][1] * rs; const f32x4 c0 = t0[m], c1 = t1[m]; f32x4 v0, v1;
                    v0[0] = a[0] * c0[0] - a[1] * c0[1]; v0[1] = a[1] * c0[0] + a[0] * c0[1]; v0[2] = a[2] * c0[2] - a[3] * c0[3]; v0[3] = a[3] * c0[2] + a[2] * c0[3];
                    v1[0] = b[0] * c1[0] - b[1] * c1[1]; v1[1] = b[1] * c1[0] + b[0] * c1[1]; v1[2] = b[2] * c1[2] - b[3] * c1[3]; v1[3] = b[3] * c1[2] + b[2] * c1[3];
                    u32x4 w; w.x = pkb(v0[0], v0[1]); w.y = pkb(v0[2], v0[3]); w.z = pkb(v1[0], v1[1]); w.w = pkb(v1[2], v1[3]);
                    *(u32x4*)(z + (size_t)row * ZP + colb) = w; } } }
    }
};
struct EpiWin8 {
    static constexpr bool PERM = true, AFTER_DRAIN = false;
    bf16_t* z; const PG8_LAS float* rstab; const float* RT; const float* MT; const PG8_LAS float* ctab;
    __device__ __forceinline__ void operator()(const f32x4 (&acc)[2][2][4][2], const Unit& u, int wr, int wc, int fr, int fq) const {
        const int row0 = u.pm * BM + wr * 64 + fr; const PG8_LAS float* T = rstab + u.ord * 256 + wr * 64 + fr;
        const int hc = (wc * 32 + 8 * fq) & 63;
        const bool rot_tile = u.pn < 6, use = (u.pn < 3) || (hc < 16);
        const float* tbase = (u.pn < 3) ? RT + hc : MT + (hc & 8); const int tpitch = (u.pn < 3) ? 64 : 16;
#pragma unroll
        for (int ai = 0; ai < 2; ++ai) {
            f32x4 t0[4], t1[4];
#pragma unroll
            for (int m = 0; m < 4; ++m) { t0[m] = (f32x4){1.f, 0.f, 1.f, 0.f}; t1[m] = t0[m]; }
            if (rot_tile) {
#pragma unroll
                for (int m = 0; m < 4; ++m) { const float* tb = tbase + (size_t)(row0 + ai * HALF + m * 16) * tpitch; t0[m] = *(const f32x4*)tb; t1[m] = *(const f32x4*)(tb + 4); }
#pragma unroll
                for (int m = 0; m < 4; ++m) { asm volatile("" : "+v"(t0[m]), "+v"(t1[m]));
                    t0[m] = use ? t0[m] : (f32x4){1.f, 0.f, 1.f, 0.f}; t1[m] = use ? t1[m] : (f32x4){1.f, 0.f, 1.f, 0.f}; } }
#pragma unroll
            for (int m = 0; m < 4; ++m) { const int row = row0 + ai * HALF + m * 16; const float rs = T[ai * HALF + m * 16];
#pragma unroll
                for (int bj = 0; bj < 2; ++bj) { const int colb = (2 * u.pn + bj) * HALF + wc * 32 + 8 * fq; const PG8_LAS float* C = ctab + u.ord * 256 + bj * HALF + wc * 32 + 8 * fq;
                    const f32x4 a = cvt_i4(acc[ai][bj][m][0]) * (*(const PG8_LAS f32x4*)C * rs), b = cvt_i4(acc[ai][bj][m][1]) * (*(const PG8_LAS f32x4*)(C + 4) * rs); const f32x4 c0 = t0[m], c1 = t1[m]; f32x4 v0, v1;
                    v0[0] = a[0] * c0[0] - a[1] * c0[1]; v0[1] = a[1] * c0[0] + a[0] * c0[1]; v0[2] = a[2] * c0[2] - a[3] * c0[3]; v0[3] = a[3] * c0[2] + a[2] * c0[3];
                    v1[0] = b[0] * c1[0] - b[1] * c1[1]; v1[1] = b[1] * c1[0] + b[0] * c1[1]; v1[2] = b[2] * c1[2] - b[3] * c1[3]; v1[3] = b[3] * c1[2] + b[2] * c1[3];
                    u32x4 w; w.x = pkb(v0[0], v0[1]); w.y = pkb(v0[2], v0[3]); w.z = pkb(v1[0], v1[1]); w.w = pkb(v1[2], v1[3]);
                    *(u32x4*)(z + (size_t)row * ZP + colb) = w; } } }
    }
};
__device__ __forceinline__ unsigned q8x4(float a, float b, float c, float d, float inv) {
    const float M_ = 12582912.0f; const unsigned ya = __float_as_uint(__builtin_fmaf(a, inv, M_)), yb = __float_as_uint(__builtin_fmaf(b, inv, M_)), yc = __float_as_uint(__builtin_fmaf(c, inv, M_)), yd = __float_as_uint(__builtin_fmaf(d, inv, M_));
    return __builtin_amdgcn_perm(yb, ya, 0x0c0c0400u) | __builtin_amdgcn_perm(yd, yc, 0x04000c0cu);
}
struct EpiRes {
    static constexpr bool PERM = true, AFTER_DRAIN = true;
    bf16_t* xb; float* ssq; float alpha, ralpha;
    signed char* x8; float* rf; float* ex; unsigned* pctr; unsigned* tmo; float* fout; const float* fgain;
    __device__ __forceinline__ void init(f32x4 (&acc)[2][2][4][2], const Unit& u, int wr, int wc, int fr, int fq) const {
        const int col0 = u.pn * BM + wc * 32 + 8 * fq;
#pragma unroll
        for (int ai = 0; ai < 2; ++ai)
#pragma unroll
            for (int m = 0; m < 4; ++m)
#pragma unroll
                for (int bj = 0; bj < 2; ++bj) { const u32x4 x4 = *(const u32x4*)(xb + (size_t)(u.pm * BM + ai * HALF + wr * 64 + m * 16 + fr) * DM + col0 + bj * HALF);
                    acc[ai][bj][m][0] = (f32x4){__uint_as_float(x4.x << 16), __uint_as_float(x4.x & 0xffff0000u), __uint_as_float(x4.y << 16), __uint_as_float(x4.y & 0xffff0000u)} * ralpha;
                    acc[ai][bj][m][1] = (f32x4){__uint_as_float(x4.z << 16), __uint_as_float(x4.z & 0xffff0000u), __uint_as_float(x4.w << 16), __uint_as_float(x4.w & 0xffff0000u)} * ralpha; }
    }
    __device__ __forceinline__ void fused(f32x4 (&acc)[2][2][4][2], const Unit& u, int wr, int wc, int fr, int fq, PG8_LAS unsigned char* lds, int wid, int lane) const {
        PG8_LAS float* P = (PG8_LAS float*)lds;
        PG8_LAS float* Q = P + 1024; PG8_LAS float* IV = P + 2048;
        const bool fin = fout != nullptr, q8 = x8 != nullptr || fin; unsigned* const pc = pctr + 16 * u.pm;
        const int col0 = u.pn * BM + wc * 32 + 8 * fq;
#pragma unroll
        for (int ai = 0; ai < 2; ++ai)
#pragma unroll
            for (int m = 0; m < 4; ++m) { const int r = ai * HALF + wr * 64 + m * 16 + fr; bf16_t* xp = xb + (size_t)(u.pm * BM + r) * DM + col0; float ss = 0.f, am = 0.f;
#pragma unroll
                for (int bj = 0; bj < 2; ++bj) { const f32x4 a0 = acc[ai][bj][m][0] * alpha, a1 = acc[ai][bj][m][1] * alpha;
                    ss += ((a0[0] * a0[0] + a0[1] * a0[1]) + (a0[2] * a0[2] + a0[3] * a0[3])) + ((a1[0] * a1[0] + a1[1] * a1[1]) + (a1[2] * a1[2] + a1[3] * a1[3]));
                    am = fmaxf(am, fmaxf(fmaxf(fmaxf(fabsf(a0[0]), fabsf(a0[1])), fmaxf(fabsf(a0[2]), fabsf(a0[3]))), fmaxf(fmaxf(fabsf(a1[0]), fabsf(a1[1])), fmaxf(fabsf(a1[2]), fabsf(a1[3])))));
                    u32x4 w; w.x = pkb(a0[0], a0[1]); w.y = pkb(a0[2], a0[3]); w.z = pkb(a1[0], a1[1]); w.w = pkb(a1[2], a1[3]); if (!fin) *(u32x4*)(xp + bj * HALF) = w; }
                ss += __shfl_xor(ss, 16); ss += __shfl_xor(ss, 32); am = fmaxf(am, __shfl_xor(am, 16)); am = fmaxf(am, __shfl_xor(am, 32));
                if (fq == 0) { P[r * 4 + wc] = ss; Q[r * 4 + wc] = am; } }
        __syncthreads();
        const int tid = wid * 64 + lane;
        if (tid < 256) { const f32x4 p = *(const PG8_LAS f32x4*)(P + tid * 4); const float ts = (p[0] + p[1]) + (p[2] + p[3]); ssq[(size_t)(u.pm * BM + tid) * 4 + u.pn] = ts;
            if (q8) { const f32x4 q = *(const PG8_LAS f32x4*)(Q + tid * 4); float* e = ex + ((size_t)(u.pm * BM + tid) * 4 + u.pn) * 2;
                __hip_atomic_store(e, ts, __ATOMIC_RELAXED, __HIP_MEMORY_SCOPE_AGENT); __hip_atomic_store(e + 1, fmaxf(fmaxf(q[0], q[1]), fmaxf(q[2], q[3])), __ATOMIC_RELAXED, __HIP_MEMORY_SCOPE_AGENT); } }
        if (q8) {
            if (wid < 4) { asm volatile("s_waitcnt vmcnt(0)" ::: "memory"); if (lane == 0) __hip_atomic_fetch_add(pc, 1u, __ATOMIC_RELAXED, __HIP_MEMORY_SCOPE_AGENT); }
            if (tid == 0) { unsigned sp = 0u; while (__hip_atomic_load(pc, __ATOMIC_RELAXED, __HIP_MEMORY_SCOPE_AGENT) < 16u) { __builtin_amdgcn_s_sleep(1); if (++sp > (1u << 22)) { __hip_atomic_store(tmo, 1u, __ATOMIC_RELAXED, __HIP_MEMORY_SCOPE_AGENT); break; } } }
            __syncthreads();
            if (tid < 256) { const float* e = ex + (size_t)(u.pm * BM + tid) * 8; float s4 = 0.f, a4 = 0.f;
#pragma unroll
                for (int k = 0; k < 4; ++k) { s4 += __hip_atomic_load(e + 2 * k, __ATOMIC_RELAXED, __HIP_MEMORY_SCOPE_AGENT); a4 = fmaxf(a4, __hip_atomic_load(e + 2 * k + 1, __ATOMIC_RELAXED, __HIP_MEMORY_SCOPE_AGENT)); }
                IV[tid] = fin ? __builtin_amdgcn_rsqf(s4 * (1.0f / 1024.0f) + RMS_EPS) : (a4 > 0.f ? 127.0f / a4 : 0.f);
                if (u.pn == 0 && !fin) rf[u.pm * BM + tid] = __builtin_amdgcn_rsqf(s4 * (1.0f / 1024.0f) + RMS_EPS) * a4 * (1.0f / 127.0f); }
            __syncthreads();
            if (fin) {
                f32x4 gn[2][2];
#pragma unroll
                for (int bj = 0; bj < 2; ++bj) { gn[bj][0] = *(const f32x4*)(fgain + col0 + bj * HALF); gn[bj][1] = *(const f32x4*)(fgain + col0 + bj * HALF + 4); }
#pragma unroll
                for (int ai = 0; ai < 2; ++ai)
#pragma unroll
                    for (int m = 0; m < 4; ++m) { const int r = ai * HALF + wr * 64 + m * 16 + fr; const float rs = IV[r] * alpha; float* op = fout + (size_t)(u.pm * BM + r) * DM + col0;
#pragma unroll
                        for (int bj = 0; bj < 2; ++bj) { *(f32x4*)(op + bj * HALF) = acc[ai][bj][m][0] * rs * gn[bj][0]; *(f32x4*)(op + bj * HALF + 4) = acc[ai][bj][m][1] * rs * gn[bj][1]; } }
                return; }
#pragma unroll
            for (int ai = 0; ai < 2; ++ai)
#pragma unroll
                for (int m = 0; m < 4; ++m) { const int r = ai * HALF + wr * 64 + m * 16 + fr; const float inv = IV[r] * alpha; signed char* qp = x8 + (size_t)(u.pm * BM + r) * DM + col0;
#pragma unroll
                    for (int bj = 0; bj < 2; ++bj) { const f32x4 a0 = acc[ai][bj][m][0], a1 = acc[ai][bj][m][1]; u32x2 w; w.x = q8x4(a0[0], a0[1], a0[2], a0[3], inv); w.y = q8x4(a1[0], a1[1], a1[2], a1[3], inv); *(u32x2*)(qp + bj * HALF) = w; } }
        }
    }
};

typedef int i32x4 __attribute__((ext_vector_type(4)));
template <bool I8> __device__ __forceinline__ f32x4 mma16(const bf16x8 a, const bf16x8 b, const f32x4 c) {
    if constexpr (I8) return __builtin_bit_cast(f32x4, __builtin_amdgcn_mfma_i32_16x16x64_i8(__builtin_bit_cast(i32x4, a), __builtin_bit_cast(i32x4, b), __builtin_bit_cast(i32x4, c), 0, 0, 0));
    else return __builtin_amdgcn_mfma_f32_16x16x32_bf16(a, b, c, 0, 0, 0);
}
template <class Epi, class Sched, bool ALIGN_EPI = false, bool SP2 = false, bool I8 = false>
__device__ __forceinline__ void gemm_phase(PG8_LAS unsigned char* lds, const Gemm g, const Sched& S, const Epi& E, const int tid) {
    const int wid = __builtin_amdgcn_readfirstlane(tid >> 6), lane = tid & 63, wr = wid >> 2, wc = wid & 3, fr = lane & 15, fq = lane >> 4;
    const int K = g.K, nt = K / BK;
    unsigned voffA[2], voffB[2];
#pragma unroll
    for (int i = 0; i < 2; ++i) { int R, C; stage_rc(tid * 16 + i * 8192, R, C); const int Rb = Epi::PERM ? ((R & ~31) + perm32(R & 31)) : R;
        voffA[i] = (unsigned)(R * K + C) * 2u; voffB[i] = (unsigned)(Rb * K + C) * 2u; }
    const size_t kstep = (size_t)(BK * 2);
    const size_t hstep = (size_t)HALF * K * 2;
    const size_t tstep = 2 * hstep;
    const unsigned ldsw = (unsigned)wid * 1024u;
    const int aoff = lds_byte(wr * 64 + fr, fq * 8), boff = lds_byte(wc * 32 + fr, fq * 8);
#define PG8_SA(b, h) (((b) * 2 + (h)) * HTB)
#define PG8_SB(b, h) ((4 + (b) * 2 + (h)) * HTB)
#define PG8_STAGE(bufoff, gbase, voff) do { _Pragma("unroll") for (int _i = 0; _i < 2; ++_i) \
        __builtin_amdgcn_global_load_lds((const unsigned*)((const char*)(gbase) + (voff)[_i]), (PG8_LAS unsigned*)(lds + (bufoff) + ldsw + _i * 8192), 16, 0, 0); } while (0)
#define PG8_LDA(dst, b, h) do { _Pragma("unroll") for (int m = 0; m < 4; ++m) _Pragma("unroll") for (int k = 0; k < 2; ++k) dst[m][k] = *(const PG8_LAS bf16x8*)(lds + PG8_SA(b, h) + aoff + m * 2048 + k * 1024); } while (0)
#define PG8_LDB(dst, b, h) do { _Pragma("unroll") for (int n = 0; n < 2; ++n) _Pragma("unroll") for (int k = 0; k < 2; ++k) dst[n][k] = *(const PG8_LAS bf16x8*)(lds + PG8_SB(b, h) + boff + n * 2048 + k * 1024); } while (0)
#define PG8_MMA(ai, bj, At, Bt) do { __builtin_amdgcn_s_setprio(1); _Pragma("unroll") for (int m = 0; m < 4; ++m) _Pragma("unroll") for (int n = 0; n < 2; ++n) _Pragma("unroll") for (int k = 0; k < 2; ++k) \
        acc[ai][bj][m][n] = mma16<I8>(Bt[n][k], At[m][k], acc[ai][bj][m][n]); __builtin_amdgcn_s_setprio(0); } while (0)
#define PG8_WAIT_V(n) asm volatile("s_waitcnt vmcnt(" #n ")" ::: "memory")
#define PG8_WAIT_L(n) asm volatile("s_waitcnt lgkmcnt(" #n ")" ::: "memory")
#define PG8_BAR __builtin_amdgcn_s_barrier()
#define PG8_SCHED __builtin_amdgcn_sched_barrier(0)
    Unit cur, nxt; int ui = 0;
    if (!S.next(0, cur)) return;
    f32x4 acc[2][2][4][2];
    if constexpr (Epi::AFTER_DRAIN) E.init(acc, cur, wr, wc, fr, fq);
    else {
#pragma unroll
    for (int a = 0; a < 2; ++a)
#pragma unroll
        for (int b = 0; b < 2; ++b)
#pragma unroll
            for (int m = 0; m < 4; ++m)
#pragma unroll
                for (int n = 0; n < 2; ++n) acc[a][b][m][n] = (f32x4){0.f, 0.f, 0.f, 0.f};
    }
    bf16x8 At[4][2], B0[2][2], B1[2][2];
    const char* cA = (const char*)g.A + (size_t)cur.pm * tstep; const char* cB = (const char*)g.Bt + (size_t)cur.pn * tstep;
    S.a_ready(cur);
    if constexpr (SP2) {
        PG8_STAGE(PG8_SB(0, 0), cB, voffB); PG8_STAGE(PG8_SB(0, 1), cB + hstep, voffB); PG8_STAGE(PG8_SA(0, 0), cA, voffA); PG8_STAGE(PG8_SA(0, 1), cA + hstep, voffA);
        if (wr == 1) PG8_BAR;
        PG8_WAIT_V(2); PG8_BAR;
        PG8_STAGE(PG8_SB(1, 0), cB + kstep, voffB); PG8_STAGE(PG8_SA(1, 0), cA + kstep, voffA); PG8_STAGE(PG8_SB(1, 1), cB + hstep + kstep, voffB);
        PG8_WAIT_V(6); PG8_BAR;
    } else {
        PG8_STAGE(PG8_SB(0, 0), cB, voffB); PG8_STAGE(PG8_SA(0, 0), cA, voffA); PG8_STAGE(PG8_SB(0, 1), cB + hstep, voffB); PG8_STAGE(PG8_SA(0, 1), cA + hstep, voffA);
        if (wr == 1) PG8_BAR;
        PG8_WAIT_V(4); PG8_BAR;
        PG8_STAGE(PG8_SB(1, 0), cB + kstep, voffB); PG8_STAGE(PG8_SA(1, 0), cA + kstep, voffA); PG8_STAGE(PG8_SB(1, 1), cB + hstep + kstep, voffB);
        PG8_WAIT_V(6); PG8_BAR;
    }
    for (;;) {
        const bool has_next = S.next(ui + 1, nxt);
        const char* nA = has_next ? (const char*)g.A + (size_t)nxt.pm * tstep : cA; const char* nB = has_next ? (const char*)g.Bt + (size_t)nxt.pn * tstep : cB;
        for (int t = 0; t < nt; t += 2) {
            const bool last = (t == nt - 2);
            const char* a1 = cA + (size_t)(t + 1) * kstep;
            const char* a2 = last ? nA : cA + (size_t)(t + 2) * kstep; const char* b2 = last ? nB : cB + (size_t)(t + 2) * kstep;
            const char* a3 = a2 + kstep; const char* b3 = b2 + kstep;
            if (last && has_next) S.a_ready(nxt);
            if constexpr (SP2) {
            PG8_LDB(B0, 0, 0); PG8_LDB(B1, 0, 1); PG8_SCHED; PG8_LDA(At, 0, 0); PG8_STAGE(PG8_SA(1, 1), a1 + hstep, voffA);
            PG8_WAIT_V(8); PG8_WAIT_L(0); PG8_BAR; PG8_MMA(0, 0, At, B0); PG8_MMA(0, 1, At, B1); PG8_BAR; PG8_SCHED;
            PG8_LDA(At, 0, 1); PG8_STAGE(PG8_SB(0, 0), b2, voffB); PG8_STAGE(PG8_SB(0, 1), b2 + hstep, voffB); PG8_STAGE(PG8_SA(0, 0), a2, voffA);
            PG8_WAIT_V(8); PG8_WAIT_L(0); PG8_BAR; PG8_MMA(1, 0, At, B0); PG8_MMA(1, 1, At, B1); PG8_BAR; PG8_SCHED;
            PG8_LDB(B0, 1, 0); PG8_LDB(B1, 1, 1); PG8_SCHED; PG8_LDA(At, 1, 0); PG8_STAGE(PG8_SA(0, 1), a2 + hstep, voffA);
            PG8_WAIT_V(8); PG8_WAIT_L(0); PG8_BAR; PG8_MMA(0, 0, At, B0); PG8_MMA(0, 1, At, B1); PG8_BAR; PG8_SCHED;
            PG8_LDA(At, 1, 1); PG8_STAGE(PG8_SB(1, 0), b3, voffB); PG8_STAGE(PG8_SB(1, 1), b3 + hstep, voffB); PG8_STAGE(PG8_SA(1, 0), a3, voffA);
            PG8_WAIT_V(8); PG8_WAIT_L(0); PG8_BAR; PG8_MMA(1, 0, At, B0); PG8_MMA(1, 1, At, B1); PG8_BAR; PG8_SCHED;
            } else {
            PG8_LDB(B0, 0, 0); PG8_SCHED; PG8_LDA(At, 0, 0); PG8_STAGE(PG8_SA(1, 1), a1 + hstep, voffA);
            PG8_WAIT_L(8); PG8_BAR; PG8_WAIT_L(0); PG8_MMA(0, 0, At, B0); PG8_BAR; PG8_SCHED;
            PG8_LDB(B1, 0, 1); PG8_STAGE(PG8_SB(0, 0), b2, voffB);
            PG8_BAR; PG8_WAIT_L(0); PG8_MMA(0, 1, At, B1); PG8_BAR;
            PG8_LDA(At, 0, 1); PG8_STAGE(PG8_SA(0, 0), a2, voffA);
            PG8_BAR; PG8_WAIT_L(0); PG8_MMA(1, 0, At, B0); PG8_BAR; PG8_SCHED;
            PG8_STAGE(PG8_SB(0, 1), b2 + hstep, voffB);
            PG8_WAIT_V(6); PG8_BAR; PG8_MMA(1, 1, At, B1); PG8_BAR;
            PG8_LDB(B0, 1, 0); PG8_SCHED; PG8_LDA(At, 1, 0); PG8_STAGE(PG8_SA(0, 1), a2 + hstep, voffA);
            PG8_WAIT_L(8); PG8_BAR; PG8_WAIT_L(0); PG8_MMA(0, 0, At, B0); PG8_BAR; PG8_SCHED;
            PG8_LDB(B1, 1, 1); PG8_STAGE(PG8_SB(1, 0), b3, voffB);
            PG8_BAR; PG8_WAIT_L(0); PG8_MMA(0, 1, At, B1); PG8_BAR;
            PG8_LDA(At, 1, 1); PG8_STAGE(PG8_SA(1, 0), a3, voffA);
            PG8_BAR; PG8_WAIT_L(0); PG8_MMA(1, 0, At, B0); PG8_BAR; PG8_SCHED;
            PG8_STAGE(PG8_SB(1, 1), b3 + hstep, voffB);
            PG8_WAIT_V(6); PG8_BAR; PG8_MMA(1, 1, At, B1); PG8_BAR;
            }
        }
        if constexpr (ALIGN_EPI) { if (wr == 0) PG8_BAR; }
        if constexpr (!Epi::AFTER_DRAIN) { E(acc, cur, wr, wc, fr, fq); S.done(cur); }
        if (!has_next) break;
#pragma unroll
        for (int a = 0; a < 2; ++a)
#pragma unroll
            for (int b = 0; b < 2; ++b)
#pragma unroll
                for (int m = 0; m < 4; ++m)
#pragma unroll
                    for (int n = 0; n < 2; ++n) acc[a][b][m][n] = (f32x4){0.f, 0.f, 0.f, 0.f};
        cur = nxt; cA = nA; cB = nB; ++ui;
        if constexpr (ALIGN_EPI) { if (wr == 1) PG8_BAR; }
    }
    PG8_WAIT_V(0);
    if constexpr (!ALIGN_EPI) { if (wr == 0) PG8_BAR; }
    PG8_BAR;
    if constexpr (Epi::AFTER_DRAIN) { E.fused(acc, cur, wr, wc, fr, fq, lds, wid, lane); S.done(cur); }
#undef PG8_SA
#undef PG8_SB
#undef PG8_STAGE
#undef PG8_LDA
#undef PG8_LDB
#undef PG8_MMA
#undef PG8_WAIT_V
#undef PG8_WAIT_L
#undef PG8_BAR
#undef PG8_SCHED
}
}
constexpr size_t KiB = 1024, MiB = 1u << 20;
constexpr size_t WS_CTL = 0, CTL_BYTES = 1 * MiB;
constexpr size_t WS_W = 1 * MiB, WBUF_BYTES = 42 * MiB;
constexpr size_t WO_GU1 = 0, WO_D1 = 11 * MiB, WO_IN = 16896 * KiB, WO_OUT = 23 * MiB, WO_GU2 = 25 * MiB, WO_D2 = 36 * MiB;
constexpr size_t WS_XB = 85 * MiB;
constexpr size_t WS_Z = 117 * MiB;
constexpr size_t WS_MIX = 221 * MiB;
constexpr size_t WS_ACT = 253 * MiB;
constexpr size_t WS_OP = 253 * MiB;
constexpr size_t WS_LSE = 301 * MiB;
constexpr size_t WS_SEL = 303 * MiB;
constexpr size_t WS_KV = 304 * MiB;
constexpr size_t WS_PREV = 310 * MiB;
constexpr size_t WS_KM = 313 * MiB;
constexpr size_t WS_RT = 341 * MiB, WS_MT = 345 * MiB;
constexpr size_t WS_SSQ = 346 * MiB;
constexpr size_t WS_X8 = 347 * MiB;
constexpr size_t WS_RF = 363 * MiB;
constexpr size_t WS_EX = WS_RF + 512 * KiB;
constexpr size_t WS_END = 364 * MiB;
constexpr size_t WO_IN8 = 7 * MiB, WO_SWIN = 10752 * KiB;
constexpr size_t WO_SW = 6 * MiB;
static_assert(WS_KM + 1 * MiB <= WS_ACT + 88 * MiB && WS_ACT + 88 * MiB <= WS_RT, "d_ws map");
constexpr int CW_TMO = 8, CW_XT = 1024  , CW_LB = 2048  , CW_BAR = 4096, CW_Q = 16384, CW_HC = 32768, CW_PC = 65536  ;

constexpr int RING_BYTES = 131072, LDSCTL_OFF = RING_BYTES, MISC_OFF = LDSCTL_OFF + 320, LDS_BYTES = 147456;

#define LAS __attribute__((address_space(3)))
#define GAS __attribute__((address_space(1)))
typedef unsigned short bf16;
typedef unsigned u32x4 __attribute__((ext_vector_type(4)));
typedef unsigned u32x2 __attribute__((ext_vector_type(2)));
typedef float f32x4 __attribute__((ext_vector_type(4)));
typedef float f32x2 __attribute__((ext_vector_type(2)));
typedef float f32x16 __attribute__((ext_vector_type(16)));
typedef short bf16x8 __attribute__((ext_vector_type(8)));
typedef short s16x4 __attribute__((ext_vector_type(4)));
typedef short v4i16_t __attribute__((ext_vector_type(4)));
typedef __bf16 bf16x2_t __attribute__((ext_vector_type(2)));
#define LDS_WAIT() asm volatile("s_waitcnt lgkmcnt(0)" ::: "memory")
__device__ __forceinline__ unsigned pk2(float lo, float hi) { const f32x2 v = {lo, hi}; const bf16x2_t b = __builtin_convertvector(v, bf16x2_t); return __builtin_bit_cast(unsigned, b); }
__device__ __forceinline__ float bflo(unsigned w) { return __uint_as_float(w << 16); }
__device__ __forceinline__ float bfhi(unsigned w) { return __uint_as_float(w & 0xffff0000u); }
__device__ __forceinline__ float ex2(float x) { return __builtin_amdgcn_exp2f(x); }
__device__ __forceinline__ float silu1(float x) { return x * __builtin_amdgcn_rcpf(1.0f + ex2(-1.4426950408889634f * x)); }
__device__ __forceinline__ float sigm1(float x) { return __builtin_amdgcn_rcpf(1.0f + ex2(-1.4426950408889634f * x)); }
__device__ __forceinline__ float wave_sum(float v) {
#pragma unroll
    for (int o = 1; o < 64; o <<= 1) v += __shfl_xor(v, o);
    return v;
}
__device__ __forceinline__ f32x16 mfma32(bf16x8 a, bf16x8 b, f32x16 c) { return __builtin_amdgcn_mfma_f32_32x32x16_bf16(a, b, c, 0, 0, 0); }
__device__ __forceinline__ int crow(int i, int h) { return (i & 3) + 8 * (i >> 2) + 4 * h; }
__device__ __forceinline__ s16x4 vtr(LAS const unsigned char* p) { return __builtin_bit_cast(s16x4, __builtin_amdgcn_ds_read_tr16_b64_v4i16((LAS v4i16_t*)p)); }
__device__ __forceinline__ bf16x8 cat8(s16x4 lo, s16x4 hi) { return __builtin_shufflevector(lo, hi, 0, 1, 2, 3, 4, 5, 6, 7); }
__device__ __forceinline__ bf16x8 ldsrow(LAS const unsigned char* p) { return *(const LAS bf16x8*)p; }
__device__ __forceinline__ f32x16 zero16() { f32x16 z;
#pragma unroll
    for (int i = 0; i < 16; ++i) z[i] = 0.f;
    return z; }
__device__ __forceinline__ bf16x8 pack8(const f32x16& x, int s) {
    u32x4 p; p.x = pk2(x[8 * s], x[8 * s + 1]); p.y = pk2(x[8 * s + 2], x[8 * s + 3]); p.z = pk2(x[8 * s + 4], x[8 * s + 5]); p.w = pk2(x[8 * s + 6], x[8 * s + 7]);
    return __builtin_bit_cast(bf16x8, p);
}
constexpr int PIT = 144;
constexpr int IMG = 256 * PIT;
template <int NR> __device__ __forceinline__ void stage64(LAS unsigned char* dst, const bf16* src, int gp, int tid) {
    constexpr int N = (NR * 8 + 511) / 512; u32x4 v[N];
#pragma unroll
    for (int i = 0; i < N; ++i) { const int c = tid + 512 * i, row = c >> 3, ch = c & 7; if (NR * 8 % 512 == 0 || c < NR * 8) v[i] = *(const u32x4*)(src + (size_t)row * gp + ch * 8); }
#pragma unroll
    for (int i = 0; i < N; ++i) { const int c = tid + 512 * i, row = c >> 3, ch = c & 7; if (NR * 8 % 512 == 0 || c < NR * 8) *(LAS u32x4*)(dst + row * PIT + ch * 16) = v[i]; }
}

template <int NI> __device__ __forceinline__ void stage256n(LAS unsigned char* const (&dst)[NI], const bf16* const (&src)[NI], int gp, int tid) {
    u32x4 v[NI][4];
#pragma unroll
    for (int k = 0; k < NI; ++k)
#pragma unroll
        for (int i = 0; i < 4; ++i) { const int c = tid + 512 * i, row = c >> 3, ch = c & 7; v[k][i] = *(const u32x4*)(src[k] + (size_t)row * gp + ch * 8); }
#pragma unroll
    for (int k = 0; k < NI; ++k)
#pragma unroll
        for (int i = 0; i < 4; ++i) { const int c = tid + 512 * i, row = c >> 3, ch = c & 7; *(LAS u32x4*)(dst[k] + row * PIT + ch * 16) = v[k][i]; }
}

__device__ __forceinline__ void sincos_acc(float angf, float& c, float& s) {
    const double a = (double)angf, kq = rint(a * 0.63661977236758134308), r = a - kq * 1.57079632679489661923, r2 = r * r;
    const double sn = r * (1.0 + r2 * (-1.0 / 6.0 + r2 * (1.0 / 120.0 + r2 * (-1.0 / 5040.0 + r2 * (1.0 / 362880.0 + r2 * (-1.0 / 39916800.0))))));
    const double cs = 1.0 + r2 * (-0.5 + r2 * (1.0 / 24.0 + r2 * (-1.0 / 720.0 + r2 * (1.0 / 40320.0 + r2 * (-1.0 / 3628800.0 + r2 * (1.0 / 479001600.0))))));
    const int q = ((int)kq) & 3;
    const double cc = (q == 0) ? cs : (q == 1) ? -sn : (q == 2) ? -cs : sn, ssv = (q == 0) ? sn : (q == 1) ? cs : (q == 2) ? -sn : -cs;
    c = (float)cc; s = (float)ssv;
}
__device__ __forceinline__ int cvt_tgt(int mode, int c, float& sc) {
    sc = 1.f;
    if (mode == 0) return c;
    if (mode == 1) return 256 * (c >> 7) + (c & 127);
    if (mode == 2) return 256 * (c >> 7) + 128 + (c & 127);
    if (c < 768) { const int sec = c >= 384, w = c - 384 * sec, hh = w >> 6, o = w & 63; if (sec) sc = 0.125f; return (sec ? Z_RK : Z_RQ) + hh * 64 + (o < 32 ? 2 * o : 2 * (o - 32) + 1); }
    if (c < 1152) return Z_RV + (c - 768);
    if (c < 1536) return Z_RG + (c - 1152);
    if (c < 2304) { const int sec = c >= 1920, w = c - 1536 - 384 * sec, hh = w >> 6, o = w & 63; if (!sec) sc = C2; return (sec ? Z_MK : Z_MQ) + hh * 64 + (o < 8 ? 2 * o : o < 16 ? 2 * (o - 8) + 1 : o); }
    if (c < 2688) return Z_MV + (c - 2304);
    if (c < 2944) return Z_CA + (c - 2688);
    return Z_CG + (c - 2944);
}
__device__ __forceinline__ void cvt_item(const float* W, const float* gain, bf16* dst, int K, int NS, int mode, int item, LAS float* scr, int lane) {
    const int nblk = NS >> 5, kb = item / nblk, nb = item - kb * nblk, k0 = kb << 6, c0 = nb << 5;
    const int ksub = lane >> 3, n4 = lane & 7;
    f32x4 v[8]; float gv[8];
#pragma unroll
    for (int i = 0; i < 8; ++i) v[i] = *(const f32x4*)(W + (size_t)(k0 + ksub + 8 * i) * NS + c0 + 4 * n4);
#pragma unroll
    for (int i = 0; i < 8; ++i) gv[i] = gain ? gain[k0 + ksub + 8 * i] : 1.f;
    float sc; (void)cvt_tgt(mode, c0, sc);
#pragma unroll
    for (int i = 0; i < 8; ++i) { const float g = gv[i] * sc; LAS float* s = scr + (ksub + 8 * i) * 33 + 4 * n4; s[0] = v[i][0] * g; s[1] = v[i][1] * g; s[2] = v[i][2] * g; s[3] = v[i][3] * g; }
    LDS_WAIT(); asm volatile("" ::: "memory");
    const int c = lane & 7;
#pragma unroll
    for (int j = 0; j < 4; ++j) { const int n = (lane >> 3) + 8 * j; const LAS float* s = scr + (8 * c) * 33 + n; float dummy;
        u32x4 o; o.x = pk2(s[0 * 33], s[1 * 33]); o.y = pk2(s[2 * 33], s[3 * 33]); o.z = pk2(s[4 * 33], s[5 * 33]); o.w = pk2(s[6 * 33], s[7 * 33]);
        *(u32x4*)(dst + (size_t)cvt_tgt(mode, c0 + n, dummy) * K + k0 + 8 * c) = o; }
    LDS_WAIT(); asm volatile("" ::: "memory");
}
__device__ __forceinline__ void cvt_q8_batch(const float* W, const float* gain, signed char* dst, float* SWt, int NS, int mode, int nb, LAS unsigned char* lds, int wave, int lane) {
    LAS float* scr = (LAS float*)(lds + wave * 16384); LAS float* red = (LAS float*)(lds + wave * 16384 + 12288);
    const int c0 = nb << 5, ksub = lane >> 3, n4 = lane & 7;
    f32x4 v[2][8]; float gv[2][8];
#pragma unroll
    for (int h = 0; h < 2; ++h)
#pragma unroll
        for (int i = 0; i < 8; ++i) v[h][i] = *(const f32x4*)(W + (size_t)(64 * (wave + 8 * h) + ksub + 8 * i) * NS + c0 + 4 * n4);
#pragma unroll
    for (int h = 0; h < 2; ++h)
#pragma unroll
        for (int i = 0; i < 8; ++i) gv[h][i] = gain[64 * (wave + 8 * h) + ksub + 8 * i];
    float sc0; (void)cvt_tgt(mode, c0, sc0);
    f32x4 am = {0.f, 0.f, 0.f, 0.f};
#pragma unroll
    for (int h = 0; h < 2; ++h)
#pragma unroll
        for (int i = 0; i < 8; ++i) { v[h][i] = v[h][i] * (gv[h][i] * sc0);
#pragma unroll
            for (int e = 0; e < 4; ++e) am[e] = fmaxf(am[e], fabsf(v[h][i][e])); }
#pragma unroll
    for (int o = 8; o < 64; o <<= 1)
#pragma unroll
        for (int e = 0; e < 4; ++e) am[e] = fmaxf(am[e], __shfl_xor(am[e], o));
    if (lane < 8) *(LAS f32x4*)(red + 4 * n4) = am;
    __syncthreads();
    f32x4 cm = {0.f, 0.f, 0.f, 0.f};
#pragma unroll
    for (int w = 0; w < 8; ++w) { const f32x4 t = *(const LAS f32x4*)(lds + w * 16384 + 12288 + 16 * n4);
#pragma unroll
        for (int e = 0; e < 4; ++e) cm[e] = fmaxf(cm[e], t[e]); }
    f32x4 inv;
#pragma unroll
    for (int e = 0; e < 4; ++e) inv[e] = cm[e] > 0.f ? 127.0f / cm[e] : 0.f;
    float dummy;
#pragma unroll
    for (int h = 0; h < 2; ++h) {
#pragma unroll
        for (int i = 0; i < 8; ++i) { LAS float* s = scr + (ksub + 8 * i) * 33 + 4 * n4;
#pragma unroll
            for (int e = 0; e < 4; ++e) s[e] = __builtin_rintf(v[h][i][e] * inv[e]); }
        LDS_WAIT(); asm volatile("" ::: "memory");
        const int c = lane & 7;
#pragma unroll
        for (int j = 0; j < 4; ++j) { const int n = (lane >> 3) + 8 * j; const LAS float* s = scr + (8 * c) * 33 + n; unsigned q[8];
#pragma unroll
            for (int t = 0; t < 8; ++t) q[t] = (unsigned)(int)s[t * 33] & 0xffu;
            u32x2 o; o.x = q[0] | (q[1] << 8) | (q[2] << 16) | (q[3] << 24); o.y = q[4] | (q[5] << 8) | (q[6] << 16) | (q[7] << 24);
            *(u32x2*)(dst + (size_t)cvt_tgt(mode, c0 + n, dummy) * DM + 64 * (wave + 8 * h) + 8 * c) = o; }
        LDS_WAIT(); asm volatile("" ::: "memory");
    }
    if (wave == 0 && lane < 8) {
#pragma unroll
        for (int e = 0; e < 4; ++e) SWt[cvt_tgt(mode, c0 + 4 * n4 + e, dummy)] = cm[e] * (1.0f / 127.0f); }
}
constexpr int I_D = (FF / 64) * (DM / 32), I_IN = (DM / 64) * (ZN / 32), I_OUT = (DM / 64) * (DM / 32);
constexpr int B_G = FF / 32, B_D = I_D / 8, B_IN = I_IN / 8, B_IN8 = ZN / 32, B_OUT = I_OUT / 8;
static_assert(I_D % 8 == 0 && I_IN % 8 == 0 && I_OUT % 8 == 0, "whole batches");
constexpr int WIN8_FROM = 1;
__host__ __device__ constexpr int b_in(int l) { return l >= WIN8_FROM ? B_IN8 : B_IN; }
constexpr int B_EARLY0 = 2 * B_G + B_D, B_LATE = 2 * B_G + B_D + B_OUT;
__host__ __device__ constexpr int b_early(int l) { return B_EARLY0 + b_in(l); }
__host__ __device__ constexpr int b_layer(int l) { return b_early(l) + B_LATE; }
struct Args { const float* in[18]; float* out; unsigned char* ws; float invf[40]; int ph_lo, ph_hi; };
#define AIN(k) ((const float*)(GAS const float*)A.in[(k) + zi])
__device__ __forceinline__ void cvt_layer_batch(const Args& A, int zi, int l, unsigned char* wb, int bt, LAS unsigned char* lds, int wave, int lane) {
    const size_t lgu = (size_t)l * DM * FF, lw = (size_t)l * DM; LAS float* scr = (LAS float*)(lds + wave * 16384);
    int r = bt;
    if (r < B_G) { cvt_q8_batch(AIN(3) + lgu, AIN(2) + lw, (signed char*)(wb + WO_GU1), (float*)(wb + WO_GU1 + WO_SW), FF, 1, r, lds, wave, lane); return; } r -= B_G;
    if (r < B_G) { cvt_q8_batch(AIN(4) + lgu, AIN(2) + lw, (signed char*)(wb + WO_GU1), (float*)(wb + WO_GU1 + WO_SW), FF, 2, r, lds, wave, lane); return; } r -= B_G;
    if (r < B_D) { cvt_item(AIN(5) + lgu, nullptr, (bf16*)(wb + WO_D1), FF, DM, 0, 8 * r + wave, scr, lane); return; } r -= B_D;
    if (r < b_in(l)) { if (l >= WIN8_FROM) cvt_q8_batch(AIN(7) + (size_t)l * DM * ZN, AIN(6) + lw, (signed char*)(wb + WO_IN8), (float*)(wb + WO_SWIN), ZN, 3, r, lds, wave, lane);
        else cvt_item(AIN(7) + (size_t)l * DM * ZN, AIN(6) + lw, (bf16*)(wb + WO_IN), DM, ZN, 3, 8 * r + wave, scr, lane); return; } r -= b_in(l);
    if (r < B_G) { cvt_q8_batch(AIN(14) + lgu, AIN(13) + lw, (signed char*)(wb + WO_GU2), (float*)(wb + WO_GU2 + WO_SW), FF, 1, r, lds, wave, lane); return; } r -= B_G;
    if (r < B_G) { cvt_q8_batch(AIN(15) + lgu, AIN(13) + lw, (signed char*)(wb + WO_GU2), (float*)(wb + WO_GU2 + WO_SW), FF, 2, r, lds, wave, lane); return; } r -= B_G;
    if (r < B_D) { cvt_item(AIN(16) + lgu, nullptr, (bf16*)(wb + WO_D2), FF, DM, 0, 8 * r + wave, scr, lane); return; } r -= B_D;
    cvt_item(AIN(12) + (size_t)l * DM * DM, nullptr, (bf16*)(wb + WO_OUT), DM, DM, 0, 8 * r + wave, scr, lane);
}
#define XB_TMO      128
#define XB_XCNT(j)  (256  + 64 * (j))
#define XB_XSUB(j)  (1280 + 64 * (j))
#define XB_XGEN(j)  (2304 + 64 * (j))
#define XB_TOP      3328
#define XB_TOPGEN   3392
#define XCD_BAR_WORDS 3456
#define XB_SPIN_CAP (1u << 18)

__device__ __forceinline__ unsigned xb_ld(unsigned* p)              { return __hip_atomic_load(p, __ATOMIC_RELAXED, __HIP_MEMORY_SCOPE_AGENT); }
__device__ __forceinline__ unsigned xb_add(unsigned* p, unsigned v) { return __hip_atomic_fetch_add(p, v, __ATOMIC_RELAXED, __HIP_MEMORY_SCOPE_AGENT); }
__device__ __forceinline__ unsigned xb_xcc_id() { return (unsigned)__builtin_amdgcn_s_getreg((3 << 11) | 20) & 0xFu; }
#define XB_SPIN(cond, bar) do { unsigned _sp = 0; while (cond) { __builtin_amdgcn_s_sleep(1); \
    if ((++_sp & 255u) == 0u) { if (xb_ld(&(bar)[XB_TMO])) break; if (_sp > XB_SPIN_CAP) { atomicAdd(&(bar)[XB_TMO], 1u); break; } } } } while (0)

struct XcdBarrier {
    unsigned* bar; unsigned x;
    volatile LAS unsigned* st;
};

__device__ __forceinline__ XcdBarrier xcd_barrier_post(unsigned* bar, volatile LAS unsigned* st) {
    XcdBarrier b; b.bar = bar; b.x = xb_xcc_id(); b.st = st;
    if (threadIdx.x == 0) (void)xb_add(&bar[XB_XCNT(b.x)], 1u);
    return b;
}
__device__ __forceinline__ void xcd_barrier_complete(unsigned* bar, unsigned x, unsigned& nloc, unsigned& nx) {
    const unsigned G = gridDim.x * gridDim.y * gridDim.z;
    unsigned sum, cnt, mine, sp = 0u;
    for (;;) {
        sum = 0u; cnt = 0u; mine = 0u;
#pragma unroll
        for (unsigned j = 0; j < 16; ++j) { const unsigned c = xb_ld(&bar[XB_XCNT(j)]); sum += c; cnt += (c > 0u) ? 1u : 0u; mine = (j == x) ? c : mine; }
        if (sum == G) break;
        __builtin_amdgcn_s_sleep(1);
        if ((++sp & 255u) == 0u) { if (xb_ld(&bar[XB_TMO])) break; if (sp > XB_SPIN_CAP) { atomicAdd(&bar[XB_TMO], 1u); break; } }
    }
    nloc = mine > 0u ? mine : 1u; nx = cnt > 0u ? cnt : 1u;
}

__device__ __forceinline__ void xcd_barrier(const XcdBarrier& b) {
    asm volatile("s_waitcnt vmcnt(0)" ::: "memory");
    __syncthreads();
    if (threadIdx.x == 0) {
        unsigned* bar = b.bar;
        __builtin_amdgcn_s_waitcnt(0);
        unsigned nloc = b.st[0], nx = b.st[1];
        if (nloc == 0u) { xcd_barrier_complete(bar, b.x, nloc, nx); b.st[0] = nloc; b.st[1] = nx; }
        const unsigned old = xb_add(&bar[XB_XSUB(b.x)], 1u);
        const unsigned gen = old / nloc;
        if (old + 1u == (gen + 1u) * nloc) {
            __builtin_amdgcn_fence(__ATOMIC_RELEASE, "agent");
            asm volatile("s_waitcnt vmcnt(0)" ::: "memory");
            const unsigned og = xb_add(&bar[XB_TOP], 1u);
            const unsigned tg = og / nx;
            if (og + 1u == (tg + 1u) * nx) xb_add(&bar[XB_TOPGEN], 1u);
            else XB_SPIN(xb_ld(&bar[XB_TOPGEN]) == tg, bar);
            __builtin_amdgcn_fence(__ATOMIC_ACQUIRE, "agent");
            xb_add(&bar[XB_XGEN(b.x)], 1u);
            asm volatile("s_waitcnt vmcnt(0)" ::: "memory");
        } else {
            XB_SPIN(xb_ld(&bar[XB_XGEN(b.x)]) == gen, bar);
            __builtin_amdgcn_fence(__ATOMIC_ACQUIRE, "agent");
            asm volatile("s_waitcnt vmcnt(0)" ::: "memory");
        }
    }
    __syncthreads();
}
__device__ __forceinline__ void xcd_local_barrier(unsigned* lb, unsigned x, unsigned nloc, unsigned* tmo) {
    asm volatile("s_waitcnt vmcnt(0)" ::: "memory");
    __syncthreads();
    if (threadIdx.x == 0) {
        __builtin_amdgcn_s_waitcnt(0);
        const unsigned old = xb_add(&lb[64 * x], 1u), gen = old / nloc;
        if (old + 1u == (gen + 1u) * nloc) xb_add(&lb[64 * (16 + x)], 1u);
        else { unsigned sp = 0u; while (xb_ld(&lb[64 * (16 + x)]) == gen) { __builtin_amdgcn_s_sleep(1); if (++sp > (1u << 22)) { __hip_atomic_store(tmo, 1u, __ATOMIC_RELAXED, __HIP_MEMORY_SCOPE_AGENT); break; } } }
        __builtin_amdgcn_fence(__ATOMIC_ACQUIRE, "agent");
        asm volatile("s_waitcnt vmcnt(0)" ::: "memory");
    }
    __syncthreads();
}
__device__ __forceinline__ void conv_item(int it, const bf16* z, bf16* mix, const float* cw, const float* cb, const float* lg, const float* lb, LAS unsigned char* lds, int tid, int wave, int lane) {
    LAS float* U = (LAS float*)lds;
    const int t0 = it * 64, s0 = t0 & (SEQ - 1);
    u32x4 av[6], gv[6];
#pragma unroll
    for (int i = 0; i < 6; ++i) { const int c = tid + 512 * i, row = c >> 5, ch = c & 31; av[i] = (u32x4){0u, 0u, 0u, 0u}; gv[i] = av[i];
        if (c < 94 * 32 && s0 - 30 + row >= 0) { const bf16* zr = z + (size_t)(t0 - 30 + row) * ZP; av[i] = *(const u32x4*)(zr + Z_CA + 8 * ch); gv[i] = *(const u32x4*)(zr + Z_CG + 8 * ch); } }
#pragma unroll
    for (int i = 0; i < 6; ++i) { const int c = tid + 512 * i, row = c >> 5, ch = c & 31; const u32x4 a = av[i], g = gv[i]; f32x4 o0, o1;
        o0[0] = bflo(a.x) * sigm1(bflo(g.x)); o0[1] = bfhi(a.x) * sigm1(bfhi(g.x)); o0[2] = bflo(a.y) * sigm1(bflo(g.y)); o0[3] = bfhi(a.y) * sigm1(bfhi(g.y));
        o1[0] = bflo(a.z) * sigm1(bflo(g.z)); o1[1] = bfhi(a.z) * sigm1(bfhi(g.z)); o1[2] = bflo(a.w) * sigm1(bflo(g.w)); o1[3] = bfhi(a.w) * sigm1(bfhi(g.w));
        if (c < 94 * 32) { *(LAS f32x4*)(U + row * 256 + 8 * ch) = o0; *(LAS f32x4*)(U + row * 256 + 8 * ch + 4) = o1; } }
    __syncthreads();
    const int g = wave & 3, half = wave >> 2, c = 64 * g + lane;
    float w[31];
#pragma unroll
    for (int j = 0; j < 31; ++j) w[j] = cw[j * 256 + c];
    const float bias = cb[c], gg = lg[c], bb = lb[c];
    float uw[62];
#pragma unroll
    for (int i = 0; i < 62; ++i) uw[i] = U[(32 * half + i) * 256 + c];
#pragma unroll
    for (int tb = 0; tb < 32; tb += 4) {
        float y[4], mu[4], var[4];
#pragma unroll
        for (int k = 0; k < 4; ++k) { y[k] = bias;
#pragma unroll
            for (int j = 0; j < 31; ++j) y[k] += w[j] * uw[tb + k + j]; }
#pragma unroll
        for (int k = 0; k < 4; ++k) mu[k] = y[k];
#pragma unroll
        for (int o = 1; o < 64; o <<= 1) {
#pragma unroll
            for (int k = 0; k < 4; ++k) mu[k] += __shfl_xor(mu[k], o); }
#pragma unroll
        for (int k = 0; k < 4; ++k) { mu[k] *= (1.f / 64.f); y[k] -= mu[k]; var[k] = y[k] * y[k]; }
#pragma unroll
        for (int o = 1; o < 64; o <<= 1) {
#pragma unroll
            for (int k = 0; k < 4; ++k) var[k] += __shfl_xor(var[k], o); }
#pragma unroll
        for (int k = 0; k < 4; ++k) { const float yn = y[k] * __builtin_amdgcn_rsqf(var[k] * (1.f / 64.f) + RMS_EPS) * gg + bb;
            mix[(size_t)(t0 + 32 * half + tb + k) * DM + X_CONV + c] = (bf16)(pk2(silu1(yn), 0.f) & 0xffffu); }
    }
    __syncthreads();
}
#define RLX_AGENT __ATOMIC_RELAXED, __HIP_MEMORY_SCOPE_AGENT
__device__ __forceinline__ void st_wt(float* p, float v) { __hip_atomic_store(p, v, RLX_AGENT); }
__device__ __forceinline__ void st_wt(unsigned* p, unsigned v) { __hip_atomic_store(p, v, RLX_AGENT); }
__device__ __forceinline__ void st_wt(unsigned long long* p, unsigned long long v) { __hip_atomic_store(p, v, RLX_AGENT); }
__device__ __forceinline__ float ld_wt(const float* p) { return __hip_atomic_load(p, RLX_AGENT); }
__device__ __forceinline__ unsigned ld_wt(const unsigned* p) { return __hip_atomic_load(p, RLX_AGENT); }
__device__ __forceinline__ unsigned long long ld_wt(const unsigned long long* p) { return __hip_atomic_load(p, RLX_AGENT); }
__device__ __forceinline__ void publish_wave(unsigned* ctr, int lane) { asm volatile("s_waitcnt vmcnt(0)" ::: "memory"); if (lane == 0) __hip_atomic_fetch_add(ctr, 1u, RLX_AGENT); }
__device__ __forceinline__ void wait_count(unsigned* ctr, unsigned need, unsigned* tmo, int tid) {
    if (tid == 0) { unsigned sp = 0u;
        while (__hip_atomic_load(ctr, RLX_AGENT) < need) { __builtin_amdgcn_s_sleep(2); if (++sp > (1u << 20)) { __hip_atomic_store(tmo, 1u, RLX_AGENT); break; } } }
    __syncthreads();
}
__device__ __forceinline__ void kv_item(int it2, const bf16* z, float* KV, unsigned* kvc, LAS unsigned char* lds, int tid, int wave, int lane) {
    const int team = wave >> 2, it = 2 * it2 + team, tt = tid & 255;
    const int bh = it >> 5, n = it & 31, b = bh / NHM, hh = bh - b * NHM; const size_t tok0 = (size_t)b * SEQ + 256 * n;
    const float lg2 = log2f(1.0f - ex2(-5.0f - (float)hh));
    LAS unsigned char* Ki = lds + team * 65536; LAS unsigned char* Vw = Ki + 32768;
    { u32x4 kk[8], vv[8];
#pragma unroll
    for (int i = 0; i < 8; ++i) { const int c = tt + 256 * i, row = c >> 3, ch = c & 7; kk[i] = *(const u32x4*)(z + (tok0 + row) * ZP + Z_RK + 64 * hh + ch * 8); vv[i] = *(const u32x4*)(z + (tok0 + row) * ZP + Z_RV + 64 * hh + ch * 8); }
#pragma unroll
    for (int i = 0; i < 8; ++i) { const int c = tt + 256 * i, row = c >> 3, ch = c & 7; const u32x4 v = vv[i];
        const float wg = ex2((float)(255 - row) * lg2); u32x4 o;
        o.x = pk2(bflo(v.x) * wg, bfhi(v.x) * wg); o.y = pk2(bflo(v.y) * wg, bfhi(v.y) * wg); o.z = pk2(bflo(v.z) * wg, bfhi(v.z) * wg); o.w = pk2(bflo(v.w) * wg, bfhi(v.w) * wg);
        *(LAS u32x4*)(Ki + row * 128 + ch * 16) = kk[i]; *(LAS u32x4*)(Vw + row * 128 + ch * 16) = o; } }
    __syncthreads();
    const int tl = wave & 3, ce = tl >> 1, cd = tl & 1, r = lane & 31, h = lane >> 5, blk = (lane >> 4) & 1, q4 = (lane & 15) >> 2, p = lane & 3;
    f32x16 acc = zero16();
#pragma unroll
    for (int kk = 0; kk < 16; ++kk) { const int rowa = 16 * kk + 8 * h + q4; const int ofa = rowa * 128 + 32 * blk + 8 * p;
        const bf16x8 a = cat8(vtr(Vw + ofa + 64 * ce), vtr(Vw + ofa + 4 * 128 + 64 * ce));
        const bf16x8 bb = cat8(vtr(Ki + ofa + 64 * cd), vtr(Ki + ofa + 4 * 128 + 64 * cd));
        acc = mfma32(a, bb, acc); }
    float* o = KV + (size_t)it * 4096;
#pragma unroll
    for (int i = 0; i < 16; ++i) st_wt(o + (32 * ce + crow(i, h)) * 64 + 32 * cd + r, acc[i]);
    publish_wave(kvc + 64 * bh, lane);
    __syncthreads();
}
__device__ __forceinline__ void kmean_item(int it8, const bf16* z, float* KM, unsigned* kmc, LAS unsigned char* lds, int wave, int lane) {
    const int it = 8 * it8 + wave, bh = it >> 5, j = it & 31, b = bh / NHM, hh = bh - b * NHM; const size_t tok0 = (size_t)b * SEQ + 256 * j;
    LAS float* S = (LAS float*)(lds + wave * 2048);
    const int g = lane >> 3, ch = lane & 7; float a[8];
#pragma unroll
    for (int k = 0; k < 8; ++k) a[k] = 0.f;
#pragma unroll
    for (int q = 0; q < 4; ++q) { u32x4 v[8];
#pragma unroll
        for (int i = 0; i < 8; ++i) v[i] = *(const u32x4*)(z + (tok0 + g + 8 * (8 * q + i)) * ZP + Z_MK + 64 * hh + ch * 8);
#pragma unroll
        for (int i = 0; i < 8; ++i) { a[0] += bflo(v[i].x); a[1] += bfhi(v[i].x); a[2] += bflo(v[i].y); a[3] += bfhi(v[i].y); a[4] += bflo(v[i].z); a[5] += bfhi(v[i].z); a[6] += bflo(v[i].w); a[7] += bfhi(v[i].w); } }
    *(LAS f32x4*)(S + g * 64 + ch * 8) = (f32x4){a[0], a[1], a[2], a[3]}; *(LAS f32x4*)(S + g * 64 + ch * 8 + 4) = (f32x4){a[4], a[5], a[6], a[7]};
    LDS_WAIT(); asm volatile("" ::: "memory");
    float s = 0.f;
#pragma unroll
    for (int q = 0; q < 8; ++q) s += S[q * 64 + lane];
    st_wt(KM + (size_t)it * 64 + lane, s * (1.f / 256.f)); publish_wave(kmc + 64 * bh, lane);
    LDS_WAIT(); asm volatile("" ::: "memory");
}
__device__ __forceinline__ void scan_item(int it, const float* KV, bf16* PREV, unsigned* kvc, unsigned* scc, unsigned* tmo, int tid, int lane) {
    const int bh = it >> 1, part = it & 1, hh = bh % NHM; const int idx = part * 2048 + 4 * tid;
    wait_count(kvc + 64 * bh, 128u, tmo, tid);
    const float g256 = ex2(256.0f * log2f(1.0f - ex2(-5.0f - (float)hh)));
    float k0[NCH], k1[NCH], k2[NCH], k3[NCH];
#pragma unroll
    for (int n = 0; n < NCH; ++n) { const float* p = KV + ((size_t)bh * NCH + n) * 4096 + idx; k0[n] = ld_wt(p); k1[n] = ld_wt(p + 1); k2[n] = ld_wt(p + 2); k3[n] = ld_wt(p + 3); }
    float s0 = 0.f, s1 = 0.f, s2 = 0.f, s3 = 0.f;
#pragma unroll
    for (int n = 0; n < NCH; ++n) { st_wt((unsigned long long*)(PREV + ((size_t)bh * NCH + n) * 4096 + idx), (unsigned long long)pk2(s0, s1) | ((unsigned long long)pk2(s2, s3) << 32));
        s0 = s0 * g256 + k0[n]; s1 = s1 * g256 + k1[n]; s2 = s2 * g256 + k2[n]; s3 = s3 * g256 + k3[n]; }
    publish_wave(scc + 64 * bh, lane);
}
__device__ __forceinline__ void gate_item(int it, const bf16* z, const float* KM, unsigned* SEL, unsigned* kmc, unsigned* gtc, unsigned* tmo, LAS unsigned char* lds, int tid, int lane) {
    const int bh = it >> 4, ip = it & 15, b = bh / NHM, hh = bh - b * NHM;
    wait_count(kmc + 64 * bh, 32u, tmo, tid);
    LAS float* km = (LAS float*)lds;
#pragma unroll
    for (int i = 0; i < 4; ++i) km[tid + 512 * i] = ld_wt(KM + (size_t)bh * 2048 + tid + 512 * i);
    __syncthreads();
    const int i = 2 * ip + (tid >> 8), s = 256 * i + (tid & 255);
    const bf16* qp = z + ((size_t)b * SEQ + s) * ZP + Z_MQ + 64 * hh;
    float q[64];
#pragma unroll
    for (int c = 0; c < 8; ++c) { const u32x4 v = *(const u32x4*)(qp + 8 * c);
        q[8 * c] = bflo(v.x); q[8 * c + 1] = bfhi(v.x); q[8 * c + 2] = bflo(v.y); q[8 * c + 3] = bfhi(v.y); q[8 * c + 4] = bflo(v.z); q[8 * c + 5] = bfhi(v.z); q[8 * c + 6] = bflo(v.w); q[8 * c + 7] = bfhi(v.w); }
    const float ninf = -__builtin_inff();
    float v0 = ninf, v1 = ninf, v2 = ninf; int i0 = 0, i1 = 0, i2 = 0;
    for (int j = 0; j < i; ++j) { float g = 0.f;
#pragma unroll
        for (int d = 0; d < 64; d += 4) { const f32x4 k4 = *(const LAS f32x4*)(km + j * 64 + d); g += q[d] * k4[0] + q[d + 1] * k4[1] + q[d + 2] * k4[2] + q[d + 3] * k4[3]; }
        if (g > v0) { v2 = v1; i2 = i1; v1 = v0; i1 = i0; v0 = g; i0 = j; }
        else if (g > v1) { v2 = v1; i2 = i1; v1 = g; i1 = j; }
        else if (g > v2) { v2 = g; i2 = j; } }
    unsigned mask = 0u;
    if (i > 0) mask |= 1u << i0;
    if (i > 1) mask |= 1u << i1;
    if (i > 2) mask |= 1u << i2;
    st_wt(SEL + (size_t)bh * SEQ + s, mask);
    publish_wave(gtc + 64 * bh, lane);
    __syncthreads();
}
__device__ __forceinline__ void attn_wave(LAS const unsigned char* Ki, LAS const unsigned char* Vi, const bf16x8 (&qf)[4], int nkt, int diag, int qloc, int lane, f32x16 (&o)[2], float& m, float& l) {
    const int r = lane & 31, h = lane >> 5, blk = (lane >> 4) & 1, q4 = (lane & 15) >> 2, p = lane & 3;
    o[0] = zero16(); o[1] = zero16(); l = 0.f; m = 0.f;
    f32x16 negm = zero16();
    bf16x8 kf[4];
#pragma unroll
    for (int s = 0; s < 4; ++s) kf[s] = ldsrow(Ki + r * PIT + 32 * s + 16 * h);
    for (int kt = 0; kt < nkt; ++kt) {
        f32x16 x = negm;
        asm volatile("" : "+v"(kf[0]), "+v"(kf[1]), "+v"(kf[2]), "+v"(kf[3]));
#pragma unroll
        for (int s = 0; s < 4; ++s) x = mfma32(kf[s], qf[s], x);
        const int ktn = (kt + 1 < nkt) ? kt + 1 : kt;
#pragma unroll
        for (int s = 0; s < 4; ++s) kf[s] = ldsrow(Ki + (32 * ktn + r) * PIT + 32 * s + 16 * h);
        bf16x8 vf[2][2];
#pragma unroll
        for (int s2 = 0; s2 < 2; ++s2) { const int ofv = (32 * kt + 16 * s2 + 4 * h + q4) * PIT + 32 * blk + 8 * p;
#pragma unroll
            for (int c = 0; c < 2; ++c) vf[s2][c] = cat8(vtr(Vi + ofv + 64 * c), vtr(Vi + ofv + 8 * PIT + 64 * c)); }
        __builtin_amdgcn_sched_barrier(0);
        if (kt == diag) {
#pragma unroll
            for (int i = 0; i < 16; ++i) if (32 * kt + crow(i, h) > qloc) x[i] = -__builtin_inff(); }
        float tm = x[0];
#pragma unroll
        for (int i = 1; i < 16; ++i) tm = fmaxf(tm, x[i]);
        tm = fmaxf(tm, __shfl_xor(tm, 32));
        if (kt == 0) { m = tm;
#pragma unroll
            for (int i = 0; i < 16; ++i) { x[i] -= tm; negm[i] = -tm; } }
        else if (__any(tm > 8.0f)) {
            const float dm = fmaxf(tm, 0.f), sc = ex2(-dm);
            l *= sc; o[0] = o[0] * sc; o[1] = o[1] * sc; m += dm;
#pragma unroll
            for (int i = 0; i < 16; ++i) { x[i] -= dm; negm[i] = -m; } }
#pragma unroll
        for (int i = 0; i < 16; ++i) { x[i] = ex2(x[i]); l += x[i]; }
        const bf16x8 pf0 = pack8(x, 0), pf1 = pack8(x, 1);
        __builtin_amdgcn_sched_barrier(0);
        o[0] = mfma32(vf[0][0], pf0, o[0]); o[1] = mfma32(vf[0][1], pf0, o[1]); o[0] = mfma32(vf[1][0], pf1, o[0]); o[1] = mfma32(vf[1][1], pf1, o[1]);
    }
}
__device__ __forceinline__ void store_partial(const f32x16 (&o)[2], float m, float l, bf16* OP, float* LSE, int bh, int slot, int qidx, bool valid, int lane) {
    const int h = lane >> 5; const float lt = l + __shfl_xor(l, 32), inv = 1.0f / lt;
    if (!valid) return;
    bf16* op = OP + (((size_t)bh * 4 + slot) * SEQ + qidx) * 64;
#pragma unroll
    for (int c = 0; c < 2; ++c)
#pragma unroll
        for (int g = 0; g < 4; ++g) { u32x2 w; w.x = pk2(o[c][4 * g] * inv, o[c][4 * g + 1] * inv); w.y = pk2(o[c][4 * g + 2] * inv, o[c][4 * g + 3] * inv); *(u32x2*)(op + 32 * c + 8 * g + 4 * h) = w; }
    if (h == 0) LSE[((size_t)bh * 4 + slot) * SEQ + qidx] = m + log2f(lt);
}
__device__ __forceinline__ void moba_item(int bh, int j, bool own, int i0, int i1, const bf16* z, const unsigned* SEL, bf16* OP, float* LSE, unsigned* gtc, unsigned* tmo, LAS unsigned char* lds, int tid, int wave, int lane) {
    const int b = bh / NHM, hh = bh - b * NHM; const size_t tokb = (size_t)b * SEQ;
    wait_count(gtc + 64 * bh, 128u, tmo, tid);
    LAS unsigned char* Ki = lds; LAS unsigned char* Vi = lds + IMG; LAS unsigned short* list = (LAS unsigned short*)(lds + 2 * IMG); LAS int* wtot = (LAS int*)(lds + 2 * IMG + 4096);
    const int ncand = 256 * (i1 - i0), c0 = 4 * tid; int f[4] = {0, 0, 0, 0};
    u32x4 mk = {0u, 0u, 0u, 0u};
    if (c0 < ncand) { const unsigned* sp = SEL + (size_t)bh * SEQ + 256 * i0 + c0; mk = (u32x4){ld_wt(sp), ld_wt(sp + 1), ld_wt(sp + 2), ld_wt(sp + 3)}; }
    const int r = lane & 31, h = lane >> 5, qt = wave < 4 ? wave : 11 - wave;
    { LAS unsigned char* const d_[2] = {Ki, Vi}; const bf16* const s_[2] = {z + (tokb + 256 * j) * ZP + Z_MK + 64 * hh, z + (tokb + 256 * j) * ZP + Z_MV + 64 * hh}; stage256n<2>(d_, s_, ZP, tid); }
    f[0] = (mk.x >> j) & 1; f[1] = (mk.y >> j) & 1; f[2] = (mk.z >> j) & 1; f[3] = (mk.w >> j) & 1;
    const int mine = f[0] + f[1] + f[2] + f[3]; int inc = mine;
#pragma unroll
    for (int o = 1; o < 64; o <<= 1) { const int t = __shfl_up(inc, o); if (lane >= o) inc += t; }
    if (lane == 63) wtot[wave] = inc;
    __syncthreads();
    int base = 0, cnt = 0;
#pragma unroll
    for (int w = 0; w < 8; ++w) { const int t = wtot[w]; if (w < wave) base += t; cnt += t; }
    int pos = base + inc - mine;
#pragma unroll
    for (int k = 0; k < 4; ++k) if (f[k]) { list[pos] = (unsigned short)(256 * i0 + c0 + k); ++pos; }
    __syncthreads();
    const int ntl = (cnt + 255) >> 8, Tfirst = own ? -1 : 0;
    int qidx = 0; bool valid = false; unsigned mq = 0u; bf16x8 qn[4];
#define MOBA_LOADQ(Tn) do { if ((Tn) < 0) { qidx = 256 * j + 32 * qt + r; valid = true; } else { const int li_ = 256 * (Tn) + 32 * wave + r; valid = li_ < cnt; qidx = list[valid ? li_ : cnt - 1]; } \
        _Pragma("unroll") for (int s = 0; s < 4; ++s) qn[s] = *(const bf16x8*)(z + (tokb + qidx) * ZP + Z_MQ + 64 * hh + 16 * s + 8 * h); \
        mq = ld_wt(SEL + (size_t)bh * SEQ + qidx); } while (0)
    if (Tfirst < 0 || 32 * wave < cnt) MOBA_LOADQ(Tfirst);
    for (int T = Tfirst; T < ntl; ++T) {
        if (T >= 0 && 256 * T + 32 * wave >= cnt) break;
        bf16x8 qf[4];
#pragma unroll
        for (int s = 0; s < 4; ++s) qf[s] = qn[s];
        const int qcur = qidx, slot = (T < 0) ? 3 : __builtin_popcount(mq & ((1u << j) - 1u)); const bool vcur = valid;
        if (T + 1 < ntl && 256 * (T + 1) + 32 * wave < cnt) MOBA_LOADQ(T + 1);
        f32x16 o[2]; float m, l;
        attn_wave(Ki, Vi, qf, (T < 0) ? qt + 1 : 8, (T < 0) ? qt : -1, 32 * qt + r, lane, o, m, l);
        store_partial(o, m, l, OP, LSE, bh, slot, qcur, vcur, lane);
    }
#undef MOBA_LOADQ
    __syncthreads();
}
__device__ __forceinline__ void ret_item(int it, const bf16* z, const bf16* PREV, bf16* mix, unsigned* scc, unsigned* tmo, LAS unsigned char* lds, int tid, int wave, int lane) {
    const int bh = it >> 5, n = it & 31, b = bh / NHM, hh = bh - b * NHM; const size_t tok0 = (size_t)b * SEQ + 256 * n;
    wait_count(scc + 64 * bh, 16u, tmo, tid);
    const float lg2 = log2f(1.0f - ex2(-5.0f - (float)hh));
    LAS unsigned char* Qi = lds; LAS unsigned char* Ki = lds + IMG; LAS unsigned char* Vi = lds + 2 * IMG; LAS unsigned char* Pi = lds + 3 * IMG;
    { const unsigned* pp_ = (const unsigned*)(PREV + (size_t)it * 4096 + (size_t)(tid >> 3) * 64 + (tid & 7) * 8);
      const u32x4 pv_ = {ld_wt(pp_), ld_wt(pp_ + 1), ld_wt(pp_ + 2), ld_wt(pp_ + 3)};
      LAS unsigned char* const d_[3] = {Qi, Ki, Vi}; const bf16* const s_[3] = {z + tok0 * ZP + Z_RQ + 64 * hh, z + tok0 * ZP + Z_RK + 64 * hh, z + tok0 * ZP + Z_RV + 64 * hh}; stage256n<3>(d_, s_, ZP, tid);
      *(LAS u32x4*)(Pi + (tid >> 3) * PIT + (tid & 7) * 16) = pv_; }
    __syncthreads();
    const int qt = wave < 4 ? wave : 11 - wave, r = lane & 31, h = lane >> 5, blk = (lane >> 4) & 1, q4 = (lane & 15) >> 2, p = lane & 3, qloc = 32 * qt + r;
    const bf16* gp = z + (tok0 + qloc) * ZP + Z_RG + 64 * hh;
    u32x2 gvv[2][4];
#pragma unroll
    for (int c = 0; c < 2; ++c)
#pragma unroll
        for (int g = 0; g < 4; ++g) gvv[c][g] = (hh < 4) ? *(const u32x2*)(gp + 32 * c + 8 * g + 4 * h) : (u32x2){0u, 0u};
    bf16x8 qf[4];
#pragma unroll
    for (int s = 0; s < 4; ++s) qf[s] = ldsrow(Qi + qloc * PIT + 32 * s + 16 * h);
    f32x16 cx[2], o[2]; cx[0] = zero16(); cx[1] = zero16(); o[0] = zero16(); o[1] = zero16();
#pragma unroll
    for (int c = 0; c < 2; ++c)
#pragma unroll
        for (int s = 0; s < 4; ++s) cx[c] = mfma32(ldsrow(Pi + (32 * c + r) * PIT + 32 * s + 16 * h), qf[s], cx[c]);
    float grel[16];
#pragma unroll
    for (int i = 0; i < 16; ++i) grel[i] = ex2((float)(r - crow(i, h)) * lg2);
    bf16x8 kf[4];
#pragma unroll
    for (int s = 0; s < 4; ++s) kf[s] = ldsrow(Ki + r * PIT + 32 * s + 16 * h);
    for (int kt = 0; kt <= qt; ++kt) {
        f32x16 x = zero16();
        asm volatile("" : "+v"(kf[0]), "+v"(kf[1]), "+v"(kf[2]), "+v"(kf[3]));
#pragma unroll
        for (int s = 0; s < 4; ++s) x = mfma32(kf[s], qf[s], x);
        const int ktn = (kt < qt) ? kt + 1 : kt;
#pragma unroll
        for (int s = 0; s < 4; ++s) kf[s] = ldsrow(Ki + (32 * ktn + r) * PIT + 32 * s + 16 * h);
        bf16x8 vf[2][2];
#pragma unroll
        for (int s2 = 0; s2 < 2; ++s2) { const int ofv = (32 * kt + 16 * s2 + 4 * h + q4) * PIT + 32 * blk + 8 * p;
#pragma unroll
            for (int c = 0; c < 2; ++c) vf[s2][c] = cat8(vtr(Vi + ofv + 64 * c), vtr(Vi + ofv + 8 * PIT + 64 * c)); }
        __builtin_amdgcn_sched_barrier(0);
        { const float ts = ex2((float)(32 * (qt - kt)) * lg2);
#pragma unroll
        for (int i = 0; i < 16; ++i) { const float wv = grel[i] * ts; x[i] = (kt < qt || r >= crow(i, h)) ? x[i] * wv : 0.f; } }
        const bf16x8 pf0 = pack8(x, 0), pf1 = pack8(x, 1);
        __builtin_amdgcn_sched_barrier(0);
        o[0] = mfma32(vf[0][0], pf0, o[0]); o[1] = mfma32(vf[0][1], pf0, o[1]); o[0] = mfma32(vf[1][0], pf1, o[0]); o[1] = mfma32(vf[1][1], pf1, o[1]);
    }
    const float wcr = ex2((float)(qloc + 1) * lg2); float ss = 0.f;
#pragma unroll
    for (int c = 0; c < 2; ++c)
#pragma unroll
        for (int i = 0; i < 16; ++i) { const float y = o[c][i] + wcr * cx[c][i]; o[c][i] = y; ss += y * y; }
    ss += __shfl_xor(ss, 32);
    const float rn = __builtin_amdgcn_rsqf(ss * (1.f / 64.f) + RMS_EPS);
    bf16* mp = mix + (tok0 + qloc) * DM + X_RET + 64 * hh;
#pragma unroll
    for (int c = 0; c < 2; ++c)
#pragma unroll
        for (int g = 0; g < 4; ++g) { const int e0 = 32 * c + 8 * g + 4 * h; const u32x2 gv = gvv[c][g]; u32x2 w;
            if (hh < 4) { w.x = pk2(silu1(bflo(gv.x)) * o[c][4 * g] * rn, silu1(bfhi(gv.x)) * o[c][4 * g + 1] * rn); w.y = pk2(silu1(bflo(gv.y)) * o[c][4 * g + 2] * rn, silu1(bfhi(gv.y)) * o[c][4 * g + 3] * rn); }
            else { w.x = pk2(o[c][4 * g] * rn, o[c][4 * g + 1] * rn); w.y = pk2(o[c][4 * g + 2] * rn, o[c][4 * g + 3] * rn); }
            *(u32x2*)(mp + e0) = w; }
    __syncthreads();
}
struct CombIn { unsigned selw; float ls[4]; u32x4 ov[4]; };
__device__ __forceinline__ void combine_load(int idx, const bf16* OP, const float* LSE, const unsigned* SEL, CombIn& c) {
    const int ch = idx & 7, th = idx >> 3, hh = th % NHM, tok = th / NHM, b = tok >> 13, s = tok & (SEQ - 1), bh = b * NHM + hh;
    c.selw = SEL[(size_t)bh * SEQ + s];
#pragma unroll
    for (int k = 0; k < 4; ++k) { c.ls[k] = LSE[((size_t)bh * 4 + k) * SEQ + s]; c.ov[k] = *(const u32x4*)(OP + (((size_t)bh * 4 + k) * SEQ + s) * 64 + 8 * ch); }
}
__device__ __forceinline__ void combine_store(int idx, const CombIn& c, bf16* mix) {
    const int ch = idx & 7, th = idx >> 3, hh = th % NHM, tok = th / NHM;
    const int ns = __builtin_popcount(c.selw); float mx = -__builtin_inff(); float ls[4];
#pragma unroll
    for (int k = 0; k < 4; ++k) { const bool on = (k == 3) || (k < ns); ls[k] = on ? c.ls[k] : -__builtin_inff(); mx = fmaxf(mx, ls[k]); }
    float a[8], wsum = 0.f;
#pragma unroll
    for (int k = 0; k < 8; ++k) a[k] = 0.f;
#pragma unroll
    for (int k = 0; k < 4; ++k) { const bool on = (k == 3) || (k < ns); const float wg = on ? ex2(ls[k] - mx) : 0.f; wsum += wg;
        u32x4 v = c.ov[k]; if (!on) v = (u32x4){0u, 0u, 0u, 0u};
        a[0] += wg * bflo(v.x); a[1] += wg * bfhi(v.x); a[2] += wg * bflo(v.y); a[3] += wg * bfhi(v.y); a[4] += wg * bflo(v.z); a[5] += wg * bfhi(v.z); a[6] += wg * bflo(v.w); a[7] += wg * bfhi(v.w); }
    const float inv = 1.0f / wsum; u32x4 w; w.x = pk2(a[0] * inv, a[1] * inv); w.y = pk2(a[2] * inv, a[3] * inv); w.z = pk2(a[4] * inv, a[5] * inv); w.w = pk2(a[6] * inv, a[7] * inv);
    *(u32x4*)(mix + (size_t)tok * DM + X_MOBA + 64 * hh + 8 * ch) = w;
}
__device__ __forceinline__ void rgate_item2(int idx0, int idx1, const bf16* z, bf16* mix) {
    u32x4 g[2], v[2]; bf16* mp[2];
#pragma unroll
    for (int k = 0; k < 2; ++k) { const int idx = k ? idx1 : idx0, ch = idx & 7, th = idx >> 3, hh = 4 + (th & 1), tok = th >> 1;
        g[k] = *(const u32x4*)(z + (size_t)tok * ZP + Z_RG + 64 * hh + 8 * ch); mp[k] = mix + (size_t)tok * DM + X_RET + 64 * hh + 8 * ch; v[k] = *(const u32x4*)mp[k]; }
#pragma unroll
    for (int k = 0; k < 2; ++k) { if (k == 1 && idx1 == idx0) break; u32x4 w;
        w.x = pk2(silu1(bflo(g[k].x)) * bflo(v[k].x), silu1(bfhi(g[k].x)) * bfhi(v[k].x)); w.y = pk2(silu1(bflo(g[k].y)) * bflo(v[k].y), silu1(bfhi(g[k].y)) * bfhi(v[k].y));
        w.z = pk2(silu1(bflo(g[k].z)) * bflo(v[k].z), silu1(bfhi(g[k].z)) * bfhi(v[k].z)); w.w = pk2(silu1(bflo(g[k].w)) * bflo(v[k].w), silu1(bfhi(g[k].w)) * bfhi(v[k].w));
        *(u32x4*)mp[k] = w; }
}
#ifndef MK_PER_PHASE
#define MK_PER_PHASE 0
#endif
constexpr int N_PHASES = 1 + DEPTH * 8;
constexpr int T_KM = NBH * NCH / 8, T_KV = T_KM + NBH * NCH / 2, T_GT = T_KV + NBH * 16, T_SC = T_GT + NBH * 2, T_CV = T_SC + 256, T_G13 = T_CV + M / 256, MIXC_LIST = NBH * 76, T_MB = T_G13 + MIXC_LIST, T_RT = T_MB + NBH * NCH, MIXC_ITEMS = T_RT + NBH;

__global__ void __launch_bounds__(512, 2) fwd(Args args) {
    extern __shared__ __attribute__((aligned(16))) unsigned char lds_raw[];
    LAS unsigned char* lds = (LAS unsigned char*)lds_raw;
    volatile LAS unsigned* MISC = (volatile LAS unsigned*)(lds + MISC_OFF);
    const int tid0 = threadIdx.x, wave0 = __builtin_amdgcn_readfirstlane(tid0 >> 6);
    const int G = gridDim.x, bid = blockIdx.x, NGW = G * 8;
    unsigned char* const ws0 = args.ws;
    unsigned* ctl = (unsigned*)(ws0 + WS_CTL);
    for (int u = tid0; u < (LDS_BYTES - LDSCTL_OFF) / 4; u += 512) ((LAS unsigned*)(lds + LDSCTL_OFF))[u] = 0u;
    __syncthreads();
    XcdBarrier bar; bar.bar = ctl + CW_BAR; bar.x = 0; bar.st = nullptr;
    if (!MK_PER_PHASE) bar = xcd_barrier_post(ctl + CW_BAR, MISC + 8);
    if (tid0 == 0) __hip_atomic_store(ctl + CW_XT + bid, xb_xcc_id() + 1u, __ATOMIC_RELAXED, __HIP_MEMORY_SCOPE_AGENT);
    int lok = 0;
    const int lo = args.ph_lo, hi = args.ph_hi; int pc = 0;
#define RUN (pc >= lo && pc < hi)
#define SEAM do { ++pc; if (!MK_PER_PHASE && pc > lo && pc < hi) xcd_barrier(bar); } while (0)
#define SEAM_LOCAL do { ++pc; if (!MK_PER_PHASE && pc > lo && pc < hi) { if (lok) xcd_local_barrier(ctl + CW_LB, bar.x, 32u, ctl + CW_TMO); else xcd_barrier(bar); } } while (0)

#define ENV unsigned sd_ = 0u; asm volatile("" : "+s"(sd_)); int tid = wave0 * 64 + (int)__builtin_amdgcn_mbcnt_hi(~0u, __builtin_amdgcn_mbcnt_lo(~0u, sd_)); asm volatile("" : "+v"(tid)); const int lane = tid & 63, wave = __builtin_amdgcn_readfirstlane(tid >> 6), gw = bid * 8 + wave; (void)lane; (void)gw; \
    GAS unsigned char* wsl = (GAS unsigned char*)ws0; asm volatile("" : "+s"(wsl)); unsigned char* ws = (unsigned char*)wsl; int zi = 0; asm volatile("" : "+s"(zi)); GAS float* xresl = (GAS float*)args.out; asm volatile("" : "+s"(xresl)); float* xres = (float*)xresl; \
    bf16* XB = (bf16*)(ws + WS_XB); bf16* Z = (bf16*)(ws + WS_Z); bf16* ACT = (bf16*)(ws + WS_ACT); bf16* MIX = (bf16*)(ws + WS_MIX); \
    bf16* OP = (bf16*)(ws + WS_OP); float* LSE = (float*)(ws + WS_LSE); unsigned* SEL = (unsigned*)(ws + WS_SEL); \
    float* RT = (float*)(ws + WS_RT); float* MT = (float*)(ws + WS_MT); float* SSQ = (float*)(ws + WS_SSQ); \
    float* KV = (float*)(ws + WS_KV); bf16* PREV = (bf16*)(ws + WS_PREV); float* KM = (float*)(ws + WS_KM); \
    LAS float* scr = (LAS float*)(lds + wave * 16384); (void)scr; (void)XB; (void)Z; (void)ACT; (void)MIX; (void)OP; (void)LSE; (void)SEL; (void)RT; (void)MT; (void)SSQ; (void)KV; (void)PREV; (void)KM; (void)xres
#define INP(k) ((const float*)(GAS const float*)args.in[(k) + zi])

#define CVT_PULL_L(hd, L_, blo, bhi) do { unsigned* cvh = (unsigned*)(ws + WS_CTL) + CW_Q + 64 * (hd); \
        for (;;) { __syncthreads(); if (tid == 0) MISC[1] = __hip_atomic_fetch_add(cvh, 1u, __ATOMIC_RELAXED, __HIP_MEMORY_SCOPE_AGENT); __syncthreads(); \
            const int bt = (blo) + (int)MISC[1]; if (bt >= (bhi)) break; \
            cvt_layer_batch(args, zi, (L_), ws + WS_W + (size_t)((L_) & 1) * WBUF_BYTES, bt, lds, wave, lane); } } while (0)
#define CVT_PULL(qi, blo, bhi) do { if (l + 1 < DEPTH) CVT_PULL_L(8 + 2 * l + (qi), l + 1, blo, bhi); } while (0)

    if (RUN) { ENV; const float* x_in = INP(0);
        CVT_PULL_L(14, 0, 0, b_layer(0));
        for (int m = gw; m < M; m += 2 * NGW) {
            const int m1 = (m + NGW < M) ? m + NGW : m;
            const f32x4* xr0 = (const f32x4*)(x_in + (size_t)m * DM) + lane; const f32x4* xr1 = (const f32x4*)(x_in + (size_t)m1 * DM) + lane; f32x4 v0[4], v1[4]; float s0[4], s1[4];
#pragma unroll
            for (int j = 0; j < 4; ++j) { v0[j] = xr0[64 * j]; v1[j] = xr1[64 * j]; }
#pragma unroll
            for (int j = 0; j < 4; ++j) { s0[j] = (v0[j][0] * v0[j][0] + v0[j][1] * v0[j][1]) + (v0[j][2] * v0[j][2] + v0[j][3] * v0[j][3]); s1[j] = (v1[j][0] * v1[j][0] + v1[j][1] * v1[j][1]) + (v1[j][2] * v1[j][2] + v1[j][3] * v1[j][3]); }
            float am0 = 0.f, am1 = 0.f;
#pragma unroll
            for (int j = 0; j < 4; ++j) { am0 = fmaxf(am0, fmaxf(fmaxf(fabsf(v0[j][0]), fabsf(v0[j][1])), fmaxf(fabsf(v0[j][2]), fabsf(v0[j][3])))); am1 = fmaxf(am1, fmaxf(fmaxf(fabsf(v1[j][0]), fabsf(v1[j][1])), fmaxf(fabsf(v1[j][2]), fabsf(v1[j][3])))); }
#pragma unroll
            for (int o = 1; o < 64; o <<= 1) {
#pragma unroll
                for (int j = 0; j < 4; ++j) { s0[j] += __shfl_xor(s0[j], o); s1[j] += __shfl_xor(s1[j], o); }
                am0 = fmaxf(am0, __shfl_xor(am0, o)); am1 = fmaxf(am1, __shfl_xor(am1, o)); }
            unsigned long long* o0 = (unsigned long long*)(XB + (size_t)m * DM) + lane; unsigned long long* o1 = (unsigned long long*)(XB + (size_t)m1 * DM) + lane;
#pragma unroll
            for (int j = 0; j < 4; ++j) { o0[64 * j] = (unsigned long long)pk2(v0[j][0], v0[j][1]) | ((unsigned long long)pk2(v0[j][2], v0[j][3]) << 32); o1[64 * j] = (unsigned long long)pk2(v1[j][0], v1[j][1]) | ((unsigned long long)pk2(v1[j][2], v1[j][3]) << 32); }
            { const float iv0 = am0 > 0.f ? 127.0f / am0 : 0.f, iv1 = am1 > 0.f ? 127.0f / am1 : 0.f; unsigned* q0 = (unsigned*)(ws + WS_X8 + (size_t)m * DM) + lane; unsigned* q1 = (unsigned*)(ws + WS_X8 + (size_t)m1 * DM) + lane;
#pragma unroll
              for (int j = 0; j < 4; ++j) { q0[64 * j] = pg8::q8x4(v0[j][0], v0[j][1], v0[j][2], v0[j][3], iv0); q1[64 * j] = pg8::q8x4(v1[j][0], v1[j][1], v1[j][2], v1[j][3], iv1); } }
            if (lane == 0) { *(f32x4*)(SSQ + (size_t)m * 4) = (f32x4){s0[0], s0[1], s0[2], s0[3]}; *(f32x4*)(SSQ + (size_t)m1 * 4) = (f32x4){s1[0], s1[1], s1[2], s1[3]};
                float* RF = (float*)(ws + WS_RF); RF[m] = __builtin_amdgcn_rsqf(((s0[0] + s0[1]) + (s0[2] + s0[3])) * (1.0f / 1024.0f) + RMS_EPS) * am0 * (1.0f / 127.0f); RF[m1] = __builtin_amdgcn_rsqf(((s1[0] + s1[1]) + (s1[2] + s1[3])) * (1.0f / 1024.0f) + RMS_EPS) * am1 * (1.0f / 127.0f); } }
        const int* pos = (const int*)INP(1);
        for (int i = bid * 512 + tid; i < M * 40; i += G * 512) { const int row = i / 40, k = i - row * 40; float c, s; sincos_acc((float)pos[row] * args.invf[k], c, s);
            float* t = (k < 32) ? RT + (size_t)row * 64 + 2 * k : MT + (size_t)row * 16 + 2 * (k - 32); *(f32x2*)t = (f32x2){c, s}; }
    }
    SEAM;
    if (!MK_PER_PHASE && lo == 0 && hi > 1) {
        int ok = (G == 256);
        if (tid0 < G) { const unsigned v = __hip_atomic_load(ctl + CW_XT + tid0, __ATOMIC_RELAXED, __HIP_MEMORY_SCOPE_AGENT), r = __hip_atomic_load(ctl + CW_XT + (tid0 & 7), __ATOMIC_RELAXED, __HIP_MEMORY_SCOPE_AGENT); ok &= (v == r) && (v != 0u); }
        unsigned seen = 0u;
#pragma unroll
        for (int q = 0; q < 8; ++q) seen |= 1u << (__hip_atomic_load(ctl + CW_XT + q, __ATOMIC_RELAXED, __HIP_MEMORY_SCOPE_AGENT) & 31u);
        ok &= (__builtin_popcount(seen) == 8);
        lok = __syncthreads_and(ok);
    }

    for (int l = 0; l < DEPTH; ++l) {
        for (int hf = 0; hf < 2; ++hf) {
            if (RUN) { ENV; unsigned char* wb = ws + WS_W + (size_t)(l & 1) * WBUF_BYTES; unsigned char* wgu = wb + (hf ? WO_GU2 : WO_GU1);
                pg8::Gemm g{(const bf16*)(ws + WS_X8), (const bf16*)wgu, M, NGU, DM / 2}; pg8::StaticOrder S; S.init(M, NGU, G, bid);
                pg8::EpiGU8 E{ACT, (const LAS float*)(lds + LDSCTL_OFF + 1024), (const LAS float*)(lds + LDSCTL_OFF + 7168)};
                { LAS float* rt_ = (LAS float*)(lds + LDSCTL_OFF + 1024); LAS float* ct_ = (LAS float*)(lds + LDSCTL_OFF + 7168); const float* RF = (const float*)(ws + WS_RF); const float* SWt = (const float*)(wgu + WO_SW);
                  pg8::Unit u_; for (int i_ = 0; S.next(i_, u_); ++i_) if (tid < 256) { rt_[i_ * 256 + tid] = RF[u_.pm * 256 + tid]; ct_[i_ * 256 + tid] = SWt[u_.pn * 256 + tid]; } __syncthreads(); }
                pg8::gemm_phase<pg8::EpiGU8, pg8::StaticOrder, true, true, true>(lds, g, S, E, tid);
                if (hf == 0) CVT_PULL(0, 0, b_early(l + 1)); else CVT_PULL(1, b_early(l + 1), b_layer(l + 1)); }
            SEAM_LOCAL;
            if (RUN) { ENV; unsigned char* wb = ws + WS_W + (size_t)(l & 1) * WBUF_BYTES; pg8::Gemm g{ACT, (const bf16*)(wb + (hf ? WO_D2 : WO_D1)), M, DM, FF}; pg8::StaticOrder S; S.init(M, DM, G, bid);
                const bool q8_ = hf == 1 && l + 1 < DEPTH, fin_ = hf == 1 && l + 1 == DEPTH;
                pg8::EpiRes E{XB, SSQ, 0.5f, 2.0f, (q8_ || (hf == 0 && l >= WIN8_FROM)) ? (signed char*)(ws + WS_X8) : nullptr, (float*)(ws + WS_RF), (float*)(ws + WS_EX), (unsigned*)(ws + WS_CTL) + CW_PC + 16 * 64 * (3 * l + (hf ? 2 : 0)), (unsigned*)(ws + WS_CTL) + CW_TMO, fin_ ? xres : nullptr, INP(17)};
                pg8::gemm_phase<pg8::EpiRes, pg8::StaticOrder, false, true>(lds, g, S, E, tid); }
            SEAM_LOCAL;
            if (hf == 0) {
                if (RUN && l < WIN8_FROM) { ENV; unsigned char* wb = ws + WS_W + (size_t)(l & 1) * WBUF_BYTES; pg8::Gemm g{XB, (const bf16*)(wb + WO_IN), M, ZN1, DM}; pg8::StaticOrder S; S.init(M, ZN1, G, bid);
                    pg8::EpiWin E{Z, (const LAS float*)(lds + LDSCTL_OFF + 1024), RT, MT};
                    { LAS float* rt_ = (LAS float*)(lds + LDSCTL_OFF + 1024); pg8::Unit u_; for (int i_ = 0; S.next(i_, u_); ++i_) if (tid < 256) rt_[i_ * 256 + tid] = pg8::row_rstd(SSQ, u_.pm * 256 + tid); __syncthreads(); }
                pg8::gemm_phase<pg8::EpiWin, pg8::StaticOrder, true, true>(lds, g, S, E, tid); }
                if (RUN && l >= WIN8_FROM) { ENV; unsigned char* wb = ws + WS_W + (size_t)(l & 1) * WBUF_BYTES; pg8::Gemm g{(const bf16*)(ws + WS_X8), (const bf16*)(wb + WO_IN8), M, ZN1, DM / 2}; pg8::StaticOrder S; S.init(M, ZN1, G, bid);
                    pg8::EpiWin8 E{Z, (const LAS float*)(lds + LDSCTL_OFF + 1024), RT, MT, (const LAS float*)(lds + LDSCTL_OFF + 7168)};
                    { LAS float* rt_ = (LAS float*)(lds + LDSCTL_OFF + 1024); LAS float* ct_ = (LAS float*)(lds + LDSCTL_OFF + 7168); const float* RF = (const float*)(ws + WS_RF); const float* SWt = (const float*)(wb + WO_SWIN);
                      pg8::Unit u_; for (int i_ = 0; S.next(i_, u_); ++i_) if (tid < 256) { rt_[i_ * 256 + tid] = RF[u_.pm * 256 + tid]; ct_[i_ * 256 + tid] = SWt[u_.pn * 256 + tid]; } __syncthreads(); }
                pg8::gemm_phase<pg8::EpiWin8, pg8::StaticOrder, true, true, true>(lds, g, S, E, tid); }
                SEAM;
                if (RUN) { ENV;
                    unsigned* head = (unsigned*)(ws + WS_CTL) + CW_Q + 64 * l;
                    unsigned nxt = (unsigned)bid;
                    for (;;) {
                        __syncthreads();
                        if (tid == 0) MISC[0] = nxt;
                        __syncthreads();
                        int it = (int)MISC[0];
                        if (it >= MIXC_ITEMS) break;
                        int tq = tid; asm volatile("" : "+v"(tq)); const int lq = tq & 63;
                        if (tid == 0) nxt = (unsigned)G + __hip_atomic_fetch_add(head, 1u, __ATOMIC_RELAXED, __HIP_MEMORY_SCOPE_AGENT);
                        unsigned* hc = (unsigned*)(ws + WS_CTL) + CW_HC + 64 * 16 * 4 * l; unsigned* kmc = hc, * kvc = hc + 64 * 16, * gtc = hc + 64 * 32, * scc = hc + 64 * 48; unsigned* tmo = (unsigned*)(ws + WS_CTL) + CW_TMO;
                        if (it < T_KM) kmean_item(it, Z, KM, kmc, lds, wave, lq);
                        else if (it < T_KV) kv_item(it - T_KM, Z, KV, kvc, lds, tq, wave, lq);
                        else if (it < T_GT) gate_item(it - T_KV, Z, KM, SEL, kmc, gtc, tmo, lds, tq, lq);
                        else if (it < T_SC) scan_item(it - T_GT, KV, PREV, kvc, scc, tmo, tq, lq);
                        else if (it < T_CV) conv_item(it - T_SC, Z, MIX, INP(8) + (size_t)l * 31 * 256, INP(9) + l * 256, INP(10) + l * 256, INP(11) + l * 256, lds, tq, wave, lq);
                        else if (it < T_G13) {
                            const int pm_ = it - T_CV;
                            if (l < WIN8_FROM) {
                            unsigned char* wb = ws + WS_W + (size_t)(l & 1) * WBUF_BYTES; pg8::Gemm g{XB, (const bf16*)(wb + WO_IN), M, ZNP, DM}; pg8::OneUnit S{pm_, ZN1 / 256};
                            pg8::EpiWin E{Z, (const LAS float*)(lds + LDSCTL_OFF + 1024), RT, MT};
                            { LAS float* rt_ = (LAS float*)(lds + LDSCTL_OFF + 1024); if (tq < 256) rt_[tq] = pg8::row_rstd(SSQ, pm_ * 256 + tq); __syncthreads(); }
                            pg8::gemm_phase<pg8::EpiWin, pg8::OneUnit, false, true>(lds, g, S, E, tq); }
                            else {
                            unsigned char* wb = ws + WS_W + (size_t)(l & 1) * WBUF_BYTES; pg8::Gemm g{(const bf16*)(ws + WS_X8), (const bf16*)(wb + WO_IN8), M, ZNP, DM / 2}; pg8::OneUnit S{pm_, ZN1 / 256};
                            pg8::EpiWin8 E{Z, (const LAS float*)(lds + LDSCTL_OFF + 1024), RT, MT, (const LAS float*)(lds + LDSCTL_OFF + 7168)};
                            { LAS float* rt_ = (LAS float*)(lds + LDSCTL_OFF + 1024); LAS float* ct_ = (LAS float*)(lds + LDSCTL_OFF + 7168);
                              if (tq < 256) { rt_[tq] = ((const float*)(ws + WS_RF))[pm_ * 256 + tq]; ct_[tq] = ((const float*)(wb + WO_SWIN))[ZN1 + tq]; } __syncthreads(); }
                            pg8::gemm_phase<pg8::EpiWin8, pg8::OneUnit, false, true, true>(lds, g, S, E, tq); } }
                        else if (it >= T_MB && it < T_RT) ret_item(it - T_MB, Z, PREV, MIX, scc, tmo, lds, tq, wave, lq);
                        else { int bh, j, i0, i1; bool own;
                            if (it < T_MB) { const int rank = (it - T_G13) / NBH; bh = (it - T_G13) - rank * NBH; i0 = 1; int rem = rank;
                                while (rem >= ((i0 - 1) >> 3) + 1) { rem -= ((i0 - 1) >> 3) + 1; ++i0; }
                                j = i0 - 1 - 8 * rem; i1 = (i0 + 8 < NCH) ? i0 + 8 : NCH; own = rem == 0; }
                            else { bh = it - T_RT; j = NCH - 1; i0 = NCH; i1 = NCH; own = true; }
                            moba_item(bh, j, own, i0, i1, Z, SEL, OP, LSE, gtc, tmo, lds, tq, wave, lq); }
                    }
                }
                SEAM;
                if (RUN) { ENV; { constexpr int NCMB = M * NHM * 8; const int st_ = G * 512;
                    for (int i = bid * 512 + tid; i < NCMB; i += 3 * st_) { CombIn c0, c1, c2; const int i1 = (i + st_ < NCMB) ? i + st_ : i, i2 = (i + 2 * st_ < NCMB) ? i + 2 * st_ : i;
                        combine_load(i, OP, LSE, SEL, c0); combine_load(i1, OP, LSE, SEL, c1); combine_load(i2, OP, LSE, SEL, c2);
                        combine_store(i, c0, MIX); combine_store(i1, c1, MIX); combine_store(i2, c2, MIX); } }
                    { constexpr int NRG = M * 2 * 8; const int st_ = G * 512; for (int i = bid * 512 + tid; i < NRG; i += 2 * st_) rgate_item2(i, (i + st_ < NRG) ? i + st_ : i, Z, MIX); } }
                SEAM;
                if (RUN) { ENV; unsigned char* wb = ws + WS_W + (size_t)(l & 1) * WBUF_BYTES; pg8::Gemm g{MIX, (const bf16*)(wb + WO_OUT), M, DM, DM}; pg8::StaticOrder S; S.init(M, DM, G, bid);
                    pg8::EpiRes E{XB, SSQ, 1.0f, 1.0f, (signed char*)(ws + WS_X8), (float*)(ws + WS_RF), (float*)(ws + WS_EX), (unsigned*)(ws + WS_CTL) + CW_PC + 16 * 64 * (3 * l + 1), (unsigned*)(ws + WS_CTL) + CW_TMO, nullptr, nullptr};
                    pg8::gemm_phase<pg8::EpiRes, pg8::StaticOrder, false, true>(lds, g, S, E, tid); }
                SEAM_LOCAL;
            }
        }
    }
#undef RUN
#undef SEAM
}

extern "C" void kernel_launch(void* const* d_in, const int* in_sizes, int n_in, void* d_out, int out_size, void* d_ws, size_t ws_size, hipStream_t stream) {
    static int grid = 0;
    if (grid == 0) {
        if (n_in != 18 || in_sizes[0] != M * DM || out_size != M * DM || ws_size < WS_END) { fprintf(stderr, "kernel_launch: unexpected problem shape (n_in %d, in0 %d, out %d, ws %zu); nothing launched\n", n_in, n_in > 0 ? in_sizes[0] : -1, out_size, ws_size); grid = -1; return; }
        int dev = 0, cus = 0, per_cu = 0;
        if (hipGetDevice(&dev) != hipSuccess || hipDeviceGetAttribute(&cus, hipDeviceAttributeMultiprocessorCount, dev) != hipSuccess) { grid = -1; return; }
        if (hipFuncSetAttribute((const void*)fwd, hipFuncAttributeMaxDynamicSharedMemorySize, LDS_BYTES) != hipSuccess) { fprintf(stderr, "kernel_launch: hipFuncSetAttribute failed\n"); grid = -1; return; }
        if (hipOccupancyMaxActiveBlocksPerMultiprocessor(&per_cu, (const void*)fwd, 512, LDS_BYTES) != hipSuccess || per_cu < 1) { fprintf(stderr, "kernel_launch: occupancy query reports %d blocks per CU\n", per_cu); }
        (void)hipGetLastError();
        grid = cus;
        if (grid != 256) fprintf(stderr, "kernel_launch: %d CUs; the N = 1024 GEMM phases assume a 256-workgroup grid\n", grid);
        if (grid > 256) grid = 256;
    }
    if (grid < 0) return;
    if (hipMemsetAsync((char*)d_ws + WS_CTL, 0, CTL_BYTES, stream) != hipSuccess) return;
    Args a{};
    for (int i = 0; i < 18; ++i) a.in[i] = (const float*)d_in[i];
    a.out = (float*)d_out; a.ws = (unsigned char*)d_ws;
    for (int i = 0; i < 32; ++i) { const float t = (float)i / 31.0f; a.invf[i] = (float)pow(10000.0, -(double)t); }
    for (int i = 0; i < 8; ++i) { const float t = (float)i / 8.0f; a.invf[32 + i] = (float)pow(500000.0, -(double)t); }
#if MK_PER_PHASE
    for (int p = 0; p < N_PHASES; ++p) { a.ph_lo = p; a.ph_hi = p + 1; hipLaunchKernelGGL(fwd, dim3(grid), dim3(512), LDS_BYTES, stream, a); }
#else
    a.ph_lo = 0; a.ph_hi = N_PHASES;
    hipLaunchKernelGGL(fwd, dim3(grid), dim3(512), LDS_BYTES, stream, a);
#endif
}
```

```cpp
#include <hip/hip_runtime.h>
#include <cstdio>
#include <cstdint>
#include <cmath>

constexpr int BATCH = 2, SEQ = 8192, DM = 1024, DEPTH = 4, HD = 64, NHM = 6;
constexpr int M = BATCH * SEQ, FF = 2816, NGU = 2 * FF, ZN = 3200, ZNP = 3328, ZP = ZNP, NCH = SEQ / 256, NBH = BATCH * NHM;
constexpr float RMS_EPS = 1e-6f;
constexpr float C2 = 0.125f * 1.4426950408889634f;
constexpr int Z_RQ = 0, Z_RK = 384, Z_MQ = 768, Z_MK = 1152, Z_RV = 1536, Z_MV = 1920, Z_CA = 2304, Z_CG = 2560, Z_RG = 2816;
constexpr int ZN1 = 3072;
constexpr int X_RET = 0, X_MOBA = 384, X_CONV = 768;

namespace pg8 {
#define PG8_LAS __attribute__((address_space(3)))
typedef unsigned short bf16_t;
typedef short bf16x8 __attribute__((ext_vector_type(8)));
typedef float f32x4 __attribute__((ext_vector_type(4)));
typedef unsigned u32x4 __attribute__((ext_vector_type(4)));
constexpr int BM = 256, BK = 64, HALF = 128, HTB = HALF * BK * 2  , STAGE_BYTES = 8 * HTB, NXCD = 8, WGM = 8;

__host__ __device__ __forceinline__ int lds_byte(int r, int c) { const int st = (r >> 4) * 2 + (c >> 5), rr = r & 15, cc = c & 31, ob = rr * 64 + cc * 2; return st * 1024 + (ob ^ (((ob >> 9) & 1) << 5)); }
__host__ __device__ __forceinline__ void stage_rc(int b, int& R, int& C) { const int st = b / 1024, sb = b % 1024, swz = sb ^ (((sb >> 9) & 1) << 5); R = (st >> 1) * 16 + swz / 64; C = (st & 1) * 32 + (swz % 64) / 2; }
__host__ __device__ __forceinline__ int perm32(int rho) { const int n = rho >> 4, i = rho & 15; return 8 * (i >> 2) + 4 * n + (i & 3); }

struct Unit { int pm, pn, ord; };
struct Gemm { const bf16_t* A; const bf16_t* Bt; int M, N, K; };

struct StaticOrder {
    int nM, nN, nwg, G, c;
    __host__ __device__ __forceinline__ void init(int M, int N, int G_, int c_) { nM = M / BM; nN = N / BM; nwg = nM * nN; G = G_; c = c_; }
    __host__ __device__ __forceinline__ bool next(int i, Unit& u) const {
        const long L = (long)i * G + c; if (L >= nwg) return false;
        int wgid = (int)L; { const int q = nwg / NXCD, r = nwg % NXCD, xcd = wgid % NXCD, off = wgid / NXCD; wgid = (xcd < r ? xcd * (q + 1) : r * (q + 1) + (xcd - r) * q) + off; }
        const int nig = WGM * nN, gid = wgid / nig, fm = gid * WGM, gsz = (nM - fm) < WGM ? (nM - fm) : WGM;
        u.pm = fm + ((wgid % nig) % gsz); u.pn = (wgid % nig) / gsz; u.ord = i; return true;
    }
    __device__ __forceinline__ void a_ready(const Unit&) const {}
    __device__ __forceinline__ void done(const Unit&) const {}
};

struct OneUnit { int pm, pn;
    __device__ __forceinline__ bool next(int i, Unit& u) const { if (i) return false; u.pm = pm; u.pn = pn; u.ord = 0; return true; }
    __device__ __forceinline__ void a_ready(const Unit&) const {}
    __device__ __forceinline__ void done(const Unit&) const {} };
__device__ __forceinline__ unsigned cvt_pk_bf16(float lo, float hi) { unsigned r; asm volatile("v_cvt_pk_bf16_f32 %0, %1, %2" : "=v"(r) : "v"(lo), "v"(hi)); return r; }
typedef float f32x2 __attribute__((ext_vector_type(2)));
typedef unsigned u32x2 __attribute__((ext_vector_type(2)));
typedef __bf16 bf16x2v __attribute__((ext_vector_type(2)));
__device__ __forceinline__ unsigned pkb(float lo, float hi) { const f32x2 v = {lo, hi}; const bf16x2v b = __builtin_convertvector(v, bf16x2v); return __builtin_bit_cast(unsigned, b); }
__device__ __forceinline__ float silu_f(float x) { return x * __builtin_amdgcn_rcpf(1.0f + __builtin_amdgcn_exp2f(-1.4426950408889634f * x)); }
__device__ __forceinline__ float row_rstd(const float* ssq, int row) { const f32x4 s = *(const f32x4*)(ssq + (size_t)row * 4); return __builtin_amdgcn_rsqf(((s[0] + s[1]) + (s[2] + s[3])) * (1.0f / 1024.0f) + RMS_EPS); }
struct EpiGU {
    static constexpr bool PERM = true, AFTER_DRAIN = false;
    bf16_t* act; const PG8_LAS float* rstab;
    __device__ __forceinline__ void operator()(const f32x4 (&acc)[2][2][4][2], const Unit& u, int wr, int wc, int fr, int fq) const {
        const int row0 = u.pm * BM + wr * 64 + fr, col0 = u.pn * HALF + wc * 32 + 8 * fq; const PG8_LAS float* T = rstab + u.ord * 256 + wr * 64 + fr;
#pragma unroll
        for (int ai = 0; ai < 2; ++ai)
#pragma unroll
            for (int m = 0; m < 4; ++m) { const int row = row0 + ai * HALF + m * 16; const float rs = T[ai * HALF + m * 16];
                const f32x4 g0 = acc[ai][0][m][0] * rs, g1 = acc[ai][0][m][1] * rs, u0 = acc[ai][1][m][0] * rs, u1 = acc[ai][1][m][1] * rs;
                u32x4 w; w.x = pkb(silu_f(g0[0]) * u0[0], silu_f(g0[1]) * u0[1]); w.y = pkb(silu_f(g0[2]) * u0[2], silu_f(g0[3]) * u0[3]);
                w.z = pkb(silu_f(g1[0]) * u1[0], silu_f(g1[1]) * u1[1]); w.w = pkb(silu_f(g1[2]) * u1[2], silu_f(g1[3]) * u1[3]);
                *(u32x4*)(act + (size_t)row * FF + col0) = w; }
    }
};
typedef int i32x4e __attribute__((ext_vector_type(4)));
__device__ __forceinline__ f32x4 cvt_i4(const f32x4 a) { const i32x4e v = __builtin_bit_cast(i32x4e, a); return __builtin_convertvector(v, f32x4); }
struct EpiGU8 {
    static constexpr bool PERM = true, AFTER_DRAIN = false;
    bf16_t* act; const PG8_LAS float* rstab; const PG8_LAS float* ctab;
    __device__ __forceinline__ void operator()(const f32x4 (&acc)[2][2][4][2], const Unit& u, int wr, int wc, int fr, int fq) const {
        const int row0 = u.pm * BM + wr * 64 + fr, col0 = u.pn * HALF + wc * 32 + 8 * fq; const PG8_LAS float* T = rstab + u.ord * 256 + wr * 64 + fr;
        const PG8_LAS float* C = ctab + u.ord * 256 + wc * 32 + 8 * fq;
        const f32x4 sg0 = *(const PG8_LAS f32x4*)C, sg1 = *(const PG8_LAS f32x4*)(C + 4), su0 = *(const PG8_LAS f32x4*)(C + HALF), su1 = *(const PG8_LAS f32x4*)(C + HALF + 4);
#pragma unroll
        for (int ai = 0; ai < 2; ++ai)
#pragma unroll
            for (int m = 0; m < 4; ++m) { const int row = row0 + ai * HALF + m * 16; const float rs = T[ai * HALF + m * 16];
                const f32x4 g0 = cvt_i4(acc[ai][0][m][0]) * (sg0 * rs), g1 = cvt_i4(acc[ai][0][m][1]) * (sg1 * rs), u0 = cvt_i4(acc[ai][1][m][0]) * (su0 * rs), u1 = cvt_i4(acc[ai][1][m][1]) * (su1 * rs);
                u32x4 w; w.x = pkb(silu_f(g0[0]) * u0[0], silu_f(g0[1]) * u0[1]); w.y = pkb(silu_f(g0[2]) * u0[2], silu_f(g0[3]) * u0[3]);
                w.z = pkb(silu_f(g1[0]) * u1[0], silu_f(g1[1]) * u1[1]); w.w = pkb(silu_f(g1[2]) * u1[2], silu_f(g1[3]) * u1[3]);
                *(u32x4*)(act + (size_t)row * FF + col0) = w; }
    }
};
struct EpiWin {
    static constexpr bool PERM = true, AFTER_DRAIN = false;
    bf16_t* z; const PG8_LAS float* rstab; const float* RT; const float* MT;
    __device__ __forceinline__ void operator()(const f32x4 (&acc)[2][2][4][2], const Unit& u, int wr, int wc, int fr, int fq) const {
        const int row0 = u.pm * BM + wr * 64 + fr; const PG8_LAS float* T = rstab + u.ord * 256 + wr * 64 + fr;
        const int hc = (wc * 32 + 8 * fq) & 63;
        const bool rot_tile = u.pn < 6, use = (u.pn < 3) || (hc < 16);
        const float* tbase = (u.pn < 3) ? RT + hc : MT + (hc & 8); const int tpitch = (u.pn < 3) ? 64 : 16;
#pragma unroll
        for (int ai = 0; ai < 2; ++ai) {
            f32x4 t0[4], t1[4];
#pragma unroll
            for (int m = 0; m < 4; ++m) { t0[m] = (f32x4){1.f, 0.f, 1.f, 0.f}; t1[m] = t0[m]; }
            if (rot_tile) {
#pragma unroll
                for (int m = 0; m < 4; ++m) { const float* tb = tbase + (size_t)(row0 + ai * HALF + m * 16) * tpitch; t0[m] = *(const f32x4*)tb; t1[m] = *(const f32x4*)(tb + 4); }
#pragma unroll
                for (int m = 0; m < 4; ++m) { asm volatile("" : "+v"(t0[m]), "+v"(t1[m]));
                    t0[m] = use ? t0[m] : (f32x4){1.f, 0.f, 1.f, 0.f}; t1[m] = use ? t1[m] : (f32x4){1.f, 0.f, 1.f, 0.f}; } }
#pragma unroll
            for (int m = 0; m < 4; ++m) { const int row = row0 + ai * HALF + m * 16; const float rs = T[ai * HALF + m * 16];
#pragma unroll
                for (int bj = 0; bj < 2; ++bj) { const int colb = (2 * u.pn + bj) * HALF + wc * 32 + 8 * fq;
                    const f32x4 a = acc[ai][bj][m][0] * rs, b = acc[ai][bj][m][1] * rs; const f32x4 c0 = t0[m], c1 = t1[m]; f32x4 v0, v1;
                    v0[0] = a[0] * c0[0] - a[1] * c0[1]; v0[1] = a[1] * c0[0] + a[0] * c0[1]; v0[2] = a[2] * c0[2] - a[3] * c0[3]; v0[3] = a[3] * c0[2] + a[2] * c0[3];
                    v1[0] = b[0] * c1[0] - b[1] * c1[1]; v1[1] = b[1] * c1[0] + b[0] * c1[1]; v1[2] = b[2] * c1[2] - b[3] * c1[3]; v1[3] = b[3] * c1[2] + b[2] * c1[3];
                    u32x4 w; w.x = pkb(v0[0], v0[1]); w.y = pkb(v0[2], v0[3]); w.z = pkb(v1[0], v1[1]); w.w = pkb(v1[2], v1[3]);
                    *(u32x4*)(z + (size_t)row * ZP + colb) = w; } } }
    }
};
struct EpiWin8 {
    static constexpr bool PERM = true, AFTER_DRAIN = false;
    bf16_t* z; const PG8_LAS float* rstab; const float* RT; const float* MT; const PG8_LAS float* ctab;
    __device__ __forceinline__ void operator()(const f32x4 (&acc)[2][2][4][2], const Unit& u, int wr, int wc, int fr, int fq) const {
        const int row0 = u.pm * BM + wr * 64 + fr; const PG8_LAS float* T = rstab + u.ord * 256 + wr * 64 + fr;
        const int hc = (wc * 32 + 8 * fq) & 63;
        const bool rot_tile = u.pn < 6, use = (u.pn < 3) || (hc < 16);
        const float* tbase = (u.pn < 3) ? RT + hc : MT + (hc & 8); const int tpitch = (u.pn < 3) ? 64 : 16;
#pragma unroll
        for (int ai = 0; ai < 2; ++ai) {
            f32x4 t0[4], t1[4];
#pragma unroll
            for (int m = 0; m < 4; ++m) { t0[m] = (f32x4){1.f, 0.f, 1.f, 0.f}; t1[m] = t0[m]; }
            if (rot_tile) {
#pragma unroll
                for (int m = 0; m < 4; ++m) { const float* tb = tbase + (size_t)(row0 + ai * HALF + m * 16) * tpitch; t0[m] = *(const f32x4*)tb; t1[m] = *(const f32x4*)(tb + 4); }
#pragma unroll
                for (int m = 0; m < 4; ++m) { asm volatile("" : "+v"(t0[m]), "+v"(t1[m]));
                    t0[m] = use ? t0[m] : (f32x4){1.f, 0.f, 1.f, 0.f}; t1[m] = use ? t1[m] : (f32x4){1.f, 0.f, 1.f, 0.f}; } }
#pragma unroll
            for (int m = 0; m < 4; ++m) { const int row = row0 + ai * HALF + m * 16; const float rs = T[ai * HALF + m * 16];
#pragma unroll
                for (int bj = 0; bj < 2; ++bj) { const int colb = (2 * u.pn + bj) * HALF + wc * 32 + 8 * fq; const PG8_LAS float* C = ctab + u.ord * 256 + bj * HALF + wc * 32 + 8 * fq;
                    const f32x4 a = cvt_i4(acc[ai][bj][m][0]) * (*(const PG8_LAS f32x4*)C * rs), b = cvt_i4(acc[ai][bj][m][1]) * (*(const PG8_LAS f32x4*)(C + 4) * rs); const f32x4 c0 = t0[m], c1 = t1[m]; f32x4 v0, v1;
                    v0[0] = a[0] * c0[0] - a[1] * c0[1]; v0[1] = a[1] * c0[0] + a[0] * c0[1]; v0[2] = a[2] * c0[2] - a[3] * c0[3]; v0[3] = a[3] * c0[2] + a[2] * c0[3];
                    v1[0] = b[0] * c1[0] - b[1] * c1[1]; v1[1] = b[1] * c1[0] + b[0] * c1[1]; v1[2] = b[2] * c1[2] - b[3] * c1[3]; v1[3] = b[3] * c1[2] + b[2] * c1[3];
                    u32x4 w; w.x = pkb(v0[0], v0[1]); w.y = pkb(v0[2], v0[3]); w.z = pkb(v1[0], v1[1]); w.w = pkb(v1[2], v1[3]);
                    *(u32x4*)(z + (size_t)row * ZP + colb) = w; } } }
    }
};
__device__ __forceinline__ unsigned q8x4(float a, float b, float c, float d, float inv) {
    const float M_ = 12582912.0f; const unsigned ya = __float_as_uint(__builtin_fmaf(a, inv, M_)), yb = __float_as_uint(__builtin_fmaf(b, inv, M_)), yc = __float_as_uint(__builtin_fmaf(c, inv, M_)), yd = __float_as_uint(__builtin_fmaf(d, inv, M_));
    return __builtin_amdgcn_perm(yb, ya, 0x0c0c0400u) | __builtin_amdgcn_perm(yd, yc, 0x04000c0cu);
}
struct EpiRes {
    static constexpr bool PERM = true, AFTER_DRAIN = true;
    bf16_t* xb; float* ssq; float alpha, ralpha;
    signed char* x8; float* rf; float* ex; unsigned* pctr; unsigned* tmo; float* fout; const float* fgain;
    __device__ __forceinline__ void init(f32x4 (&acc)[2][2][4][2], const Unit& u, int wr, int wc, int fr, int fq) const {
        const int col0 = u.pn * BM + wc * 32 + 8 * fq;
#pragma unroll
        for (int ai = 0; ai < 2; ++ai)
#pragma unroll
            for (int m = 0; m < 4; ++m)
#pragma unroll
                for (int bj = 0; bj < 2; ++bj) { const u32x4 x4 = *(const u32x4*)(xb + (size_t)(u.pm * BM + ai * HALF + wr * 64 + m * 16 + fr) * DM + col0 + bj * HALF);
                    acc[ai][bj][m][0] = (f32x4){__uint_as_float(x4.x << 16), __uint_as_float(x4.x & 0xffff0000u), __uint_as_float(x4.y << 16), __uint_as_float(x4.y & 0xffff0000u)} * ralpha;
                    acc[ai][bj][m][1] = (f32x4){__uint_as_float(x4.z << 16), __uint_as_float(x4.z & 0xffff0000u), __uint_as_float(x4.w << 16), __uint_as_float(x4.w & 0xffff0000u)} * ralpha; }
    }
    __device__ __forceinline__ void fused(f32x4 (&acc)[2][2][4][2], const Unit& u, int wr, int wc, int fr, int fq, PG8_LAS unsigned char* lds, int wid, int lane) const {
        PG8_LAS float* P = (PG8_LAS float*)lds;
        PG8_LAS float* Q = P + 1024; PG8_LAS float* IV = P + 2048;
        const bool fin = fout != nullptr, q8 = x8 != nullptr || fin; unsigned* const pc = pctr + 16 * u.pm;
        const int col0 = u.pn * BM + wc * 32 + 8 * fq;
#pragma unroll
        for (int ai = 0; ai < 2; ++ai)
#pragma unroll
            for (int m = 0; m < 4; ++m) { const int r = ai * HALF + wr * 64 + m * 16 + fr; bf16_t* xp = xb + (size_t)(u.pm * BM + r) * DM + col0; float ss = 0.f, am = 0.f;
#pragma unroll
                for (int bj = 0; bj < 2; ++bj) { const f32x4 a0 = acc[ai][bj][m][0] * alpha, a1 = acc[ai][bj][m][1] * alpha;
                    ss += ((a0[0] * a0[0] + a0[1] * a0[1]) + (a0[2] * a0[2] + a0[3] * a0[3])) + ((a1[0] * a1[0] + a1[1] * a1[1]) + (a1[2] * a1[2] + a1[3] * a1[3]));
                    am = fmaxf(am, fmaxf(fmaxf(fmaxf(fabsf(a0[0]), fabsf(a0[1])), fmaxf(fabsf(a0[2]), fabsf(a0[3]))), fmaxf(fmaxf(fabsf(a1[0]), fabsf(a1[1])), fmaxf(fabsf(a1[2]), fabsf(a1[3])))));
                    u32x4 w; w.x = pkb(a0[0], a0[1]); w.y = pkb(a0[2], a0[3]); w.z = pkb(a1[0], a1[1]); w.w = pkb(a1[2], a1[3]); if (!fin) *(u32x4*)(xp + bj * HALF) = w; }
                ss += __shfl_xor(ss, 16); ss += __shfl_xor(ss, 32); am = fmaxf(am, __shfl_xor(am, 16)); am = fmaxf(am, __shfl_xor(am, 32));
                if (fq == 0) { P[r * 4 + wc] = ss; Q[r * 4 + wc] = am; } }
        __syncthreads();
        const int tid = wid * 64 + lane;
        if (tid < 256) { const f32x4 p = *(const PG8_LAS f32x4*)(P + tid * 4); const float ts = (p[0] + p[1]) + (p[2] + p[3]); ssq[(size_t)(u.pm * BM + tid) * 4 + u.pn] = ts;
            if (q8) { const f32x4 q = *(const PG8_LAS f32x4*)(Q + tid * 4); float* e = ex + ((size_t)(u.pm * BM + tid) * 4 + u.pn) * 2;
                __hip_atomic_store(e, ts, __ATOMIC_RELAXED, __HIP_MEMORY_SCOPE_AGENT); __hip_atomic_store(e + 1, fmaxf(fmaxf(q[0], q[1]), fmaxf(q[2], q[3])), __ATOMIC_RELAXED, __HIP_MEMORY_SCOPE_AGENT); } }
        if (q8) {
            if (wid < 4) { asm volatile("s_waitcnt vmcnt(0)" ::: "memory"); if (lane == 0) __hip_atomic_fetch_add(pc, 1u, __ATOMIC_RELAXED, __HIP_MEMORY_SCOPE_AGENT); }
            if (tid == 0) { unsigned sp = 0u; while (__hip_atomic_load(pc, __ATOMIC_RELAXED, __HIP_MEMORY_SCOPE_AGENT) < 16u) { __builtin_amdgcn_s_sleep(1); if (++sp > (1u << 22)) { __hip_atomic_store(tmo, 1u, __ATOMIC_RELAXED, __HIP_MEMORY_SCOPE_AGENT); break; } } }
            __syncthreads();
            if (tid < 256) { const float* e = ex + (size_t)(u.pm * BM + tid) * 8; float s4 = 0.f, a4 = 0.f;
#pragma unroll
                for (int k = 0; k < 4; ++k) { s4 += __hip_atomic_load(e + 2 * k, __ATOMIC_RELAXED, __HIP_MEMORY_SCOPE_AGENT); a4 = fmaxf(a4, __hip_atomic_load(e + 2 * k + 1, __ATOMIC_RELAXED, __HIP_MEMORY_SCOPE_AGENT)); }
                IV[tid] = fin ? __builtin_amdgcn_rsqf(s4 * (1.0f / 1024.0f) + RMS_EPS) : (a4 > 0.f ? 127.0f / a4 : 0.f);
                if (u.pn == 0 && !fin) rf[u.pm * BM + tid] = __builtin_amdgcn_rsqf(s4 * (1.0f / 1024.0f) + RMS_EPS) * a4 * (1.0f / 127.0f); }
            __syncthreads();
            if (fin) {
                f32x4 gn[2][2];
#pragma unroll
                for (int bj = 0; bj < 2; ++bj) { gn[bj][0] = *(const f32x4*)(fgain + col0 + bj * HALF); gn[bj][1] = *(const f32x4*)(fgain + col0 + bj * HALF + 4); }
#pragma unroll
                for (int ai = 0; ai < 2; ++ai)
#pragma unroll
                    for (int m = 0; m < 4; ++m) { const int r = ai * HALF + wr * 64 + m * 16 + fr; const float rs = IV[r] * alpha; float* op = fout + (size_t)(u.pm * BM + r) * DM + col0;
#pragma unroll
                        for (int bj = 0; bj < 2; ++bj) { *(f32x4*)(op + bj * HALF) = acc[ai][bj][m][0] * rs * gn[bj][0]; *(f32x4*)(op + bj * HALF + 4) = acc[ai][bj][m][1] * rs * gn[bj][1]; } }
                return; }
#pragma unroll
            for (int ai = 0; ai < 2; ++ai)
#pragma unroll
                for (int m = 0; m < 4; ++m) { const int r = ai * HALF + wr * 64 + m * 16 + fr; const float inv = IV[r] * alpha; signed char* qp = x8 + (size_t)(u.pm * BM + r) * DM + col0;
#pragma unroll
                    for (int bj = 0; bj < 2; ++bj) { const f32x4 a0 = acc[ai][bj][m][0], a1 = acc[ai][bj][m][1]; u32x2 w; w.x = q8x4(a0[0], a0[1], a0[2], a0[3], inv); w.y = q8x4(a1[0], a1[1], a1[2], a1[3], inv); *(u32x2*)(qp + bj * HALF) = w; } }
        }
    }
};

typedef int i32x4 __attribute__((ext_vector_type(4)));
template <bool I8> __device__ __forceinline__ f32x4 mma16(const bf16x8 a, const bf16x8 b, const f32x4 c) {
    if constexpr (I8) return __builtin_bit_cast(f32x4, __builtin_amdgcn_mfma_i32_16x16x64_i8(__builtin_bit_cast(i32x4, a), __builtin_bit_cast(i32x4, b), __builtin_bit_cast(i32x4, c), 0, 0, 0));
    else return __builtin_amdgcn_mfma_f32_16x16x32_bf16(a, b, c, 0, 0, 0);
}
template <class Epi, class Sched, bool ALIGN_EPI = false, bool SP2 = false, bool I8 = false>
__device__ __forceinline__ void gemm_phase(PG8_LAS unsigned char* lds, const Gemm g, const Sched& S, const Epi& E, const int tid) {
    const int wid = __builtin_amdgcn_readfirstlane(tid >> 6), lane = tid & 63, wr = wid >> 2, wc = wid & 3, fr = lane & 15, fq = lane >> 4;
    const int K = g.K, nt = K / BK;
    unsigned voffA[2], voffB[2];
#pragma unroll
    for (int i = 0; i < 2; ++i) { int R, C; stage_rc(tid * 16 + i * 8192, R, C); const int Rb = Epi::PERM ? ((R & ~31) + perm32(R & 31)) : R;
        voffA[i] = (unsigned)(R * K + C) * 2u; voffB[i] = (unsigned)(Rb * K + C) * 2u; }
    const size_t kstep = (size_t)(BK * 2);
    const size_t hstep = (size_t)HALF * K * 2;
    const size_t tstep = 2 * hstep;
    const unsigned ldsw = (unsigned)wid * 1024u;
    const int aoff = lds_byte(wr * 64 + fr, fq * 8), boff = lds_byte(wc * 32 + fr, fq * 8);
#define PG8_SA(b, h) (((b) * 2 + (h)) * HTB)
#define PG8_SB(b, h) ((4 + (b) * 2 + (h)) * HTB)
#define PG8_STAGE(bufoff, gbase, voff) do { _Pragma("unroll") for (int _i = 0; _i < 2; ++_i) \
        __builtin_amdgcn_global_load_lds((const unsigned*)((const char*)(gbase) + (voff)[_i]), (PG8_LAS unsigned*)(lds + (bufoff) + ldsw + _i * 8192), 16, 0, 0); } while (0)
#define PG8_LDA(dst, b, h) do { _Pragma("unroll") for (int m = 0; m < 4; ++m) _Pragma("unroll") for (int k = 0; k < 2; ++k) dst[m][k] = *(const PG8_LAS bf16x8*)(lds + PG8_SA(b, h) + aoff + m * 2048 + k * 1024); } while (0)
#define PG8_LDB(dst, b, h) do { _Pragma("unroll") for (int n = 0; n < 2; ++n) _Pragma("unroll") for (int k = 0; k < 2; ++k) dst[n][k] = *(const PG8_LAS bf16x8*)(lds + PG8_SB(b, h) + boff + n * 2048 + k * 1024); } while (0)
#define PG8_MMA(ai, bj, At, Bt) do { __builtin_amdgcn_s_setprio(1); _Pragma("unroll") for (int m = 0; m < 4; ++m) _Pragma("unroll") for (int n = 0; n < 2; ++n) _Pragma("unroll") for (int k = 0; k < 2; ++k) \
        acc[ai][bj][m][n] = mma16<I8>(Bt[n][k], At[m][k], acc[ai][bj][m][n]); __builtin_amdgcn_s_setprio(0); } while (0)
#define PG8_WAIT_V(n) asm volatile("s_waitcnt vmcnt(" #n ")" ::: "memory")
#define PG8_WAIT_L(n) asm volatile("s_waitcnt lgkmcnt(" #n ")" ::: "memory")
#define PG8_BAR __builtin_amdgcn_s_barrier()
#define PG8_SCHED __builtin_amdgcn_sched_barrier(0)
    Unit cur, nxt; int ui = 0;
    if (!S.next(0, cur)) return;
    f32x4 acc[2][2][4][2];
    if constexpr (Epi::AFTER_DRAIN) E.init(acc, cur, wr, wc, fr, fq);
    else {
#pragma unroll
    for (int a = 0; a < 2; ++a)
#pragma unroll
        for (int b = 0; b < 2; ++b)
#pragma unroll
            for (int m = 0; m < 4; ++m)
#pragma unroll
                for (int n = 0; n < 2; ++n) acc[a][b][m][n] = (f32x4){0.f, 0.f, 0.f, 0.f};
    }
    bf16x8 At[4][2], B0[2][2], B1[2][2];
    const char* cA = (const char*)g.A + (size_t)cur.pm * tstep; const char* cB = (const char*)g.Bt + (size_t)cur.pn * tstep;
    S.a_ready(cur);
    if constexpr (SP2) {
        PG8_STAGE(PG8_SB(0, 0), cB, voffB); PG8_STAGE(PG8_SB(0, 1), cB + hstep, voffB); PG8_STAGE(PG8_SA(0, 0), cA, voffA); PG8_STAGE(PG8_SA(0, 1), cA + hstep, voffA);
        if (wr == 1) PG8_BAR;
        PG8_WAIT_V(2); PG8_BAR;
        PG8_STAGE(PG8_SB(1, 0), cB + kstep, voffB); PG8_STAGE(PG8_SA(1, 0), cA + kstep, voffA); PG8_STAGE(PG8_SB(1, 1), cB + hstep + kstep, voffB);
        PG8_WAIT_V(6); PG8_BAR;
    } else {
        PG8_STAGE(PG8_SB(0, 0), cB, voffB); PG8_STAGE(PG8_SA(0, 0), cA, voffA); PG8_STAGE(PG8_SB(0, 1), cB + hstep, voffB); PG8_STAGE(PG8_SA(0, 1), cA + hstep, voffA);
        if (wr == 1) PG8_BAR;
        PG8_WAIT_V(4); PG8_BAR;
        PG8_STAGE(PG8_SB(1, 0), cB + kstep, voffB); PG8_STAGE(PG8_SA(1, 0), cA + kstep, voffA); PG8_STAGE(PG8_SB(1, 1), cB + hstep + kstep, voffB);
        PG8_WAIT_V(6); PG8_BAR;
    }
    for (;;) {
        const bool has_next = S.next(ui + 1, nxt);
        const char* nA = has_next ? (const char*)g.A + (size_t)nxt.pm * tstep : cA; const char* nB = has_next ? (const char*)g.Bt + (size_t)nxt.pn * tstep : cB;
        for (int t = 0; t < nt; t += 2) {
            const bool last = (t == nt - 2);
            const char* a1 = cA + (size_t)(t + 1) * kstep;
            const char* a2 = last ? nA : cA + (size_t)(t + 2) * kstep; const char* b2 = last ? nB : cB + (size_t)(t + 2) * kstep;
            const char* a3 = a2 + kstep; const char* b3 = b2 + kstep;
            if (last && has_next) S.a_ready(nxt);
            if constexpr (SP2) {
            PG8_LDB(B0, 0, 0); PG8_LDB(B1, 0, 1); PG8_SCHED; PG8_LDA(At, 0, 0); PG8_STAGE(PG8_SA(1, 1), a1 + hstep, voffA);
            PG8_WAIT_V(8); PG8_WAIT_L(0); PG8_BAR; PG8_MMA(0, 0, At, B0); PG8_MMA(0, 1, At, B1); PG8_BAR; PG8_SCHED;
            PG8_LDA(At, 0, 1); PG8_STAGE(PG8_SB(0, 0), b2, voffB); PG8_STAGE(PG8_SB(0, 1), b2 + hstep, voffB); PG8_STAGE(PG8_SA(0, 0), a2, voffA);
            PG8_WAIT_V(8); PG8_WAIT_L(0); PG8_BAR; PG8_MMA(1, 0, At, B0); PG8_MMA(1, 1, At, B1); PG8_BAR; PG8_SCHED;
            PG8_LDB(B0, 1, 0); PG8_LDB(B1, 1, 1); PG8_SCHED; PG8_LDA(At, 1, 0); PG8_STAGE(PG8_SA(0, 1), a2 + hstep, voffA);
            PG8_WAIT_V(8); PG8_WAIT_L(0); PG8_BAR; PG8_MMA(0, 0, At, B0); PG8_MMA(0, 1, At, B1); PG8_BAR; PG8_SCHED;
            PG8_LDA(At, 1, 1); PG8_STAGE(PG8_SB(1, 0), b3, voffB); PG8_STAGE(PG8_SB(1, 1), b3 + hstep, voffB); PG8_STAGE(PG8_SA(1, 0), a3, voffA);
            PG8_WAIT_V(8); PG8_WAIT_L(0); PG8_BAR; PG8_MMA(1, 0, At, B0); PG8_MMA(1, 1, At, B1); PG8_BAR; PG8_SCHED;
            } else {
            PG8_LDB(B0, 0, 0); PG8_SCHED; PG8_LDA(At, 0, 0); PG8_STAGE(PG8_SA(1, 1), a1 + hstep, voffA);
            PG8_WAIT_L(8); PG8_BAR; PG8_WAIT_L(0); PG8_MMA(0, 0, At, B0); PG8_BAR; PG8_SCHED;
            PG8_LDB(B1, 0, 1); PG8_STAGE(PG8_SB(0, 0), b2, voffB);
            PG8_BAR; PG8_WAIT_L(0); PG8_MMA(0, 1, At, B1); PG8_BAR;
            PG8_LDA(At, 0, 1); PG8_STAGE(PG8_SA(0, 0), a2, voffA);
            PG8_BAR; PG8_WAIT_L(0); PG8_MMA(1, 0, At, B0); PG8_BAR; PG8_SCHED;
            PG8_STAGE(PG8_SB(0, 1), b2 + hstep, voffB);
            PG8_WAIT_V(6); PG8_BAR; PG8_MMA(1, 1, At, B1); PG8_BAR;
            PG8_LDB(B0, 1, 0); PG8_SCHED; PG8_LDA(At, 1, 0); PG8_STAGE(PG8_SA(0, 1), a2 + hstep, voffA);
            PG8_WAIT_L(8); PG8_BAR; PG8_WAIT_L(0); PG8_MMA(0, 0, At, B0); PG8_BAR; PG8_SCHED;
            PG8_LDB(B1, 1, 1); PG8_STAGE(PG8_SB(1, 0), b3, voffB);
            PG8_BAR; PG8_WAIT_L(0); PG8_MMA(0, 1, At, B1); PG8_BAR;
            PG8_LDA(At, 1, 1); PG8_STAGE(PG8_SA(1, 0), a3, voffA);
            PG8_BAR; PG8_WAIT_L(0); PG8_MMA(1, 0, At, B0); PG8_BAR; PG8_SCHED;
            PG8_STAGE(PG8_SB(1, 1), b3 + hstep, voffB);
            PG8_WAIT_V(6); PG8_BAR; PG8_MMA(1, 1, At, B1); PG8_BAR;
            }
        }
        if constexpr (ALIGN_EPI) { if (wr == 0) PG8_BAR; }
        if constexpr (!Epi::AFTER_DRAIN) { E(acc, cur, wr, wc, fr, fq); S.done(cur); }
        if (!has_next) break;
#pragma unroll
        for (int a = 0; a < 2; ++a)
#pragma unroll
            for (int b = 0; b < 2; ++b)
#pragma unroll
                for (int m = 0; m < 4; ++m)
#pragma unroll
                    for (int n = 0; n < 2; ++n) acc[a][b][m][n] = (f32x4){0.f, 0.f, 0.f, 0.f};
        cur = nxt; cA = nA; cB = nB; ++ui;
        if constexpr (ALIGN_EPI) { if (wr == 1) PG8_BAR; }
    }
    PG8_WAIT_V(0);
    if constexpr (!ALIGN_EPI) { if (wr == 0) PG8_BAR; }
    PG8_BAR;
    if constexpr (Epi::AFTER_DRAIN) { E.fused(acc, cur, wr, wc, fr, fq, lds, wid, lane); S.done(cur); }
#undef PG8_SA
#undef PG8_SB
#undef PG8_STAGE
#undef PG8_LDA
#undef PG8_LDB
#undef PG8_MMA
#undef PG8_WAIT_V
#undef PG8_WAIT_L
#undef PG8_BAR
#undef PG8_SCHED
}
}
constexpr size_t KiB = 1024, MiB = 1u << 20;
constexpr size_t WS_CTL = 0, CTL_BYTES = 1 * MiB;
constexpr size_t WS_W = 1 * MiB, WBUF_BYTES = 42 * MiB;
constexpr size_t WO_GU1 = 0, WO_D1 = 11 * MiB, WO_IN = 16896 * KiB, WO_OUT = 23 * MiB, WO_GU2 = 25 * MiB, WO_D2 = 36 * MiB;
constexpr size_t WS_XB = 85 * MiB;
constexpr size_t WS_Z = 117 * MiB;
constexpr size_t WS_MIX = 221 * MiB;
constexpr size_t WS_ACT = 253 * MiB;
constexpr size_t WS_OP = 253 * MiB;
constexpr size_t WS_LSE = 301 * MiB;
constexpr size_t WS_SEL = 303 * MiB;
constexpr size_t WS_KV = 304 * MiB;
constexpr size_t WS_PREV = 310 * MiB;
constexpr size_t WS_KM = 313 * MiB;
constexpr size_t WS_RT = 341 * MiB, WS_MT = 345 * MiB;
constexpr size_t WS_SSQ = 346 * MiB;
constexpr size_t WS_X8 = 347 * MiB;
constexpr size_t WS_RF = 363 * MiB;
constexpr size_t WS_EX = WS_RF + 512 * KiB;
constexpr size_t WS_END = 364 * MiB;
constexpr size_t WO_IN8 = 7 * MiB, WO_SWIN = 10752 * KiB;
constexpr size_t WO_SW = 6 * MiB;
static_assert(WS_KM + 1 * MiB <= WS_ACT + 88 * MiB && WS_ACT + 88 * MiB <= WS_RT, "d_ws map");
constexpr int CW_TMO = 8, CW_XT = 1024  , CW_LB = 2048  , CW_BAR = 4096, CW_Q = 16384, CW_HC = 32768, CW_PC = 65536  ;

constexpr int RING_BYTES = 131072, LDSCTL_OFF = RING_BYTES, MISC_OFF = LDSCTL_OFF + 320, LDS_BYTES = 147456;

#define LAS __attribute__((address_space(3)))
#define GAS __attribute__((address_space(1)))
typedef unsigned short bf16;
typedef unsigned u32x4 __attribute__((ext_vector_type(4)));
typedef unsigned u32x2 __attribute__((ext_vector_type(2)));
typedef float f32x4 __attribute__((ext_vector_type(4)));
typedef float f32x2 __attribute__((ext_vector_type(2)));
typedef float f32x16 __attribute__((ext_vector_type(16)));
typedef short bf16x8 __attribute__((ext_vector_type(8)));
typedef short s16x4 __attribute__((ext_vector_type(4)));
typedef short v4i16_t __attribute__((ext_vector_type(4)));
typedef __bf16 bf16x2_t __attribute__((ext_vector_type(2)));
#define LDS_WAIT() asm volatile("s_waitcnt lgkmcnt(0)" ::: "memory")
__device__ __forceinline__ unsigned pk2(float lo, float hi) { const f32x2 v = {lo, hi}; const bf16x2_t b = __builtin_convertvector(v, bf16x2_t); return __builtin_bit_cast(unsigned, b); }
__device__ __forceinline__ float bflo(unsigned w) { return __uint_as_float(w << 16); }
__device__ __forceinline__ float bfhi(unsigned w) { return __uint_as_float(w & 0xffff0000u); }
__device__ __forceinline__ float ex2(float x) { return __builtin_amdgcn_exp2f(x); }
__device__ __forceinline__ float silu1(float x) { return x * __builtin_amdgcn_rcpf(1.0f + ex2(-1.4426950408889634f * x)); }
__device__ __forceinline__ float sigm1(float x) { return __builtin_amdgcn_rcpf(1.0f + ex2(-1.4426950408889634f * x)); }
__device__ __forceinline__ float wave_sum(float v) {
#pragma unroll
    for (int o = 1; o < 64; o <<= 1) v += __shfl_xor(v, o);
    return v;
}
__device__ __forceinline__ f32x16 mfma32(bf16x8 a, bf16x8 b, f32x16 c) { return __builtin_amdgcn_mfma_f32_32x32x16_bf16(a, b, c, 0, 0, 0); }
__device__ __forceinline__ int crow(int i, int h) { return (i & 3) + 8 * (i >> 2) + 4 * h; }
__device__ __forceinline__ s16x4 vtr(LAS const unsigned char* p) { return __builtin_bit_cast(s16x4, __builtin_amdgcn_ds_read_tr16_b64_v4i16((LAS v4i16_t*)p)); }
__device__ __forceinline__ bf16x8 cat8(s16x4 lo, s16x4 hi) { return __builtin_shufflevector(lo, hi, 0, 1, 2, 3, 4, 5, 6, 7); }
__device__ __forceinline__ bf16x8 ldsrow(LAS const unsigned char* p) { return *(const LAS bf16x8*)p; }
__device__ __forceinline__ f32x16 zero16() { f32x16 z;
#pragma unroll
    for (int i = 0; i < 16; ++i) z[i] = 0.f;
    return z; }
__device__ __forceinline__ bf16x8 pack8(const f32x16& x, int s) {
    u32x4 p; p.x = pk2(x[8 * s], x[8 * s + 1]); p.y = pk2(x[8 * s + 2], x[8 * s + 3]); p.z = pk2(x[8 * s + 4], x[8 * s + 5]); p.w = pk2(x[8 * s + 6], x[8 * s + 7]);
    return __builtin_bit_cast(bf16x8, p);
}
constexpr int PIT = 144;
constexpr int IMG = 256 * PIT;
template <int NR> __device__ __forceinline__ void stage64(LAS unsigned char* dst, const bf16* src, int gp, int tid) {
    constexpr int N = (NR * 8 + 511) / 512; u32x4 v[N];
#pragma unroll
    for (int i = 0; i < N; ++i) { const int c = tid + 512 * i, row = c >> 3, ch = c & 7; if (NR * 8 % 512 == 0 || c < NR * 8) v[i] = *(const u32x4*)(src + (size_t)row * gp + ch * 8); }
#pragma unroll
    for (int i = 0; i < N; ++i) { const int c = tid + 512 * i, row = c >> 3, ch = c & 7; if (NR * 8 % 512 == 0 || c < NR * 8) *(LAS u32x4*)(dst + row * PIT + ch * 16) = v[i]; }
}

template <int NI> __device__ __forceinline__ void stage256n(LAS unsigned char* const (&dst)[NI], const bf16* const (&src)[NI], int gp, int tid) {
    u32x4 v[NI][4];
#pragma unroll
    for (int k = 0; k < NI; ++k)
#pragma unroll
        for (int i = 0; i < 4; ++i) { const int c = tid + 512 * i, row = c >> 3, ch = c & 7; v[k][i] = *(const u32x4*)(src[k] + (size_t)row * gp + ch * 8); }
#pragma unroll
    for (int k = 0; k < NI; ++k)
#pragma unroll
        for (int i = 0; i < 4; ++i) { const int c = tid + 512 * i, row = c >> 3, ch = c & 7; *(LAS u32x4*)(dst[k] + row * PIT + ch * 16) = v[k][i]; }
}

__device__ __forceinline__ void sincos_acc(float angf, float& c, float& s) {
    const double a = (double)angf, kq = rint(a * 0.63661977236758134308), r = a - kq * 1.57079632679489661923, r2 = r * r;
    const double sn = r * (1.0 + r2 * (-1.0 / 6.0 + r2 * (1.0 / 120.0 + r2 * (-1.0 / 5040.0 + r2 * (1.0 / 362880.0 + r2 * (-1.0 / 39916800.0))))));
    const double cs = 1.0 + r2 * (-0.5 + r2 * (1.0 / 24.0 + r2 * (-1.0 / 720.0 + r2 * (1.0 / 40320.0 + r2 * (-1.0 / 3628800.0 + r2 * (1.0 / 479001600.0))))));
    const int q = ((int)kq) & 3;
    const double cc = (q == 0) ? cs : (q == 1) ? -sn : (q == 2) ? -cs : sn, ssv = (q == 0) ? sn : (q == 1) ? cs : (q == 2) ? -sn : -cs;
    c = (float)cc; s = (float)ssv;
}
__device__ __forceinline__ int cvt_tgt(int mode, int c, float& sc) {
    sc = 1.f;
    if (mode == 0) return c;
    if (mode == 1) return 256 * (c >> 7) + (c & 127);
    if (mode == 2) return 256 * (c >> 7) + 128 + (c & 127);
    if (c < 768) { const int sec = c >= 384, w = c - 384 * sec, hh = w >> 6, o = w & 63; if (sec) sc = 0.125f; return (sec ? Z_RK : Z_RQ) + hh * 64 + (o < 32 ? 2 * o : 2 * (o - 32) + 1); }
    if (c < 1152) return Z_RV + (c - 768);
    if (c < 1536) return Z_RG + (c - 1152);
    if (c < 2304) { const int sec = c >= 1920, w = c - 1536 - 384 * sec, hh = w >> 6, o = w & 63; if (!sec) sc = C2; return (sec ? Z_MK : Z_MQ) + hh * 64 + (o < 8 ? 2 * o : o < 16 ? 2 * (o - 8) + 1 : o); }
    if (c < 2688) return Z_MV + (c - 2304);
    if (c < 2944) return Z_CA + (c - 2688);
    return Z_CG + (c - 2944);
}
__device__ __forceinline__ void cvt_item(const float* W, const float* gain, bf16* dst, int K, int NS, int mode, int item, LAS float* scr, int lane) {
    const int nblk = NS >> 5, kb = item / nblk, nb = item - kb * nblk, k0 = kb << 6, c0 = nb << 5;
    const int ksub = lane >> 3, n4 = lane & 7;
    f32x4 v[8]; float gv[8];
#pragma unroll
    for (int i = 0; i < 8; ++i) v[i] = *(const f32x4*)(W + (size_t)(k0 + ksub + 8 * i) * NS + c0 + 4 * n4);
#pragma unroll
    for (int i = 0; i < 8; ++i) gv[i] = gain ? gain[k0 + ksub + 8 * i] : 1.f;
    float sc; (void)cvt_tgt(mode, c0, sc);
#pragma unroll
    for (int i = 0; i < 8; ++i) { const float g = gv[i] * sc; LAS float* s = scr + (ksub + 8 * i) * 33 + 4 * n4; s[0] = v[i][0] * g; s[1] = v[i][1] * g; s[2] = v[i][2] * g; s[3] = v[i][3] * g; }
    LDS_WAIT(); asm volatile("" ::: "memory");
    const int c = lane & 7;
#pragma unroll
    for (int j = 0; j < 4; ++j) { const int n = (lane >> 3) + 8 * j; const LAS float* s = scr + (8 * c) * 33 + n; float dummy;
        u32x4 o; o.x = pk2(s[0 * 33], s[1 * 33]); o.y = pk2(s[2 * 33], s[3 * 33]); o.z = pk2(s[4 * 33], s[5 * 33]); o.w = pk2(s[6 * 33], s[7 * 33]);
        *(u32x4*)(dst + (size_t)cvt_tgt(mode, c0 + n, dummy) * K + k0 + 8 * c) = o; }
    LDS_WAIT(); asm volatile("" ::: "memory");
}
__device__ __forceinline__ void cvt_q8_batch(const float* W, const float* gain, signed char* dst, float* SWt, int NS, int mode, int nb, LAS unsigned char* lds, int wave, int lane) {
    LAS float* scr = (LAS float*)(lds + wave * 16384); LAS float* red = (LAS float*)(lds + wave * 16384 + 12288);
    const int c0 = nb << 5, ksub = lane >> 3, n4 = lane & 7;
    f32x4 v[2][8]; float gv[2][8];
#pragma unroll
    for (int h = 0; h < 2; ++h)
#pragma unroll
        for (int i = 0; i < 8; ++i) v[h][i] = *(const f32x4*)(W + (size_t)(64 * (wave + 8 * h) + ksub + 8 * i) * NS + c0 + 4 * n4);
#pragma unroll
    for (int h = 0; h < 2; ++h)
#pragma unroll
        for (int i = 0; i < 8; ++i) gv[h][i] = gain[64 * (wave + 8 * h) + ksub + 8 * i];
    float sc0; (void)cvt_tgt(mode, c0, sc0);
    f32x4 am = {0.f, 0.f, 0.f, 0.f};
#pragma unroll
    for (int h = 0; h < 2; ++h)
#pragma unroll
        for (int i = 0; i < 8; ++i) { v[h][i] = v[h][i] * (gv[h][i] * sc0);
#pragma unroll
            for (int e = 0; e < 4; ++e) am[e] = fmaxf(am[e], fabsf(v[h][i][e])); }
#pragma unroll
    for (int o = 8; o < 64; o <<= 1)
#pragma unroll
        for (int e = 0; e < 4; ++e) am[e] = fmaxf(am[e], __shfl_xor(am[e], o));
    if (lane < 8) *(LAS f32x4*)(red + 4 * n4) = am;
    __syncthreads();
    f32x4 cm = {0.f, 0.f, 0.f, 0.f};
#pragma unroll
    for (int w = 0; w < 8; ++w) { const f32x4 t = *(const LAS f32x4*)(lds + w * 16384 + 12288 + 16 * n4);
#pragma unroll
        for (int e = 0; e < 4; ++e) cm[e] = fmaxf(cm[e], t[e]); }
    f32x4 inv;
#pragma unroll
    for (int e = 0; e < 4; ++e) inv[e] = cm[e] > 0.f ? 127.0f / cm[e] : 0.f;
    float dummy;
#pragma unroll
    for (int h = 0; h < 2; ++h) {
#pragma unroll
        for (int i = 0; i < 8; ++i) { LAS float* s = scr + (ksub + 8 * i) * 33 + 4 * n4;
#pragma unroll
            for (int e = 0; e < 4; ++e) s[e] = __builtin_rintf(v[h][i][e] * inv[e]); }
        LDS_WAIT(); asm volatile("" ::: "memory");
        const int c = lane & 7;
#pragma unroll
        for (int j = 0; j < 4; ++j) { const int n = (lane >> 3) + 8 * j; const LAS float* s = scr + (8 * c) * 33 + n; unsigned q[8];
#pragma unroll
            for (int t = 0; t < 8; ++t) q[t] = (unsigned)(int)s[t * 33] & 0xffu;
            u32x2 o; o.x = q[0] | (q[1] << 8) | (q[2] << 16) | (q[3] << 24); o.y = q[4] | (q[5] << 8) | (q[6] << 16) | (q[7] << 24);
            *(u32x2*)(dst + (size_t)cvt_tgt(mode, c0 + n, dummy) * DM + 64 * (wave + 8 * h) + 8 * c) = o; }
        LDS_WAIT(); asm volatile("" ::: "memory");
    }
    if (wave == 0 && lane < 8) {
#pragma unroll
        for (int e = 0; e < 4; ++e) SWt[cvt_tgt(mode, c0 + 4 * n4 + e, dummy)] = cm[e] * (1.0f / 127.0f); }
}
constexpr int I_D = (FF / 64) * (DM / 32), I_IN = (DM / 64) * (ZN / 32), I_OUT = (DM / 64) * (DM / 32);
constexpr int B_G = FF / 32, B_D = I_D / 8, B_IN = I_IN / 8, B_IN8 = ZN / 32, B_OUT = I_OUT / 8;
static_assert(I_D % 8 == 0 && I_IN % 8 == 0 && I_OUT % 8 == 0, "whole batches");
constexpr int WIN8_FROM = 1;
__host__ __device__ constexpr int b_in(int l) { return l >= WIN8_FROM ? B_IN8 : B_IN; }
constexpr int B_EARLY0 = 2 * B_G + B_D, B_LATE = 2 * B_G + B_D + B_OUT;
__host__ __device__ constexpr int b_early(int l) { return B_EARLY0 + b_in(l); }
__host__ __device__ constexpr int b_layer(int l) { return b_early(l) + B_LATE; }
struct Args { const float* in[18]; float* out; unsigned char* ws; float invf[40]; int ph_lo, ph_hi; };
#define AIN(k) ((const float*)(GAS const float*)A.in[(k) + zi])
__device__ __forceinline__ void cvt_layer_batch(const Args& A, int zi, int l, unsigned char* wb, int bt, LAS unsigned char* lds, int wave, int lane) {
    const size_t lgu = (size_t)l * DM * FF, lw = (size_t)l * DM; LAS float* scr = (LAS float*)(lds + wave * 16384);
    int r = bt;
    if (r < B_G) { cvt_q8_batch(AIN(3) + lgu, AIN(2) + lw, (signed char*)(wb + WO_GU1), (float*)(wb + WO_GU1 + WO_SW), FF, 1, r, lds, wave, lane); return; } r -= B_G;
    if (r < B_G) { cvt_q8_batch(AIN(4) + lgu, AIN(2) + lw, (signed char*)(wb + WO_GU1), (float*)(wb + WO_GU1 + WO_SW), FF, 2, r, lds, wave, lane); return; } r -= B_G;
    if (r < B_D) { cvt_item(AIN(5) + lgu, nullptr, (bf16*)(wb + WO_D1), FF, DM, 0, 8 * r + wave, scr, lane); return; } r -= B_D;
    if (r < b_in(l)) { if (l >= WIN8_FROM) cvt_q8_batch(AIN(7) + (size_t)l * DM * ZN, AIN(6) + lw, (signed char*)(wb + WO_IN8), (float*)(wb + WO_SWIN), ZN, 3, r, lds, wave, lane);
        else cvt_item(AIN(7) + (size_t)l * DM * ZN, AIN(6) + lw, (bf16*)(wb + WO_IN), DM, ZN, 3, 8 * r + wave, scr, lane); return; } r -= b_in(l);
    if (r < B_G) { cvt_q8_batch(AIN(14) + lgu, AIN(13) + lw, (signed char*)(wb + WO_GU2), (float*)(wb + WO_GU2 + WO_SW), FF, 1, r, lds, wave, lane); return; } r -= B_G;
    if (r < B_G) { cvt_q8_batch(AIN(15) + lgu, AIN(13) + lw, (signed char*)(wb + WO_GU2), (float*)(wb + WO_GU2 + WO_SW), FF, 2, r, lds, wave, lane); return; } r -= B_G;
    if (r < B_D) { cvt_item(AIN(16) + lgu, nullptr, (bf16*)(wb + WO_D2), FF, DM, 0, 8 * r + wave, scr, lane); return; } r -= B_D;
    cvt_item(AIN(12) + (size_t)l * DM * DM, nullptr, (bf16*)(wb + WO_OUT), DM, DM, 0, 8 * r + wave, scr, lane);
}
#define XB_TMO      128
#define XB_XCNT(j)  (256  + 64 * (j))
#define XB_XSUB(j)  (1280 + 64 * (j))
#define XB_XGEN(j)  (2304 + 64 * (j))
#define XB_TOP      3328
#define XB_TOPGEN   3392
#define XCD_BAR_WORDS 3456
#define XB_SPIN_CAP (1u << 18)

__device__ __forceinline__ unsigned xb_ld(unsigned* p)              { return __hip_atomic_load(p, __ATOMIC_RELAXED, __HIP_MEMORY_SCOPE_AGENT); }
__device__ __forceinline__ unsigned xb_add(unsigned* p, unsigned v) { return __hip_atomic_fetch_add(p, v, __ATOMIC_RELAXED, __HIP_MEMORY_SCOPE_AGENT); }
__device__ __forceinline__ unsigned xb_xcc_id() { return (unsigned)__builtin_amdgcn_s_getreg((3 << 11) | 20) & 0xFu; }
#define XB_SPIN(cond, bar) do { unsigned _sp = 0; while (cond) { __builtin_amdgcn_s_sleep(1); \
    if ((++_sp & 255u) == 0u) { if (xb_ld(&(bar)[XB_TMO])) break; if (_sp > XB_SPIN_CAP) { atomicAdd(&(bar)[XB_TMO], 1u); break; } } } } while (0)

struct XcdBarrier {
    unsigned* bar; unsigned x;
    volatile LAS unsigned* st;
};

__device__ __forceinline__ XcdBarrier xcd_barrier_post(unsigned* bar, volatile LAS unsigned* st) {
    XcdBarrier b; b.bar = bar; b.x = xb_xcc_id(); b.st = st;
    if (threadIdx.x == 0) (void)xb_add(&bar[XB_XCNT(b.x)], 1u);
    return b;
}
__device__ __forceinline__ void xcd_barrier_complete(unsigned* bar, unsigned x, unsigned& nloc, unsigned& nx) {
    const unsigned G = gridDim.x * gridDim.y * gridDim.z;
    unsigned sum, cnt, mine, sp = 0u;
    for (;;) {
        sum = 0u; cnt = 0u; mine = 0u;
#pragma unroll
        for (unsigned j = 0; j < 16; ++j) { const unsigned c = xb_ld(&bar[XB_XCNT(j)]); sum += c; cnt += (c > 0u) ? 1u : 0u; mine = (j == x) ? c : mine; }
        if (sum == G) break;
        __builtin_amdgcn_s_sleep(1);
        if ((++sp & 255u) == 0u) { if (xb_ld(&bar[XB_TMO])) break; if (sp > XB_SPIN_CAP) { atomicAdd(&bar[XB_TMO], 1u); break; } }
    }
    nloc = mine > 0u ? mine : 1u; nx = cnt > 0u ? cnt : 1u;
}

__device__ __forceinline__ void xcd_barrier(const XcdBarrier& b) {
    asm volatile("s_waitcnt vmcnt(0)" ::: "memory");
    __syncthreads();
    if (threadIdx.x == 0) {
        unsigned* bar = b.bar;
        __builtin_amdgcn_s_waitcnt(0);
        unsigned nloc = b.st[0], nx = b.st[1];
        if (nloc == 0u) { xcd_barrier_complete(bar, b.x, nloc, nx); b.st[0] = nloc; b.st[1] = nx; }
        const unsigned old = xb_add(&bar[XB_XSUB(b.x)], 1u);
        const unsigned gen = old / nloc;
        if (old + 1u == (gen + 1u) * nloc) {
            __builtin_amdgcn_fence(__ATOMIC_RELEASE, "agent");
            asm volatile("s_waitcnt vmcnt(0)" ::: "memory");
            const unsigned og = xb_add(&bar[XB_TOP], 1u);
            const unsigned tg = og / nx;
            if (og + 1u == (tg + 1u) * nx) xb_add(&bar[XB_TOPGEN], 1u);
            else XB_SPIN(xb_ld(&bar[XB_TOPGEN]) == tg, bar);
            __builtin_amdgcn_fence(__ATOMIC_ACQUIRE, "agent");
            xb_add(&bar[XB_XGEN(b.x)], 1u);
            asm volatile("s_waitcnt vmcnt(0)" ::: "memory");
        } else {
            XB_SPIN(xb_ld(&bar[XB_XGEN(b.x)]) == gen, bar);
            __builtin_amdgcn_fence(__ATOMIC_ACQUIRE, "agent");
            asm volatile("s_waitcnt vmcnt(0)" ::: "memory");
        }
    }
    __syncthreads();
}
__device__ __forceinline__ void xcd_local_barrier(unsigned* lb, unsigned x, unsigned nloc, unsigned* tmo) {
    asm volatile("s_waitcnt vmcnt(0)" ::: "memory");
    __syncthreads();
    if (threadIdx.x == 0) {
        __builtin_amdgcn_s_waitcnt(0);
        const unsigned old = xb_add(&lb[64 * x], 1u), gen = old / nloc;
        if (old + 1u == (gen + 1u) * nloc) xb_add(&lb[64 * (16 + x)], 1u);
        else { unsigned sp = 0u; while (xb_ld(&lb[64 * (16 + x)]) == gen) { __builtin_amdgcn_s_sleep(1); if (++sp > (1u << 22)) { __hip_atomic_store(tmo, 1u, __ATOMIC_RELAXED, __HIP_MEMORY_SCOPE_AGENT); break; } } }
        __builtin_amdgcn_fence(__ATOMIC_ACQUIRE, "agent");
        asm volatile("s_waitcnt vmcnt(0)" ::: "memory");
    }
    __syncthreads();
}
__device__ __forceinline__ void conv_item(int it, const bf16* z, bf16* mix, const float* cw, const float* cb, const float* lg, const float* lb, LAS unsigned char* lds, int tid, int wave, int lane) {
    LAS float* U = (LAS float*)lds;
    const int t0 = it * 64, s0 = t0 & (SEQ - 1);
    u32x4 av[6], gv[6];
#pragma unroll
    for (int i = 0; i < 6; ++i) { const int c = tid + 512 * i, row = c >> 5, ch = c & 31; av[i] = (u32x4){0u, 0u, 0u, 0u}; gv[i] = av[i];
        if (c < 94 * 32 && s0 - 30 + row >= 0) { const bf16* zr = z + (size_t)(t0 - 30 + row) * ZP; av[i] = *(const u32x4*)(zr + Z_CA + 8 * ch); gv[i] = *(const u32x4*)(zr + Z_CG + 8 * ch); } }
#pragma unroll
    for (int i = 0; i < 6; ++i) { const int c = tid + 512 * i, row = c >> 5, ch = c & 31; const u32x4 a = av[i], g = gv[i]; f32x4 o0, o1;
        o0[0] = bflo(a.x) * sigm1(bflo(g.x)); o0[1] = bfhi(a.x) * sigm1(bfhi(g.x)); o0[2] = bflo(a.y) * sigm1(bflo(g.y)); o0[3] = bfhi(a.y) * sigm1(bfhi(g.y));
        o1[0] = bflo(a.z) * sigm1(bflo(g.z)); o1[1] = bfhi(a.z) * sigm1(bfhi(g.z)); o1[2] = bflo(a.w) * sigm1(bflo(g.w)); o1[3] = bfhi(a.w) * sigm1(bfhi(g.w));
        if (c < 94 * 32) { *(LAS f32x4*)(U + row * 256 + 8 * ch) = o0; *(LAS f32x4*)(U + row * 256 + 8 * ch + 4) = o1; } }
    __syncthreads();
    const int g = wave & 3, half = wave >> 2, c = 64 * g + lane;
    float w[31];
#pragma unroll
    for (int j = 0; j < 31; ++j) w[j] = cw[j * 256 + c];
    const float bias = cb[c], gg = lg[c], bb = lb[c];
    float uw[62];
#pragma unroll
    for (int i = 0; i < 62; ++i) uw[i] = U[(32 * half + i) * 256 + c];
#pragma unroll
    for (int tb = 0; tb < 32; tb += 4) {
        float y[4], mu[4], var[4];
#pragma unroll
        for (int k = 0; k < 4; ++k) { y[k] = bias;
#pragma unroll
            for (int j = 0; j < 31; ++j) y[k] += w[j] * uw[tb + k + j]; }
#pragma unroll
        for (int k = 0; k < 4; ++k) mu[k] = y[k];
#pragma unroll
        for (int o = 1; o < 64; o <<= 1) {
#pragma unroll
            for (int k = 0; k < 4; ++k) mu[k] += __shfl_xor(mu[k], o); }
#pragma unroll
        for (int k = 0; k < 4; ++k) { mu[k] *= (1.f / 64.f); y[k] -= mu[k]; var[k] = y[k] * y[k]; }
#pragma unroll
        for (int o = 1; o < 64; o <<= 1) {
#pragma unroll
            for (int k = 0; k < 4; ++k) var[k] += __shfl_xor(var[k], o); }
#pragma unroll
        for (int k = 0; k < 4; ++k) { const float yn = y[k] * __builtin_amdgcn_rsqf(var[k] * (1.f / 64.f) + RMS_EPS) * gg + bb;
            mix[(size_t)(t0 + 32 * half + tb + k) * DM + X_CONV + c] = (bf16)(pk2(silu1(yn), 0.f) & 0xffffu); }
    }
    __syncthreads();
}
#define RLX_AGENT __ATOMIC_RELAXED, __HIP_MEMORY_SCOPE_AGENT
__device__ __forceinline__ void st_wt(float* p, float v) { __hip_atomic_store(p, v, RLX_AGENT); }
__device__ __forceinline__ void st_wt(unsigned* p, unsigned v) { __hip_atomic_store(p, v, RLX_AGENT); }
__device__ __forceinline__ void st_wt(unsigned long long* p, unsigned long long v) { __hip_atomic_store(p, v, RLX_AGENT); }
__device__ __forceinline__ float ld_wt(const float* p) { return __hip_atomic_load(p, RLX_AGENT); }
__device__ __forceinline__ unsigned ld_wt(const unsigned* p) { return __hip_atomic_load(p, RLX_AGENT); }
__device__ __forceinline__ unsigned long long ld_wt(const unsigned long long* p) { return __hip_atomic_load(p, RLX_AGENT); }
__device__ __forceinline__ void publish_wave(unsigned* ctr, int lane) { asm volatile("s_waitcnt vmcnt(0)" ::: "memory"); if (lane == 0) __hip_atomic_fetch_add(ctr, 1u, RLX_AGENT); }
__device__ __forceinline__ void wait_count(unsigned* ctr, unsigned need, unsigned* tmo, int tid) {
    if (tid == 0) { unsigned sp = 0u;
        while (__hip_atomic_load(ctr, RLX_AGENT) < need) { __builtin_amdgcn_s_sleep(2); if (++sp > (1u << 20)) { __hip_atomic_store(tmo, 1u, RLX_AGENT); break; } } }
    __syncthreads();
}
__device__ __forceinline__ void kv_item(int it2, const bf16* z, float* KV, unsigned* kvc, LAS unsigned char* lds, int tid, int wave, int lane) {
    const int team = wave >> 2, it = 2 * it2 + team, tt = tid & 255;
    const int bh = it >> 5, n = it & 31, b = bh / NHM, hh = bh - b * NHM; const size_t tok0 = (size_t)b * SEQ + 256 * n;
    const float lg2 = log2f(1.0f - ex2(-5.0f - (float)hh));
    LAS unsigned char* Ki = lds + team * 65536; LAS unsigned char* Vw = Ki + 32768;
    { u32x4 kk[8], vv[8];
#pragma unroll
    for (int i = 0; i < 8; ++i) { const int c = tt + 256 * i, row = c >> 3, ch = c & 7; kk[i] = *(const u32x4*)(z + (tok0 + row) * ZP + Z_RK + 64 * hh + ch * 8); vv[i] = *(const u32x4*)(z + (tok0 + row) * ZP + Z_RV + 64 * hh + ch * 8); }
#pragma unroll
    for (int i = 0; i < 8; ++i) { const int c = tt + 256 * i, row = c >> 3, ch = c & 7; const u32x4 v = vv[i];
        const float wg = ex2((float)(255 - row) * lg2); u32x4 o;
        o.x = pk2(bflo(v.x) * wg, bfhi(v.x) * wg); o.y = pk2(bflo(v.y) * wg, bfhi(v.y) * wg); o.z = pk2(bflo(v.z) * wg, bfhi(v.z) * wg); o.w = pk2(bflo(v.w) * wg, bfhi(v.w) * wg);
        *(LAS u32x4*)(Ki + row * 128 + ch * 16) = kk[i]; *(LAS u32x4*)(Vw + row * 128 + ch * 16) = o; } }
    __syncthreads();
    const int tl = wave & 3, ce = tl >> 1, cd = tl & 1, r = lane & 31, h = lane >> 5, blk = (lane >> 4) & 1, q4 = (lane & 15) >> 2, p = lane & 3;
    f32x16 acc = zero16();
#pragma unroll
    for (int kk = 0; kk < 16; ++kk) { const int rowa = 16 * kk + 8 * h + q4; const int ofa = rowa * 128 + 32 * blk + 8 * p;
        const bf16x8 a = cat8(vtr(Vw + ofa + 64 * ce), vtr(Vw + ofa + 4 * 128 + 64 * ce));
        const bf16x8 bb = cat8(vtr(Ki + ofa + 64 * cd), vtr(Ki + ofa + 4 * 128 + 64 * cd));
        acc = mfma32(a, bb, acc); }
    float* o = KV + (size_t)it * 4096;
#pragma unroll
    for (int i = 0; i < 16; ++i) st_wt(o + (32 * ce + crow(i, h)) * 64 + 32 * cd + r, acc[i]);
    publish_wave(kvc + 64 * bh, lane);
    __syncthreads();
}
__device__ __forceinline__ void kmean_item(int it8, const bf16* z, float* KM, unsigned* kmc, LAS unsigned char* lds, int wave, int lane) {
    const int it = 8 * it8 + wave, bh = it >> 5, j = it & 31, b = bh / NHM, hh = bh - b * NHM; const size_t tok0 = (size_t)b * SEQ + 256 * j;
    LAS float* S = (LAS float*)(lds + wave * 2048);
    const int g = lane >> 3, ch = lane & 7; float a[8];
#pragma unroll
    for (int k = 0; k < 8; ++k) a[k] = 0.f;
#pragma unroll
    for (int q = 0; q < 4; ++q) { u32x4 v[8];
#pragma unroll
        for (int i = 0; i < 8; ++i) v[i] = *(const u32x4*)(z + (tok0 + g + 8 * (8 * q + i)) * ZP + Z_MK + 64 * hh + ch * 8);
#pragma unroll
        for (int i = 0; i < 8; ++i) { a[0] += bflo(v[i].x); a[1] += bfhi(v[i].x); a[2] += bflo(v[i].y); a[3] += bfhi(v[i].y); a[4] += bflo(v[i].z); a[5] += bfhi(v[i].z); a[6] += bflo(v[i].w); a[7] += bfhi(v[i].w); } }
    *(LAS f32x4*)(S + g * 64 + ch * 8) = (f32x4){a[0], a[1], a[2], a[3]}; *(LAS f32x4*)(S + g * 64 + ch * 8 + 4) = (f32x4){a[4], a[5], a[6], a[7]};
    LDS_WAIT(); asm volatile("" ::: "memory");
    float s = 0.f;
#pragma unroll
    for (int q = 0; q < 8; ++q) s += S[q * 64 + lane];
    st_wt(KM + (size_t)it * 64 + lane, s * (1.f / 256.f)); publish_wave(kmc + 64 * bh, lane);
    LDS_WAIT(); asm volatile("" ::: "memory");
}
__device__ __forceinline__ void scan_item(int it, const float* KV, bf16* PREV, unsigned* kvc, unsigned* scc, unsigned* tmo, int tid, int lane) {
    const int bh = it >> 1, part = it & 1, hh = bh % NHM; const int idx = part * 2048 + 4 * tid;
    wait_count(kvc + 64 * bh, 128u, tmo, tid);
    const float g256 = ex2(256.0f * log2f(1.0f - ex2(-5.0f - (float)hh)));
    float k0[NCH], k1[NCH], k2[NCH], k3[NCH];
#pragma unroll
    for (int n = 0; n < NCH; ++n) { const float* p = KV + ((size_t)bh * NCH + n) * 4096 + idx; k0[n] = ld_wt(p); k1[n] = ld_wt(p + 1); k2[n] = ld_wt(p + 2); k3[n] = ld_wt(p + 3); }
    float s0 = 0.f, s1 = 0.f, s2 = 0.f, s3 = 0.f;
#pragma unroll
    for (int n = 0; n < NCH; ++n) { st_wt((unsigned long long*)(PREV + ((size_t)bh * NCH + n) * 4096 + idx), (unsigned long long)pk2(s0, s1) | ((unsigned long long)pk2(s2, s3) << 32));
        s0 = s0 * g256 + k0[n]; s1 = s1 * g256 + k1[n]; s2 = s2 * g256 + k2[n]; s3 = s3 * g256 + k3[n]; }
    publish_wave(scc + 64 * bh, lane);
}
__device__ __forceinline__ void gate_item(int it, const bf16* z, const float* KM, unsigned* SEL, unsigned* kmc, unsigned* gtc, unsigned* tmo, LAS unsigned char* lds, int tid, int lane) {
    const int bh = it >> 4, ip = it & 15, b = bh / NHM, hh = bh - b * NHM;
    wait_count(kmc + 64 * bh, 32u, tmo, tid);
    LAS float* km = (LAS float*)lds;
#pragma unroll
    for (int i = 0; i < 4; ++i) km[tid + 512 * i] = ld_wt(KM + (size_t)bh * 2048 + tid + 512 * i);
    __syncthreads();
    const int i = 2 * ip + (tid >> 8), s = 256 * i + (tid & 255);
    const bf16* qp = z + ((size_t)b * SEQ + s) * ZP + Z_MQ + 64 * hh;
    float q[64];
#pragma unroll
    for (int c = 0; c < 8; ++c) { const u32x4 v = *(const u32x4*)(qp + 8 * c);
        q[8 * c] = bflo(v.x); q[8 * c + 1] = bfhi(v.x); q[8 * c + 2] = bflo(v.y); q[8 * c + 3] = bfhi(v.y); q[8 * c + 4] = bflo(v.z); q[8 * c + 5] = bfhi(v.z); q[8 * c + 6] = bflo(v.w); q[8 * c + 7] = bfhi(v.w); }
    const float ninf = -__builtin_inff();
    float v0 = ninf, v1 = ninf, v2 = ninf; int i0 = 0, i1 = 0, i2 = 0;
    for (int j = 0; j < i; ++j) { float g = 0.f;
#pragma unroll
        for (int d = 0; d < 64; d += 4) { const f32x4 k4 = *(const LAS f32x4*)(km + j * 64 + d); g += q[d] * k4[0] + q[d + 1] * k4[1] + q[d + 2] * k4[2] + q[d + 3] * k4[3]; }
        if (g > v0) { v2 = v1; i2 = i1; v1 = v0; i1 = i0; v0 = g; i0 = j; }
        else if (g > v1) { v2 = v1; i2 = i1; v1 = g; i1 = j; }
        else if (g > v2) { v2 = g; i2 = j; } }
    unsigned mask = 0u;
    if (i > 0) mask |= 1u << i0;
    if (i > 1) mask |= 1u << i1;
    if (i > 2) mask |= 1u << i2;
    st_wt(SEL + (size_t)bh * SEQ + s, mask);
    publish_wave(gtc + 64 * bh, lane);
    __syncthreads();
}
__device__ __forceinline__ void attn_wave(LAS const unsigned char* Ki, LAS const unsigned char* Vi, const bf16x8 (&qf)[4], int nkt, int diag, int qloc, int lane, f32x16 (&o)[2], float& m, float& l) {
    const int r = lane & 31, h = lane >> 5, blk = (lane >> 4) & 1, q4 = (lane & 15) >> 2, p = lane & 3;
    o[0] = zero16(); o[1] = zero16(); l = 0.f; m = 0.f;
    f32x16 negm = zero16();
    bf16x8 kf[4];
#pragma unroll
    for (int s = 0; s < 4; ++s) kf[s] = ldsrow(Ki + r * PIT + 32 * s + 16 * h);
    for (int kt = 0; kt < nkt; ++kt) {
        f32x16 x = negm;
        asm volatile("" : "+v"(kf[0]), "+v"(kf[1]), "+v"(kf[2]), "+v"(kf[3]));
#pragma unroll
        for (int s = 0; s < 4; ++s) x = mfma32(kf[s], qf[s], x);
        const int ktn = (kt + 1 < nkt) ? kt + 1 : kt;
#pragma unroll
        for (int s = 0; s < 4; ++s) kf[s] = ldsrow(Ki + (32 * ktn + r) * PIT + 32 * s + 16 * h);
        bf16x8 vf[2][2];
#pragma unroll
        for (int s2 = 0; s2 < 2; ++s2) { const int ofv = (32 * kt + 16 * s2 + 4 * h + q4) * PIT + 32 * blk + 8 * p;
#pragma unroll
            for (int c = 0; c < 2; ++c) vf[s2][c] = cat8(vtr(Vi + ofv + 64 * c), vtr(Vi + ofv + 8 * PIT + 64 * c)); }
        __builtin_amdgcn_sched_barrier(0);
        if (kt == diag) {
#pragma unroll
            for (int i = 0; i < 16; ++i) if (32 * kt + crow(i, h) > qloc) x[i] = -__builtin_inff(); }
        float tm = x[0];
#pragma unroll
        for (int i = 1; i < 16; ++i) tm = fmaxf(tm, x[i]);
        tm = fmaxf(tm, __shfl_xor(tm, 32));
        if (kt == 0) { m = tm;
#pragma unroll
            for (int i = 0; i < 16; ++i) { x[i] -= tm; negm[i] = -tm; } }
        else if (__any(tm > 8.0f)) {
            const float dm = fmaxf(tm, 0.f), sc = ex2(-dm);
            l *= sc; o[0] = o[0] * sc; o[1] = o[1] * sc; m += dm;
#pragma unroll
            for (int i = 0; i < 16; ++i) { x[i] -= dm; negm[i] = -m; } }
#pragma unroll
        for (int i = 0; i < 16; ++i) { x[i] = ex2(x[i]); l += x[i]; }
        const bf16x8 pf0 = pack8(x, 0), pf1 = pack8(x, 1);
        __builtin_amdgcn_sched_barrier(0);
        o[0] = mfma32(vf[0][0], pf0, o[0]); o[1] = mfma32(vf[0][1], pf0, o[1]); o[0] = mfma32(vf[1][0], pf1, o[0]); o[1] = mfma32(vf[1][1], pf1, o[1]);
    }
}
__device__ __forceinline__ void store_partial(const f32x16 (&o)[2], float m, float l, bf16* OP, float* LSE, int bh, int slot, int qidx, bool valid, int lane, LAS unsigned char* ot) {
    const int r = lane & 31, h = lane >> 5; const float lt = l + __shfl_xor(l, 32), inv = 1.0f / lt;
    LAS int* rowdst = (LAS int*)(ot + 32 * 80);
    const int dst = valid ? (bh * 4 + slot) * SEQ + qidx : -1;
    if (h == 0) rowdst[r] = dst;
#pragma unroll
    for (int c = 0; c < 2; ++c)
#pragma unroll
        for (int g = 0; g < 4; ++g) { int w = __builtin_amdgcn_cvt_pk_fp8_f32(o[c][4 * g] * inv, o[c][4 * g + 1] * inv, 0, false); w = __builtin_amdgcn_cvt_pk_fp8_f32(o[c][4 * g + 2] * inv, o[c][4 * g + 3] * inv, w, true);
            *(LAS int*)(ot + r * 80 + 32 * c + 8 * g + 4 * h) = w; }
    if (valid && h == 0) LSE[(size_t)dst] = m + log2f(lt);
    LDS_WAIT(); asm volatile("" ::: "memory");
    u32x4 v[2]; int d[2];
#pragma unroll
    for (int k = 0; k < 2; ++k) { const int row = 16 * k + (lane >> 2); v[k] = *(const LAS u32x4*)(ot + row * 80 + (lane & 3) * 16); d[k] = rowdst[row]; }
#pragma unroll
    for (int k = 0; k < 2; ++k) if (d[k] >= 0) *(u32x4*)((unsigned char*)OP + (size_t)d[k] * 64 + 16 * (lane & 3)) = v[k];
    LDS_WAIT(); asm volatile("" ::: "memory");
}
__device__ __forceinline__ void moba_item(int bh, int j, bool own, int i0, int i1, const bf16* z, const unsigned* SEL, bf16* OP, float* LSE, unsigned* gtc, unsigned* tmo, LAS unsigned char* lds, int tid, int wave, int lane) {
    const int b = bh / NHM, hh = bh - b * NHM; const size_t tokb = (size_t)b * SEQ;
    wait_count(gtc + 64 * bh, 128u, tmo, tid);
    LAS unsigned char* Ki = lds; LAS unsigned char* Vi = lds + IMG; LAS unsigned short* list = (LAS unsigned short*)(lds + 2 * IMG); LAS int* wtot = (LAS int*)(lds + 2 * IMG + 4096);
    const int ncand = 256 * (i1 - i0), c0 = 4 * tid; int f[4] = {0, 0, 0, 0};
    u32x4 mk = {0u, 0u, 0u, 0u};
    if (c0 < ncand) { const unsigned* sp = SEL + (size_t)bh * SEQ + 256 * i0 + c0; mk = (u32x4){ld_wt(sp), ld_wt(sp + 1), ld_wt(sp + 2), ld_wt(sp + 3)}; }
    const int r = lane & 31, h = lane >> 5, qt = wave < 4 ? wave : 11 - wave;
    { LAS unsigned char* const d_[2] = {Ki, Vi}; const bf16* const s_[2] = {z + (tokb + 256 * j) * ZP + Z_MK + 64 * hh, z + (tokb + 256 * j) * ZP + Z_MV + 64 * hh}; stage256n<2>(d_, s_, ZP, tid); }
    f[0] = (mk.x >> j) & 1; f[1] = (mk.y >> j) & 1; f[2] = (mk.z >> j) & 1; f[3] = (mk.w >> j) & 1;
    const int mine = f[0] + f[1] + f[2] + f[3]; int inc = mine;
#pragma unroll
    for (int o = 1; o < 64; o <<= 1) { const int t = __shfl_up(inc, o); if (lane >= o) inc += t; }
    if (lane == 63) wtot[wave] = inc;
    __syncthreads();
    int base = 0, cnt = 0;
#pragma unroll
    for (int w = 0; w < 8; ++w) { const int t = wtot[w]; if (w < wave) base += t; cnt += t; }
    int pos = base + inc - mine;
#pragma unroll
    for (int k = 0; k < 4; ++k) if (f[k]) { list[pos] = (unsigned short)(256 * i0 + c0 + k); ++pos; }
    __syncthreads();
    const int ntl = (cnt + 255) >> 8, Tfirst = own ? -1 : 0;
    int qidx = 0; bool valid = false; unsigned mq = 0u; bf16x8 qn[4];
#define MOBA_LOADQ(Tn) do { if ((Tn) < 0) { qidx = 256 * j + 32 * qt + r; valid = true; } else { const int li_ = 256 * (Tn) + 32 * wave + r; valid = li_ < cnt; qidx = list[valid ? li_ : cnt - 1]; } \
        _Pragma("unroll") for (int s = 0; s < 4; ++s) qn[s] = *(const bf16x8*)(z + (tokb + qidx) * ZP + Z_MQ + 64 * hh + 16 * s + 8 * h); \
        mq = ld_wt(SEL + (size_t)bh * SEQ + qidx); } while (0)
    if (Tfirst < 0 || 32 * wave < cnt) MOBA_LOADQ(Tfirst);
    for (int T = Tfirst; T < ntl; ++T) {
        if (T >= 0 && 256 * T + 32 * wave >= cnt) break;
        bf16x8 qf[4];
#pragma unroll
        for (int s = 0; s < 4; ++s) qf[s] = qn[s];
        const int qcur = qidx, slot = (T < 0) ? 3 : __builtin_popcount(mq & ((1u << j) - 1u)); const bool vcur = valid;
        if (T + 1 < ntl && 256 * (T + 1) + 32 * wave < cnt) MOBA_LOADQ(T + 1);
        f32x16 o[2]; float m, l;
        attn_wave(Ki, Vi, qf, (T < 0) ? qt + 1 : 8, (T < 0) ? qt : -1, 32 * qt + r, lane, o, m, l);
        store_partial(o, m, l, OP, LSE, bh, slot, qcur, vcur, lane, lds + 2 * IMG + 8192 + wave * 3072);
    }
#undef MOBA_LOADQ
    __syncthreads();
}
__device__ __forceinline__ void ret_item(int it, const bf16* z, const bf16* PREV, bf16* mix, unsigned* scc, unsigned* tmo, LAS unsigned char* lds, int tid, int wave, int lane) {
    const int bh = it >> 5, n = it & 31, b = bh / NHM, hh = bh - b * NHM; const size_t tok0 = (size_t)b * SEQ + 256 * n;
    wait_count(scc + 64 * bh, 16u, tmo, tid);
    const float lg2 = log2f(1.0f - ex2(-5.0f - (float)hh));
    LAS unsigned char* Qi = lds; LAS unsigned char* Ki = lds + IMG; LAS unsigned char* Vi = lds + 2 * IMG; LAS unsigned char* Pi = lds + 3 * IMG;
    { const unsigned* pp_ = (const unsigned*)(PREV + (size_t)it * 4096 + (size_t)(tid >> 3) * 64 + (tid & 7) * 8);
      const u32x4 pv_ = {ld_wt(pp_), ld_wt(pp_ + 1), ld_wt(pp_ + 2), ld_wt(pp_ + 3)};
      LAS unsigned char* const d_[3] = {Qi, Ki, Vi}; const bf16* const s_[3] = {z + tok0 * ZP + Z_RQ + 64 * hh, z + tok0 * ZP + Z_RK + 64 * hh, z + tok0 * ZP + Z_RV + 64 * hh}; stage256n<3>(d_, s_, ZP, tid);
      *(LAS u32x4*)(Pi + (tid >> 3) * PIT + (tid & 7) * 16) = pv_; }
    __syncthreads();
    const int qt = wave < 4 ? wave : 11 - wave, r = lane & 31, h = lane >> 5, blk = (lane >> 4) & 1, q4 = (lane & 15) >> 2, p = lane & 3, qloc = 32 * qt + r;
    const bf16* gp = z + (tok0 + qloc) * ZP + Z_RG + 64 * hh;
    u32x2 gvv[2][4];
#pragma unroll
    for (int c = 0; c < 2; ++c)
#pragma unroll
        for (int g = 0; g < 4; ++g) gvv[c][g] = (hh < 4) ? *(const u32x2*)(gp + 32 * c + 8 * g + 4 * h) : (u32x2){0u, 0u};
    bf16x8 qf[4];
#pragma unroll
    for (int s = 0; s < 4; ++s) qf[s] = ldsrow(Qi + qloc * PIT + 32 * s + 16 * h);
    f32x16 cx[2], o[2]; cx[0] = zero16(); cx[1] = zero16(); o[0] = zero16(); o[1] = zero16();
#pragma unroll
    for (int c = 0; c < 2; ++c)
#pragma unroll
        for (int s = 0; s < 4; ++s) cx[c] = mfma32(ldsrow(Pi + (32 * c + r) * PIT + 32 * s + 16 * h), qf[s], cx[c]);
    float grel[16];
#pragma unroll
    for (int i = 0; i < 16; ++i) grel[i] = ex2((float)(r - crow(i, h)) * lg2);
    bf16x8 kf[4];
#pragma unroll
    for (int s = 0; s < 4; ++s) kf[s] = ldsrow(Ki + r * PIT + 32 * s + 16 * h);
    for (int kt = 0; kt <= qt; ++kt) {
        f32x16 x = zero16();
        asm volatile("" : "+v"(kf[0]), "+v"(kf[1]), "+v"(kf[2]), "+v"(kf[3]));
#pragma unroll
        for (int s = 0; s < 4; ++s) x = mfma32(kf[s], qf[s], x);
        const int ktn = (kt < qt) ? kt + 1 : kt;
#pragma unroll
        for (int s = 0; s < 4; ++s) kf[s] = ldsrow(Ki + (32 * ktn + r) * PIT + 32 * s + 16 * h);
        bf16x8 vf[2][2];
#pragma unroll
        for (int s2 = 0; s2 < 2; ++s2) { const int ofv = (32 * kt + 16 * s2 + 4 * h + q4) * PIT + 32 * blk + 8 * p;
#pragma unroll
            for (int c = 0; c < 2; ++c) vf[s2][c] = cat8(vtr(Vi + ofv + 64 * c), vtr(Vi + ofv + 8 * PIT + 64 * c)); }
        __builtin_amdgcn_sched_barrier(0);
        { const float ts = ex2((float)(32 * (qt - kt)) * lg2);
#pragma unroll
        for (int i = 0; i < 16; ++i) { const float wv = grel[i] * ts; x[i] = (kt < qt || r >= crow(i, h)) ? x[i] * wv : 0.f; } }
        const bf16x8 pf0 = pack8(x, 0), pf1 = pack8(x, 1);
        __builtin_amdgcn_sched_barrier(0);
        o[0] = mfma32(vf[0][0], pf0, o[0]); o[1] = mfma32(vf[0][1], pf0, o[1]); o[0] = mfma32(vf[1][0], pf1, o[0]); o[1] = mfma32(vf[1][1], pf1, o[1]);
    }
    const float wcr = ex2((float)(qloc + 1) * lg2); float ss = 0.f;
#pragma unroll
    for (int c = 0; c < 2; ++c)
#pragma unroll
        for (int i = 0; i < 16; ++i) { const float y = o[c][i] + wcr * cx[c][i]; o[c][i] = y; ss += y * y; }
    ss += __shfl_xor(ss, 32);
    const float rn = __builtin_amdgcn_rsqf(ss * (1.f / 64.f) + RMS_EPS);
    bf16* mp = mix + (tok0 + qloc) * DM + X_RET + 64 * hh;
#pragma unroll
    for (int c = 0; c < 2; ++c)
#pragma unroll
        for (int g = 0; g < 4; ++g) { const int e0 = 32 * c + 8 * g + 4 * h; const u32x2 gv = gvv[c][g]; u32x2 w;
            if (hh < 4) { w.x = pk2(silu1(bflo(gv.x)) * o[c][4 * g] * rn, silu1(bfhi(gv.x)) * o[c][4 * g + 1] * rn); w.y = pk2(silu1(bflo(gv.y)) * o[c][4 * g + 2] * rn, silu1(bfhi(gv.y)) * o[c][4 * g + 3] * rn); }
            else { w.x = pk2(o[c][4 * g] * rn, o[c][4 * g + 1] * rn); w.y = pk2(o[c][4 * g + 2] * rn, o[c][4 * g + 3] * rn); }
            *(u32x2*)(mp + e0) = w; }
    __syncthreads();
}
struct CombIn { unsigned selw; float ls[4]; u32x2 ov[4]; };
__device__ __forceinline__ void combine_load(int idx, const bf16* OP, const float* LSE, const unsigned* SEL, CombIn& c) {
    const int ch = idx & 7, th = idx >> 3, hh = th % NHM, tok = th / NHM, b = tok >> 13, s = tok & (SEQ - 1), bh = b * NHM + hh;
    c.selw = SEL[(size_t)bh * SEQ + s];
#pragma unroll
    for (int k = 0; k < 4; ++k) { c.ls[k] = LSE[((size_t)bh * 4 + k) * SEQ + s]; c.ov[k] = *(const u32x2*)((const unsigned char*)OP + (((size_t)bh * 4 + k) * SEQ + s) * 64 + 8 * ch); }
}
__device__ __forceinline__ void combine_store(int idx, const CombIn& c, bf16* mix) {
    const int ch = idx & 7, th = idx >> 3, hh = th % NHM, tok = th / NHM;
    const int ns = __builtin_popcount(c.selw); float mx = -__builtin_inff(); float ls[4];
#pragma unroll
    for (int k = 0; k < 4; ++k) { const bool on = (k == 3) || (k < ns); ls[k] = on ? c.ls[k] : -__builtin_inff(); mx = fmaxf(mx, ls[k]); }
    float a[8], wsum = 0.f;
#pragma unroll
    for (int k = 0; k < 8; ++k) a[k] = 0.f;
#pragma unroll
    for (int k = 0; k < 4; ++k) { const bool on = (k == 3) || (k < ns); const float wg = on ? ex2(ls[k] - mx) : 0.f; wsum += wg;
        u32x2 v = c.ov[k]; if (!on) v = (u32x2){0u, 0u};
        const f32x2 p0 = __builtin_amdgcn_cvt_pk_f32_fp8((int)v.x, false), p1 = __builtin_amdgcn_cvt_pk_f32_fp8((int)v.x, true), p2 = __builtin_amdgcn_cvt_pk_f32_fp8((int)v.y, false), p3 = __builtin_amdgcn_cvt_pk_f32_fp8((int)v.y, true);
        a[0] += wg * p0[0]; a[1] += wg * p0[1]; a[2] += wg * p1[0]; a[3] += wg * p1[1]; a[4] += wg * p2[0]; a[5] += wg * p2[1]; a[6] += wg * p3[0]; a[7] += wg * p3[1]; }
    const float inv = 1.0f / wsum; u32x4 w; w.x = pk2(a[0] * inv, a[1] * inv); w.y = pk2(a[2] * inv, a[3] * inv); w.z = pk2(a[4] * inv, a[5] * inv); w.w = pk2(a[6] * inv, a[7] * inv);
    *(u32x4*)(mix + (size_t)tok * DM + X_MOBA + 64 * hh + 8 * ch) = w;
}
__device__ __forceinline__ void rgate_item2(int idx0, int idx1, const bf16* z, bf16* mix) {
    u32x4 g[2], v[2]; bf16* mp[2];
#pragma unroll
    for (int k = 0; k < 2; ++k) { const int idx = k ? idx1 : idx0, ch = idx & 7, th = idx >> 3, hh = 4 + (th & 1), tok = th >> 1;
        g[k] = *(const u32x4*)(z + (size_t)tok * ZP + Z_RG + 64 * hh + 8 * ch); mp[k] = mix + (size_t)tok * DM + X_RET + 64 * hh + 8 * ch; v[k] = *(const u32x4*)mp[k]; }
#pragma unroll
    for (int k = 0; k < 2; ++k) { if (k == 1 && idx1 == idx0) break; u32x4 w;
        w.x = pk2(silu1(bflo(g[k].x)) * bflo(v[k].x), silu1(bfhi(g[k].x)) * bfhi(v[k].x)); w.y = pk2(silu1(bflo(g[k].y)) * bflo(v[k].y), silu1(bfhi(g[k].y)) * bfhi(v[k].y));
        w.z = pk2(silu1(bflo(g[k].z)) * bflo(v[k].z), silu1(bfhi(g[k].z)) * bfhi(v[k].z)); w.w = pk2(silu1(bflo(g[k].w)) * bflo(v[k].w), silu1(bfhi(g[k].w)) * bfhi(v[k].w));
        *(u32x4*)mp[k] = w; }
}
#ifndef MK_PER_PHASE
#define MK_PER_PHASE 0
#endif
constexpr int N_PHASES = 1 + DEPTH * 8;
constexpr int T_KM = NBH * NCH / 8, T_KV = T_KM + NBH * NCH / 2, T_GT = T_KV + NBH * 16, T_SC = T_GT + NBH * 2, T_CV = T_SC + 256, T_G13 = T_CV + M / 256, MIXC_LIST = NBH * 76, T_MB = T_G13 + MIXC_LIST, T_RT = T_MB + NBH * NCH, MIXC_ITEMS = T_RT + NBH;

__global__ void __launch_bounds__(512, 2) fwd(Args args) {
    extern __shared__ __attribute__((aligned(16))) unsigned char lds_raw[];
    LAS unsigned char* lds = (LAS unsigned char*)lds_raw;
    volatile LAS unsigned* MISC = (volatile LAS unsigned*)(lds + MISC_OFF);
    const int tid0 = threadIdx.x, wave0 = __builtin_amdgcn_readfirstlane(tid0 >> 6);
    const int G = gridDim.x, bid = blockIdx.x, NGW = G * 8;
    unsigned char* const ws0 = args.ws;
    unsigned* ctl = (unsigned*)(ws0 + WS_CTL);
    for (int u = tid0; u < (LDS_BYTES - LDSCTL_OFF) / 4; u += 512) ((LAS unsigned*)(lds + LDSCTL_OFF))[u] = 0u;
    __syncthreads();
    XcdBarrier bar; bar.bar = ctl + CW_BAR; bar.x = 0; bar.st = nullptr;
    if (!MK_PER_PHASE) bar = xcd_barrier_post(ctl + CW_BAR, MISC + 8);
    if (tid0 == 0) __hip_atomic_store(ctl + CW_XT + bid, xb_xcc_id() + 1u, __ATOMIC_RELAXED, __HIP_MEMORY_SCOPE_AGENT);
    int lok = 0;
    const int lo = args.ph_lo, hi = args.ph_hi; int pc = 0;
#define RUN (pc >= lo && pc < hi)
#define SEAM do { ++pc; if (!MK_PER_PHASE && pc > lo && pc < hi) xcd_barrier(bar); } while (0)
#define SEAM_LOCAL do { ++pc; if (!MK_PER_PHASE && pc > lo && pc < hi) { if (lok) xcd_local_barrier(ctl + CW_LB, bar.x, 32u, ctl + CW_TMO); else xcd_barrier(bar); } } while (0)

#define ENV unsigned sd_ = 0u; asm volatile("" : "+s"(sd_)); int tid = wave0 * 64 + (int)__builtin_amdgcn_mbcnt_hi(~0u, __builtin_amdgcn_mbcnt_lo(~0u, sd_)); asm volatile("" : "+v"(tid)); const int lane = tid & 63, wave = __builtin_amdgcn_readfirstlane(tid >> 6), gw = bid * 8 + wave; (void)lane; (void)gw; \
    GAS unsigned char* wsl = (GAS unsigned char*)ws0; asm volatile("" : "+s"(wsl)); unsigned char* ws = (unsigned char*)wsl; int zi = 0; asm volatile("" : "+s"(zi)); GAS float* xresl = (GAS float*)args.out; asm volatile("" : "+s"(xresl)); float* xres = (float*)xresl; \
    bf16* XB = (bf16*)(ws + WS_XB); bf16* Z = (bf16*)(ws + WS_Z); bf16* ACT = (bf16*)(ws + WS_ACT); bf16* MIX = (bf16*)(ws + WS_MIX); \
    bf16* OP = (bf16*)(ws + WS_OP); float* LSE = (float*)(ws + WS_LSE); unsigned* SEL = (unsigned*)(ws + WS_SEL); \
    float* RT = (float*)(ws + WS_RT); float* MT = (float*)(ws + WS_MT); float* SSQ = (float*)(ws + WS_SSQ); \
    float* KV = (float*)(ws + WS_KV); bf16* PREV = (bf16*)(ws + WS_PREV); float* KM = (float*)(ws + WS_KM); \
    LAS float* scr = (LAS float*)(lds + wave * 16384); (void)scr; (void)XB; (void)Z; (void)ACT; (void)MIX; (void)OP; (void)LSE; (void)SEL; (void)RT; (void)MT; (void)SSQ; (void)KV; (void)PREV; (void)KM; (void)xres
#define INP(k) ((const float*)(GAS const float*)args.in[(k) + zi])

#define CVT_PULL_L(hd, L_, blo, bhi) do { unsigned* cvh = (unsigned*)(ws + WS_CTL) + CW_Q + 64 * (hd); \
        for (;;) { __syncthreads(); if (tid == 0) MISC[1] = __hip_atomic_fetch_add(cvh, 1u, __ATOMIC_RELAXED, __HIP_MEMORY_SCOPE_AGENT); __syncthreads(); \
            const int bt = (blo) + (int)MISC[1]; if (bt >= (bhi)) break; \
            cvt_layer_batch(args, zi, (L_), ws + WS_W + (size_t)((L_) & 1) * WBUF_BYTES, bt, lds, wave, lane); } } while (0)
#define CVT_PULL(qi, blo, bhi) do { if (l + 1 < DEPTH) CVT_PULL_L(8 + 2 * l + (qi), l + 1, blo, bhi); } while (0)

    if (RUN) { ENV; const float* x_in = INP(0);
        CVT_PULL_L(14, 0, 0, b_layer(0));
        for (int m = gw; m < M; m += 2 * NGW) {
            const int m1 = (m + NGW < M) ? m + NGW : m;
            const f32x4* xr0 = (const f32x4*)(x_in + (size_t)m * DM) + lane; const f32x4* xr1 = (const f32x4*)(x_in + (size_t)m1 * DM) + lane; f32x4 v0[4], v1[4]; float s0[4], s1[4];
#pragma unroll
            for (int j = 0; j < 4; ++j) { v0[j] = xr0[64 * j]; v1[j] = xr1[64 * j]; }
#pragma unroll
            for (int j = 0; j < 4; ++j) { s0[j] = (v0[j][0] * v0[j][0] + v0[j][1] * v0[j][1]) + (v0[j][2] * v0[j][2] + v0[j][3] * v0[j][3]); s1[j] = (v1[j][0] * v1[j][0] + v1[j][1] * v1[j][1]) + (v1[j][2] * v1[j][2] + v1[j][3] * v1[j][3]); }
            float am0 = 0.f, am1 = 0.f;
#pragma unroll
            for (int j = 0; j < 4; ++j) { am0 = fmaxf(am0, fmaxf(fmaxf(fabsf(v0[j][0]), fabsf(v0[j][1])), fmaxf(fabsf(v0[j][2]), fabsf(v0[j][3])))); am1 = fmaxf(am1, fmaxf(fmaxf(fabsf(v1[j][0]), fabsf(v1[j][1])), fmaxf(fabsf(v1[j][2]), fabsf(v1[j][3])))); }
#pragma unroll
            for (int o = 1; o < 64; o <<= 1) {
#pragma unroll
                for (int j = 0; j < 4; ++j) { s0[j] += __shfl_xor(s0[j], o); s1[j] += __shfl_xor(s1[j], o); }
                am0 = fmaxf(am0, __shfl_xor(am0, o)); am1 = fmaxf(am1, __shfl_xor(am1, o)); }
            unsigned long long* o0 = (unsigned long long*)(XB + (size_t)m * DM) + lane; unsigned long long* o1 = (unsigned long long*)(XB + (size_t)m1 * DM) + lane;
#pragma unroll
            for (int j = 0; j < 4; ++j) { o0[64 * j] = (unsigned long long)pk2(v0[j][0], v0[j][1]) | ((unsigned long long)pk2(v0[j][2], v0[j][3]) << 32); o1[64 * j] = (unsigned long long)pk2(v1[j][0], v1[j][1]) | ((unsigned long long)pk2(v1[j][2], v1[j][3]) << 32); }
            { const float iv0 = am0 > 0.f ? 127.0f / am0 : 0.f, iv1 = am1 > 0.f ? 127.0f / am1 : 0.f; unsigned* q0 = (unsigned*)(ws + WS_X8 + (size_t)m * DM) + lane; unsigned* q1 = (unsigned*)(ws + WS_X8 + (size_t)m1 * DM) + lane;
#pragma unroll
              for (int j = 0; j < 4; ++j) { q0[64 * j] = pg8::q8x4(v0[j][0], v0[j][1], v0[j][2], v0[j][3], iv0); q1[64 * j] = pg8::q8x4(v1[j][0], v1[j][1], v1[j][2], v1[j][3], iv1); } }
            if (lane == 0) { *(f32x4*)(SSQ + (size_t)m * 4) = (f32x4){s0[0], s0[1], s0[2], s0[3]}; *(f32x4*)(SSQ + (size_t)m1 * 4) = (f32x4){s1[0], s1[1], s1[2], s1[3]};
                float* RF = (float*)(ws + WS_RF); RF[m] = __builtin_amdgcn_rsqf(((s0[0] + s0[1]) + (s0[2] + s0[3])) * (1.0f / 1024.0f) + RMS_EPS) * am0 * (1.0f / 127.0f); RF[m1] = __builtin_amdgcn_rsqf(((s1[0] + s1[1]) + (s1[2] + s1[3])) * (1.0f / 1024.0f) + RMS_EPS) * am1 * (1.0f / 127.0f); } }
        const int* pos = (const int*)INP(1);
        for (int i = bid * 512 + tid; i < M * 40; i += G * 512) { const int row = i / 40, k = i - row * 40; float c, s; sincos_acc((float)pos[row] * args.invf[k], c, s);
            float* t = (k < 32) ? RT + (size_t)row * 64 + 2 * k : MT + (size_t)row * 16 + 2 * (k - 32); *(f32x2*)t = (f32x2){c, s}; }
    }
    SEAM;
    if (!MK_PER_PHASE && lo == 0 && hi > 1) {
        int ok = (G == 256);
        if (tid0 < G) { const unsigned v = __hip_atomic_load(ctl + CW_XT + tid0, __ATOMIC_RELAXED, __HIP_MEMORY_SCOPE_AGENT), r = __hip_atomic_load(ctl + CW_XT + (tid0 & 7), __ATOMIC_RELAXED, __HIP_MEMORY_SCOPE_AGENT); ok &= (v == r) && (v != 0u); }
        unsigned seen = 0u;
#pragma unroll
        for (int q = 0; q < 8; ++q) seen |= 1u << (__hip_atomic_load(ctl + CW_XT + q, __ATOMIC_RELAXED, __HIP_MEMORY_SCOPE_AGENT) & 31u);
        ok &= (__builtin_popcount(seen) == 8);
        lok = __syncthreads_and(ok);
    }

    for (int l = 0; l < DEPTH; ++l) {
        for (int hf = 0; hf < 2; ++hf) {
            if (RUN) { ENV; unsigned char* wb = ws + WS_W + (size_t)(l & 1) * WBUF_BYTES; unsigned char* wgu = wb + (hf ? WO_GU2 : WO_GU1);
                pg8::Gemm g{(const bf16*)(ws + WS_X8), (const bf16*)wgu, M, NGU, DM / 2}; pg8::StaticOrder S; S.init(M, NGU, G, bid);
                pg8::EpiGU8 E{ACT, (const LAS float*)(lds + LDSCTL_OFF + 1024), (const LAS float*)(lds + LDSCTL_OFF + 7168)};
                { LAS float* rt_ = (LAS float*)(lds + LDSCTL_OFF + 1024); LAS float* ct_ = (LAS float*)(lds + LDSCTL_OFF + 7168); const float* RF = (const float*)(ws + WS_RF); const float* SWt = (const float*)(wgu + WO_SW);
                  pg8::Unit u_; for (int i_ = 0; S.next(i_, u_); ++i_) if (tid < 256) { rt_[i_ * 256 + tid] = RF[u_.pm * 256 + tid]; ct_[i_ * 256 + tid] = SWt[u_.pn * 256 + tid]; } __syncthreads(); }
                pg8::gemm_phase<pg8::EpiGU8, pg8::StaticOrder, true, true, true>(lds, g, S, E, tid);
                if (hf == 0) CVT_PULL(0, 0, b_early(l + 1)); else CVT_PULL(1, b_early(l + 1), b_layer(l + 1)); }
            SEAM_LOCAL;
            if (RUN) { ENV; unsigned char* wb = ws + WS_W + (size_t)(l & 1) * WBUF_BYTES; pg8::Gemm g{ACT, (const bf16*)(wb + (hf ? WO_D2 : WO_D1)), M, DM, FF}; pg8::StaticOrder S; S.init(M, DM, G, bid);
                const bool q8_ = hf == 1 && l + 1 < DEPTH, fin_ = hf == 1 && l + 1 == DEPTH;
                pg8::EpiRes E{XB, SSQ, 0.5f, 2.0f, (q8_ || (hf == 0 && l >= WIN8_FROM)) ? (signed char*)(ws + WS_X8) : nullptr, (float*)(ws + WS_RF), (float*)(ws + WS_EX), (unsigned*)(ws + WS_CTL) + CW_PC + 16 * 64 * (3 * l + (hf ? 2 : 0)), (unsigned*)(ws + WS_CTL) + CW_TMO, fin_ ? xres : nullptr, INP(17)};
                pg8::gemm_phase<pg8::EpiRes, pg8::StaticOrder, false, true>(lds, g, S, E, tid); }
            SEAM_LOCAL;
            if (hf == 0) {
                if (RUN && l < WIN8_FROM) { ENV; unsigned char* wb = ws + WS_W + (size_t)(l & 1) * WBUF_BYTES; pg8::Gemm g{XB, (const bf16*)(wb + WO_IN), M, ZN1, DM}; pg8::StaticOrder S; S.init(M, ZN1, G, bid);
                    pg8::EpiWin E{Z, (const LAS float*)(lds + LDSCTL_OFF + 1024), RT, MT};
                    { LAS float* rt_ = (LAS float*)(lds + LDSCTL_OFF + 1024); pg8::Unit u_; for (int i_ = 0; S.next(i_, u_); ++i_) if (tid < 256) rt_[i_ * 256 + tid] = pg8::row_rstd(SSQ, u_.pm * 256 + tid); __syncthreads(); }
                pg8::gemm_phase<pg8::EpiWin, pg8::StaticOrder, true, true>(lds, g, S, E, tid); }
                if (RUN && l >= WIN8_FROM) { ENV; unsigned char* wb = ws + WS_W + (size_t)(l & 1) * WBUF_BYTES; pg8::Gemm g{(const bf16*)(ws + WS_X8), (const bf16*)(wb + WO_IN8), M, ZN1, DM / 2}; pg8::StaticOrder S; S.init(M, ZN1, G, bid);
                    pg8::EpiWin8 E{Z, (const LAS float*)(lds + LDSCTL_OFF + 1024), RT, MT, (const LAS float*)(lds + LDSCTL_OFF + 7168)};
                    { LAS float* rt_ = (LAS float*)(lds + LDSCTL_OFF + 1024); LAS float* ct_ = (LAS float*)(lds + LDSCTL_OFF + 7168); const float* RF = (const float*)(ws + WS_RF); const float* SWt = (const float*)(wb + WO_SWIN);
                      pg8::Unit u_; for (int i_ = 0; S.next(i_, u_); ++i_) if (tid < 256) { rt_[i_ * 256 + tid] = RF[u_.pm * 256 + tid]; ct_[i_ * 256 + tid] = SWt[u_.pn * 256 + tid]; } __syncthreads(); }
                pg8::gemm_phase<pg8::EpiWin8, pg8::StaticOrder, true, true, true>(lds, g, S, E, tid); }
                SEAM;
                if (RUN) { ENV;
                    unsigned* head = (unsigned*)(ws + WS_CTL) + CW_Q + 64 * l;
                    unsigned nxt = (unsigned)bid;
                    for (;;) {
                        __syncthreads();
                        if (tid == 0) MISC[0] = nxt;
                        __syncthreads();
                        int it = (int)MISC[0];
                        if (it >= MIXC_ITEMS) break;
                        int tq = tid; asm volatile("" : "+v"(tq)); const int lq = tq & 63;
                        if (tid == 0) nxt = (unsigned)G + __hip_atomic_fetch_add(head, 1u, __ATOMIC_RELAXED, __HIP_MEMORY_SCOPE_AGENT);
                        unsigned* hc = (unsigned*)(ws + WS_CTL) + CW_HC + 64 * 16 * 4 * l; unsigned* kmc = hc, * kvc = hc + 64 * 16, * gtc = hc + 64 * 32, * scc = hc + 64 * 48; unsigned* tmo = (unsigned*)(ws + WS_CTL) + CW_TMO;
                        if (it < T_KM) kmean_item(it, Z, KM, kmc, lds, wave, lq);
                        else if (it < T_KV) kv_item(it - T_KM, Z, KV, kvc, lds, tq, wave, lq);
                        else if (it < T_GT) gate_item(it - T_KV, Z, KM, SEL, kmc, gtc, tmo, lds, tq, lq);
                        else if (it < T_SC) scan_item(it - T_GT, KV, PREV, kvc, scc, tmo, tq, lq);
                        else if (it < T_CV) conv_item(it - T_SC, Z, MIX, INP(8) + (size_t)l * 31 * 256, INP(9) + l * 256, INP(10) + l * 256, INP(11) + l * 256, lds, tq, wave, lq);
                        else if (it < T_G13) {
                            const int pm_ = it - T_CV;
                            if (l < WIN8_FROM) {
                            unsigned char* wb = ws + WS_W + (size_t)(l & 1) * WBUF_BYTES; pg8::Gemm g{XB, (const bf16*)(wb + WO_IN), M, ZNP, DM}; pg8::OneUnit S{pm_, ZN1 / 256};
                            pg8::EpiWin E{Z, (const LAS float*)(lds + LDSCTL_OFF + 1024), RT, MT};
                            { LAS float* rt_ = (LAS float*)(lds + LDSCTL_OFF + 1024); if (tq < 256) rt_[tq] = pg8::row_rstd(SSQ, pm_ * 256 + tq); __syncthreads(); }
                            pg8::gemm_phase<pg8::EpiWin, pg8::OneUnit, false, true>(lds, g, S, E, tq); }
                            else {
                            unsigned char* wb = ws + WS_W + (size_t)(l & 1) * WBUF_BYTES; pg8::Gemm g{(const bf16*)(ws + WS_X8), (const bf16*)(wb + WO_IN8), M, ZNP, DM / 2}; pg8::OneUnit S{pm_, ZN1 / 256};
                            pg8::EpiWin8 E{Z, (const LAS float*)(lds + LDSCTL_OFF + 1024), RT, MT, (const LAS float*)(lds + LDSCTL_OFF + 7168)};
                            { LAS float* rt_ = (LAS float*)(lds + LDSCTL_OFF + 1024); LAS float* ct_ = (LAS float*)(lds + LDSCTL_OFF + 7168);
                              if (tq < 256) { rt_[tq] = ((const float*)(ws + WS_RF))[pm_ * 256 + tq]; ct_[tq] = ((const float*)(wb + WO_SWIN))[ZN1 + tq]; } __syncthreads(); }
                            pg8::gemm_phase<pg8::EpiWin8, pg8::OneUnit, false, true, true>(lds, g, S, E, tq); } }
                        else if (it >= T_MB && it < T_RT) ret_item(it - T_MB, Z, PREV, MIX, scc, tmo, lds, tq, wave, lq);
                        else { int bh, j, i0, i1; bool own;
                            if (it < T_MB) { const int rank = (it - T_G13) / NBH; bh = (it - T_G13) - rank * NBH; i0 = 1; int rem = rank;
                                while (rem >= ((i0 - 1) >> 3) + 1) { rem -= ((i0 - 1) >> 3) + 1; ++i0; }
                                j = i0 - 1 - 8 * rem; i1 = (i0 + 8 < NCH) ? i0 + 8 : NCH; own = rem == 0; }
                            else { bh = it - T_RT; j = NCH - 1; i0 = NCH; i1 = NCH; own = true; }
                            moba_item(bh, j, own, i0, i1, Z, SEL, OP, LSE, gtc, tmo, lds, tq, wave, lq); }
                    }
                }
                SEAM;
                if (RUN) { ENV; { constexpr int NCMB = M * NHM * 8; const int st_ = G * 512;
                    for (int i = bid * 512 + tid; i < NCMB; i += 3 * st_) { CombIn c0, c1, c2; const int i1 = (i + st_ < NCMB) ? i + st_ : i, i2 = (i + 2 * st_ < NCMB) ? i + 2 * st_ : i;
                        combine_load(i, OP, LSE, SEL, c0); combine_load(i1, OP, LSE, SEL, c1); combine_load(i2, OP, LSE, SEL, c2);
                        combine_store(i, c0, MIX); combine_store(i1, c1, MIX); combine_store(i2, c2, MIX); } }
                    { constexpr int NRG = M * 2 * 8; const int st_ = G * 512; for (int i = bid * 512 + tid; i < NRG; i += 2 * st_) rgate_item2(i, (i + st_ < NRG) ? i + st_ : i, Z, MIX); } }
                SEAM;
                if (RUN) { ENV; unsigned char* wb = ws + WS_W + (size_t)(l & 1) * WBUF_BYTES; pg8::Gemm g{MIX, (const bf16*)(wb + WO_OUT), M, DM, DM}; pg8::StaticOrder S; S.init(M, DM, G, bid);
                    pg8::EpiRes E{XB, SSQ, 1.0f, 1.0f, (signed char*)(ws + WS_X8), (float*)(ws + WS_RF), (float*)(ws + WS_EX), (unsigned*)(ws + WS_CTL) + CW_PC + 16 * 64 * (3 * l + 1), (unsigned*)(ws + WS_CTL) + CW_TMO, nullptr, nullptr};
                    pg8::gemm_phase<pg8::EpiRes, pg8::StaticOrder, false, true>(lds, g, S, E, tid); }
                SEAM_LOCAL;
            }
        }
    }
#undef RUN
#undef SEAM
}

extern "C" void kernel_launch(void* const* d_in, const int* in_sizes, int n_in, void* d_out, int out_size, void* d_ws, size_t ws_size, hipStream_t stream) {
    static int grid = 0;
    if (grid == 0) {
        if (n_in != 18 || in_sizes[0] != M * DM || out_size != M * DM || ws_size < WS_END) { fprintf(stderr, "kernel_launch: unexpected problem shape (n_in %d, in0 %d, out %d, ws %zu); nothing launched\n", n_in, n_in > 0 ? in_sizes[0] : -1, out_size, ws_size); grid = -1; return; }
        int dev = 0, cus = 0, per_cu = 0;
        if (hipGetDevice(&dev) != hipSuccess || hipDeviceGetAttribute(&cus, hipDeviceAttributeMultiprocessorCount, dev) != hipSuccess) { grid = -1; return; }
        if (hipFuncSetAttribute((const void*)fwd, hipFuncAttributeMaxDynamicSharedMemorySize, LDS_BYTES) != hipSuccess) { fprintf(stderr, "kernel_launch: hipFuncSetAttribute failed\n"); grid = -1; return; }
        if (hipOccupancyMaxActiveBlocksPerMultiprocessor(&per_cu, (const void*)fwd, 512, LDS_BYTES) != hipSuccess || per_cu < 1) { fprintf(stderr, "kernel_launch: occupancy query reports %d blocks per CU\n", per_cu); }
        (void)hipGetLastError();
        grid = cus;
        if (grid != 256) fprintf(stderr, "kernel_launch: %d CUs; the N = 1024 GEMM phases assume a 256-workgroup grid\n", grid);
        if (grid > 256) grid = 256;
    }
    if (grid < 0) return;
    if (hipMemsetAsync((char*)d_ws + WS_CTL, 0, CTL_BYTES, stream) != hipSuccess) return;
    Args a{};
    for (int i = 0; i < 18; ++i) a.in[i] = (const float*)d_in[i];
    a.out = (float*)d_out; a.ws = (unsigned char*)d_ws;
    for (int i = 0; i < 32; ++i) { const float t = (float)i / 31.0f; a.invf[i] = (float)pow(10000.0, -(double)t); }
    for (int i = 0; i < 8; ++i) { const float t = (float)i / 8.0f; a.invf[32 + i] = (float)pow(500000.0, -(double)t); }
#if MK_PER_PHASE
    for (int p = 0; p < N_PHASES; ++p) { a.ph_lo = p; a.ph_hi = p + 1; hipLaunchKernelGGL(fwd, dim3(grid), dim3(512), LDS_BYTES, stream, a); }
#else
    a.ph_lo = 0; a.ph_hi = N_PHASES;
    hipLaunchKernelGGL(fwd, dim3(grid), dim3(512), LDS_BYTES, stream, a);
#endif
}
```

```cpp
#include <hip/hip_runtime.h>
#include <cstdio>
#include <cstdint>
#include <cmath>

constexpr int BATCH = 2, SEQ = 8192, DM = 1024, DEPTH = 4, HD = 64, NHM = 6;
constexpr int M = BATCH * SEQ, FF = 2816, NGU = 2 * FF, ZN = 3200, ZNP = 3328, ZP = ZNP, NCH = SEQ / 256, NBH = BATCH * NHM;
constexpr float RMS_EPS = 1e-6f;
constexpr float C2 = 0.125f * 1.4426950408889634f;
constexpr int Z_RQ = 0, Z_RK = 384, Z_MQ = 768, Z_MK = 1152, Z_RV = 1536, Z_MV = 1920, Z_CA = 2304, Z_CG = 2560, Z_RG = 2816;
constexpr int ZN1 = 3072;
constexpr int X_RET = 0, X_MOBA = 384, X_CONV = 768;

namespace pg8 {
#define PG8_LAS __attribute__((address_space(3)))
typedef unsigned short bf16_t;
typedef short bf16x8 __attribute__((ext_vector_type(8)));
typedef float f32x4 __attribute__((ext_vector_type(4)));
typedef unsigned u32x4 __attribute__((ext_vector_type(4)));
constexpr int BM = 256, BK = 64, HALF = 128, HTB = HALF * BK * 2  , STAGE_BYTES = 8 * HTB, NXCD = 8, WGM = 8;

__host__ __device__ __forceinline__ int lds_byte(int r, int c) { const int st = (r >> 4) * 2 + (c >> 5), rr = r & 15, cc = c & 31, ob = rr * 64 + cc * 2; return st * 1024 + (ob ^ (((ob >> 9) & 1) << 5)); }
__host__ __device__ __forceinline__ void stage_rc(int b, int& R, int& C) { const int st = b / 1024, sb = b % 1024, swz = sb ^ (((sb >> 9) & 1) << 5); R = (st >> 1) * 16 + swz / 64; C = (st & 1) * 32 + (swz % 64) / 2; }
__host__ __device__ __forceinline__ int perm32(int rho) { const int n = rho >> 4, i = rho & 15; return 8 * (i >> 2) + 4 * n + (i & 3); }

struct Unit { int pm, pn, ord; };
struct Gemm { const bf16_t* A; const bf16_t* Bt; int M, N, K; };

struct StaticOrder {
    int nM, nN, nwg, G, c;
    __host__ __device__ __forceinline__ void init(int M, int N, int G_, int c_) { nM = M / BM; nN = N / BM; nwg = nM * nN; G = G_; c = c_; }
    __host__ __device__ __forceinline__ bool next(int i, Unit& u) const {
        const long L = (long)i * G + c; if (L >= nwg) return false;
        int wgid = (int)L; { const int q = nwg / NXCD, r = nwg % NXCD, xcd = wgid % NXCD, off = wgid / NXCD; wgid = (xcd < r ? xcd * (q + 1) : r * (q + 1) + (xcd - r) * q) + off; }
        const int nig = WGM * nN, gid = wgid / nig, fm = gid * WGM, gsz = (nM - fm) < WGM ? (nM - fm) : WGM;
        u.pm = fm + ((wgid % nig) % gsz); u.pn = (wgid % nig) / gsz; u.ord = i; return true;
    }
    __device__ __forceinline__ void a_ready(const Unit&) const {}
    __device__ __forceinline__ void done(const Unit&) const {}
};

struct OneUnit { int pm, pn;
    __device__ __forceinline__ bool next(int i, Unit& u) const { if (i) return false; u.pm = pm; u.pn = pn; u.ord = 0; return true; }
    __device__ __forceinline__ void a_ready(const Unit&) const {}
    __device__ __forceinline__ void done(const Unit&) const {} };
__device__ __forceinline__ unsigned cvt_pk_bf16(float lo, float hi) { unsigned r; asm volatile("v_cvt_pk_bf16_f32 %0, %1, %2" : "=v"(r) : "v"(lo), "v"(hi)); return r; }
typedef float f32x2 __attribute__((ext_vector_type(2)));
typedef unsigned u32x2 __attribute__((ext_vector_type(2)));
typedef __bf16 bf16x2v __attribute__((ext_vector_type(2)));
__device__ __forceinline__ unsigned pkb(float lo, float hi) { const f32x2 v = {lo, hi}; const bf16x2v b = __builtin_convertvector(v, bf16x2v); return __builtin_bit_cast(unsigned, b); }
__device__ __forceinline__ float silu_f(float x) { return x * __builtin_amdgcn_rcpf(1.0f + __builtin_amdgcn_exp2f(-1.4426950408889634f * x)); }
__device__ __forceinline__ float row_rstd(const float* ssq, int row) { const f32x4 s = *(const f32x4*)(ssq + (size_t)row * 4); return __builtin_amdgcn_rsqf(((s[0] + s[1]) + (s[2] + s[3])) * (1.0f / 1024.0f) + RMS_EPS); }
struct EpiGU {
    static constexpr bool PERM = true, AFTER_DRAIN = false;
    bf16_t* act; const PG8_LAS float* rstab;
    __device__ __forceinline__ void operator()(const f32x4 (&acc)[2][2][4][2], const Unit& u, int wr, int wc, int fr, int fq) const {
        const int row0 = u.pm * BM + wr * 64 + fr, col0 = u.pn * HALF + wc * 32 + 8 * fq; const PG8_LAS float* T = rstab + u.ord * 256 + wr * 64 + fr;
#pragma unroll
        for (int ai = 0; ai < 2; ++ai)
#pragma unroll
            for (int m = 0; m < 4; ++m) { const int row = row0 + ai * HALF + m * 16; const float rs = T[ai * HALF + m * 16];
                const f32x4 g0 = acc[ai][0][m][0] * rs, g1 = acc[ai][0][m][1] * rs, u0 = acc[ai][1][m][0] * rs, u1 = acc[ai][1][m][1] * rs;
                u32x4 w; w.x = pkb(silu_f(g0[0]) * u0[0], silu_f(g0[1]) * u0[1]); w.y = pkb(silu_f(g0[2]) * u0[2], silu_f(g0[3]) * u0[3]);
                w.z = pkb(silu_f(g1[0]) * u1[0], silu_f(g1[1]) * u1[1]); w.w = pkb(silu_f(g1[2]) * u1[2], silu_f(g1[3]) * u1[3]);
                *(u32x4*)(act + (size_t)row * FF + col0) = w; }
    }
};
typedef int i32x4e __attribute__((ext_vector_type(4)));
__device__ __forceinline__ f32x4 cvt_i4(const f32x4 a) { const i32x4e v = __builtin_bit_cast(i32x4e, a); return __builtin_convertvector(v, f32x4); }
struct EpiGU8 {
    static constexpr bool PERM = true, AFTER_DRAIN = false;
    bf16_t* act; const PG8_LAS float* rstab; const PG8_LAS float* ctab;
    __device__ __forceinline__ void operator()(const f32x4 (&acc)[2][2][4][2], const Unit& u, int wr, int wc, int fr, int fq) const {
        const int row0 = u.pm * BM + wr * 64 + fr, col0 = u.pn * HALF + wc * 32 + 8 * fq; const PG8_LAS float* T = rstab + u.ord * 256 + wr * 64 + fr;
        const PG8_LAS float* C = ctab + u.ord * 256 + wc * 32 + 8 * fq;
        const f32x4 sg0 = *(const PG8_LAS f32x4*)C, sg1 = *(const PG8_LAS f32x4*)(C + 4), su0 = *(const PG8_LAS f32x4*)(C + HALF), su1 = *(const PG8_LAS f32x4*)(C + HALF + 4);
#pragma unroll
        for (int ai = 0; ai < 2; ++ai)
#pragma unroll
            for (int m = 0; m < 4; ++m) { const int row = row0 + ai * HALF + m * 16; const float rs = T[ai * HALF + m * 16];
                const f32x4 g0 = cvt_i4(acc[ai][0][m][0]) * (sg0 * rs), g1 = cvt_i4(acc[ai][0][m][1]) * (sg1 * rs), u0 = cvt_i4(acc[ai][1][m][0]) * (su0 * rs), u1 = cvt_i4(acc[ai][1][m][1]) * (su1 * rs);
                u32x4 w; w.x = pkb(silu_f(g0[0]) * u0[0], silu_f(g0[1]) * u0[1]); w.y = pkb(silu_f(g0[2]) * u0[2], silu_f(g0[3]) * u0[3]);
                w.z = pkb(silu_f(g1[0]) * u1[0], silu_f(g1[1]) * u1[1]); w.w = pkb(silu_f(g1[2]) * u1[2], silu_f(g1[3]) * u1[3]);
                *(u32x4*)(act + (size_t)row * FF + col0) = w; }
    }
};
struct EpiWin {
    static constexpr bool PERM = true, AFTER_DRAIN = false;
    bf16_t* z; const PG8_LAS float* rstab; const float* RT; const float* MT;
    __device__ __forceinline__ void operator()(const f32x4 (&acc)[2][2][4][2], const Unit& u, int wr, int wc, int fr, int fq) const {
        const int row0 = u.pm * BM + wr * 64 + fr; const PG8_LAS float* T = rstab + u.ord * 256 + wr * 64 + fr;
        const int hc = (wc * 32 + 8 * fq) & 63;
        const bool rot_tile = u.pn < 6, use = (u.pn < 3) || (hc < 16);
        const float* tbase = (u.pn < 3) ? RT + hc : MT + (hc & 8); const int tpitch = (u.pn < 3) ? 64 : 16;
#pragma unroll
        for (int ai = 0; ai < 2; ++ai) {
            f32x4 t0[4], t1[4];
#pragma unroll
            for (int m = 0; m < 4; ++m) { t0[m] = (f32x4){1.f, 0.f, 1.f, 0.f}; t1[m] = t0[m]; }
            if (rot_tile) {
#pragma unroll
                for (int m = 0; m < 4; ++m) { const float* tb = tbase + (size_t)(row0 + ai * HALF + m * 16) * tpitch; t0[m] = *(const f32x4*)tb; t1[m] = *(const f32x4*)(tb + 4); }
#pragma unroll
                for (int m = 0; m < 4; ++m) { asm volatile("" : "+v"(t0[m]), "+v"(t1[m]));
                    t0[m] = use ? t0[m] : (f32x4){1.f, 0.f, 1.f, 0.f}; t1[m] = use ? t1[m] : (f32x4){1.f, 0.f, 1.f, 0.f}; } }
#pragma unroll
            for (int m = 0; m < 4; ++m) { const int row = row0 + ai * HALF + m * 16; const float rs = T[ai * HALF + m * 16];
#pragma unroll
                for (int bj = 0; bj < 2; ++bj) { const int colb = (2 * u.pn + bj) * HALF + wc * 32 + 8 * fq;
                    const f32x4 a = acc[ai][bj][m][0] * rs, b = acc[ai][bj][m][1] * rs; const f32x4 c0 = t0[m], c1 = t1[m]; f32x4 v0, v1;
                    v0[0] = a[0] * c0[0] - a[1] * c0[1]; v0[1] = a[1] * c0[0] + a[0] * c0[1]; v0[2] = a[2] * c0[2] - a[3] * c0[3]; v0[3] = a[3] * c0[2] + a[2] * c0[3];
                    v1[0] = b[0] * c1[0] - b[1] * c1[1]; v1[1] = b[1] * c1[0] + b[0] * c1[1]; v1[2] = b[2] * c1[2] - b[3] * c1[3]; v1[3] = b[3] * c1[2] + b[2] * c1[3];
                    u32x4 w; w.x = pkb(v0[0], v0[1]); w.y = pkb(v0[2], v0[3]); w.z = pkb(v1[0], v1[1]); w.w = pkb(v1[2], v1[3]);
                    *(u32x4*)(z + (size_t)row * ZP + colb) = w; } } }
    }
};
struct EpiWin8 {
    static constexpr bool PERM = true, AFTER_DRAIN = false;
    bf16_t* z; const PG8_LAS float* rstab; const float* RT; const float* MT; const PG8_LAS float* ctab;
    __device__ __forceinline__ void operator()(const f32x4 (&acc)[2][2][4][2], const Unit& u, int wr, int wc, int fr, int fq) const {
        const int row0 = u.pm * BM + wr * 64 + fr; const PG8_LAS float* T = rstab + u.ord * 256 + wr * 64 + fr;
        const int hc = (wc * 32 + 8 * fq) & 63;
        const bool rot_tile = u.pn < 6, use = (u.pn < 3) || (hc < 16);
        const float* tbase = (u.pn < 3) ? RT + hc : MT + (hc & 8); const int tpitch = (u.pn < 3) ? 64 : 16;
#pragma unroll
        for (int ai = 0; ai < 2; ++ai) {
            f32x4 t0[4], t1[4];
#pragma unroll
            for (int m = 0; m < 4; ++m) { t0[m] = (f32x4){1.f, 0.f, 1.f, 0.f}; t1[m] = t0[m]; }
            if (rot_tile) {
#pragma unroll
                for (int m = 0; m < 4; ++m) { const float* tb = tbase + (size_t)(row0 + ai * HALF + m * 16) * tpitch; t0[m] = *(const f32x4*)tb; t1[m] = *(const f32x4*)(tb + 4); }
#pragma unroll
                for (int m = 0; m < 4; ++m) { asm volatile("" : "+v"(t0[m]), "+v"(t1[m]));
                    t0[m] = use ? t0[m] : (f32x4){1.f, 0.f, 1.f, 0.f}; t1[m] = use ? t1[m] : (f32x4){1.f, 0.f, 1.f, 0.f}; } }
#pragma unroll
            for (int m = 0; m < 4; ++m) { const int row = row0 + ai * HALF + m * 16; const float rs = T[ai * HALF + m * 16];
#pragma unroll
                for (int bj = 0; bj < 2; ++bj) { const int colb = (2 * u.pn + bj) * HALF + wc * 32 + 8 * fq; const PG8_LAS float* C = ctab + u.ord * 256 + bj * HALF + wc * 32 + 8 * fq;
                    const f32x4 a = cvt_i4(acc[ai][bj][m][0]) * (*(const PG8_LAS f32x4*)C * rs), b = cvt_i4(acc[ai][bj][m][1]) * (*(const PG8_LAS f32x4*)(C + 4) * rs); const f32x4 c0 = t0[m], c1 = t1[m]; f32x4 v0, v1;
                    v0[0] = a[0] * c0[0] - a[1] * c0[1]; v0[1] = a[1] * c0[0] + a[0] * c0[1]; v0[2] = a[2] * c0[2] - a[3] * c0[3]; v0[3] = a[3] * c0[2] + a[2] * c0[3];
                    v1[0] = b[0] * c1[0] - b[1] * c1[1]; v1[1] = b[1] * c1[0] + b[0] * c1[1]; v1[2] = b[2] * c1[2] - b[3] * c1[3]; v1[3] = b[3] * c1[2] + b[2] * c1[3];
                    u32x4 w; w.x = pkb(v0[0], v0[1]); w.y = pkb(v0[2], v0[3]); w.z = pkb(v1[0], v1[1]); w.w = pkb(v1[2], v1[3]);
                    *(u32x4*)(z + (size_t)row * ZP + colb) = w; } } }
    }
};
__device__ __forceinline__ unsigned q8x4(float a, float b, float c, float d, float inv) {
    const float M_ = 12582912.0f; const unsigned ya = __float_as_uint(__builtin_fmaf(a, inv, M_)), yb = __float_as_uint(__builtin_fmaf(b, inv, M_)), yc = __float_as_uint(__builtin_fmaf(c, inv, M_)), yd = __float_as_uint(__builtin_fmaf(d, inv, M_));
    return __builtin_amdgcn_perm(yb, ya, 0x0c0c0400u) | __builtin_amdgcn_perm(yd, yc, 0x04000c0cu);
}
struct EpiRes {
    static constexpr bool PERM = true, AFTER_DRAIN = true;
    bf16_t* xb; float* ssq; float alpha, ralpha;
    signed char* x8; float* rf; float* ex; unsigned* pctr; unsigned* tmo; float* fout; const float* fgain;
    __device__ __forceinline__ void init(f32x4 (&acc)[2][2][4][2], const Unit& u, int wr, int wc, int fr, int fq) const {
        const int col0 = u.pn * BM + wc * 32 + 8 * fq;
#pragma unroll
        for (int ai = 0; ai < 2; ++ai)
#pragma unroll
            for (int m = 0; m < 4; ++m)
#pragma unroll
                for (int bj = 0; bj < 2; ++bj) { const u32x4 x4 = *(const u32x4*)(xb + (size_t)(u.pm * BM + ai * HALF + wr * 64 + m * 16 + fr) * DM + col0 + bj * HALF);
                    acc[ai][bj][m][0] = (f32x4){__uint_as_float(x4.x << 16), __uint_as_float(x4.x & 0xffff0000u), __uint_as_float(x4.y << 16), __uint_as_float(x4.y & 0xffff0000u)} * ralpha;
                    acc[ai][bj][m][1] = (f32x4){__uint_as_float(x4.z << 16), __uint_as_float(x4.z & 0xffff0000u), __uint_as_float(x4.w << 16), __uint_as_float(x4.w & 0xffff0000u)} * ralpha; }
    }
    __device__ __forceinline__ void fused(f32x4 (&acc)[2][2][4][2], const Unit& u, int wr, int wc, int fr, int fq, PG8_LAS unsigned char* lds, int wid, int lane) const {
        PG8_LAS float* P = (PG8_LAS float*)lds;
        PG8_LAS float* Q = P + 1024; PG8_LAS float* IV = P + 2048;
        const bool fin = fout != nullptr, q8 = x8 != nullptr || fin; unsigned* const pc = pctr + 16 * u.pm;
        const int col0 = u.pn * BM + wc * 32 + 8 * fq;
#pragma unroll
        for (int ai = 0; ai < 2; ++ai)
#pragma unroll
            for (int m = 0; m < 4; ++m) { const int r = ai * HALF + wr * 64 + m * 16 + fr; bf16_t* xp = xb + (size_t)(u.pm * BM + r) * DM + col0; float ss = 0.f, am = 0.f;
#pragma unroll
                for (int bj = 0; bj < 2; ++bj) { const f32x4 a0 = acc[ai][bj][m][0] * alpha, a1 = acc[ai][bj][m][1] * alpha;
                    ss += ((a0[0] * a0[0] + a0[1] * a0[1]) + (a0[2] * a0[2] + a0[3] * a0[3])) + ((a1[0] * a1[0] + a1[1] * a1[1]) + (a1[2] * a1[2] + a1[3] * a1[3]));
                    am = fmaxf(am, fmaxf(fmaxf(fmaxf(fabsf(a0[0]), fabsf(a0[1])), fmaxf(fabsf(a0[2]), fabsf(a0[3]))), fmaxf(fmaxf(fabsf(a1[0]), fabsf(a1[1])), fmaxf(fabsf(a1[2]), fabsf(a1[3])))));
                    u32x4 w; w.x = pkb(a0[0], a0[1]); w.y = pkb(a0[2], a0[3]); w.z = pkb(a1[0], a1[1]); w.w = pkb(a1[2], a1[3]); if (!fin) *(u32x4*)(xp + bj * HALF) = w; }
                ss += __shfl_xor(ss, 16); ss += __shfl_xor(ss, 32); am = fmaxf(am, __shfl_xor(am, 16)); am = fmaxf(am, __shfl_xor(am, 32));
                if (fq == 0) { P[r * 4 + wc] = ss; Q[r * 4 + wc] = am; } }
        __syncthreads();
        const int tid = wid * 64 + lane;
        if (tid < 256) { const f32x4 p = *(const PG8_LAS f32x4*)(P + tid * 4); const float ts = (p[0] + p[1]) + (p[2] + p[3]); ssq[(size_t)(u.pm * BM + tid) * 4 + u.pn] = ts;
            if (q8) { const f32x4 q = *(const PG8_LAS f32x4*)(Q + tid * 4); float* e = ex + ((size_t)(u.pm * BM + tid) * 4 + u.pn) * 2;
                __hip_atomic_store(e, ts, __ATOMIC_RELAXED, __HIP_MEMORY_SCOPE_AGENT); __hip_atomic_store(e + 1, fmaxf(fmaxf(q[0], q[1]), fmaxf(q[2], q[3])), __ATOMIC_RELAXED, __HIP_MEMORY_SCOPE_AGENT); } }
        if (q8) {
            if (wid < 4) { asm volatile("s_waitcnt vmcnt(0)" ::: "memory"); if (lane == 0) __hip_atomic_fetch_add(pc, 1u, __ATOMIC_RELAXED, __HIP_MEMORY_SCOPE_AGENT); }
            if (tid == 0) { unsigned sp = 0u; while (__hip_atomic_load(pc, __ATOMIC_RELAXED, __HIP_MEMORY_SCOPE_AGENT) < 16u) { __builtin_amdgcn_s_sleep(1); if (++sp > (1u << 22)) { __hip_atomic_store(tmo, 1u, __ATOMIC_RELAXED, __HIP_MEMORY_SCOPE_AGENT); break; } } }
            __syncthreads();
            if (tid < 256) { const float* e = ex + (size_t)(u.pm * BM + tid) * 8; float s4 = 0.f, a4 = 0.f;
#pragma unroll
                for (int k = 0; k < 4; ++k) { s4 += __hip_atomic_load(e + 2 * k, __ATOMIC_RELAXED, __HIP_MEMORY_SCOPE_AGENT); a4 = fmaxf(a4, __hip_atomic_load(e + 2 * k + 1, __ATOMIC_RELAXED, __HIP_MEMORY_SCOPE_AGENT)); }
                IV[tid] = fin ? __builtin_amdgcn_rsqf(s4 * (1.0f / 1024.0f) + RMS_EPS) : (a4 > 0.f ? 127.0f / a4 : 0.f);
                if (u.pn == 0 && !fin) rf[u.pm * BM + tid] = __builtin_amdgcn_rsqf(s4 * (1.0f / 1024.0f) + RMS_EPS) * a4 * (1.0f / 127.0f); }
            __syncthreads();
            if (fin) {
                f32x4 gn[2][2];
#pragma unroll
                for (int bj = 0; bj < 2; ++bj) { gn[bj][0] = *(const f32x4*)(fgain + col0 + bj * HALF); gn[bj][1] = *(const f32x4*)(fgain + col0 + bj * HALF + 4); }
#pragma unroll
                for (int ai = 0; ai < 2; ++ai)
#pragma unroll
                    for (int m = 0; m < 4; ++m) { const int r = ai * HALF + wr * 64 + m * 16 + fr; const float rs = IV[r] * alpha; float* op = fout + (size_t)(u.pm * BM + r) * DM + col0;
#pragma unroll
                        for (int bj = 0; bj < 2; ++bj) { *(f32x4*)(op + bj * HALF) = acc[ai][bj][m][0] * rs * gn[bj][0]; *(f32x4*)(op + bj * HALF + 4) = acc[ai][bj][m][1] * rs * gn[bj][1]; } }
                return; }
#pragma unroll
            for (int ai = 0; ai < 2; ++ai)
#pragma unroll
                for (int m = 0; m < 4; ++m) { const int r = ai * HALF + wr * 64 + m * 16 + fr; const float inv = IV[r] * alpha; signed char* qp = x8 + (size_t)(u.pm * BM + r) * DM + col0;
#pragma unroll
                    for (int bj = 0; bj < 2; ++bj) { const f32x4 a0 = acc[ai][bj][m][0], a1 = acc[ai][bj][m][1]; u32x2 w; w.x = q8x4(a0[0], a0[1], a0[2], a0[3], inv); w.y = q8x4(a1[0], a1[1], a1[2], a1[3], inv); *(u32x2*)(qp + bj * HALF) = w; } }
        }
    }
};

typedef int i32x4 __attribute__((ext_vector_type(4)));
template <bool I8> __device__ __forceinline__ f32x4 mma16(const bf16x8 a, const bf16x8 b, const f32x4 c) {
    if constexpr (I8) return __builtin_bit_cast(f32x4, __builtin_amdgcn_mfma_i32_16x16x64_i8(__builtin_bit_cast(i32x4, a), __builtin_bit_cast(i32x4, b), __builtin_bit_cast(i32x4, c), 0, 0, 0));
    else return __builtin_amdgcn_mfma_f32_16x16x32_bf16(a, b, c, 0, 0, 0);
}
template <class Epi, class Sched, bool ALIGN_EPI = false, bool SP2 = false, bool I8 = false>
__device__ __forceinline__ void gemm_phase(PG8_LAS unsigned char* lds, const Gemm g, const Sched& S, const Epi& E, const int tid) {
    const int wid = __builtin_amdgcn_readfirstlane(tid >> 6), lane = tid & 63, wr = wid >> 2, wc = wid & 3, fr = lane & 15, fq = lane >> 4;
    const int K = g.K, nt = K / BK;
    unsigned voffA[2], voffB[2];
#pragma unroll
    for (int i = 0; i < 2; ++i) { int R, C; stage_rc(tid * 16 + i * 8192, R, C); const int Rb = Epi::PERM ? ((R & ~31) + perm32(R & 31)) : R;
        voffA[i] = (unsigned)(R * K + C) * 2u; voffB[i] = (unsigned)(Rb * K + C) * 2u; }
    const size_t kstep = (size_t)(BK * 2);
    const size_t hstep = (size_t)HALF * K * 2;
    const size_t tstep = 2 * hstep;
    const unsigned ldsw = (unsigned)wid * 1024u;
    const int aoff = lds_byte(wr * 64 + fr, fq * 8), boff = lds_byte(wc * 32 + fr, fq * 8);
#define PG8_SA(b, h) (((b) * 2 + (h)) * HTB)
#define PG8_SB(b, h) ((4 + (b) * 2 + (h)) * HTB)
#define PG8_STAGE(bufoff, gbase, voff) do { _Pragma("unroll") for (int _i = 0; _i < 2; ++_i) \
        __builtin_amdgcn_global_load_lds((const unsigned*)((const char*)(gbase) + (voff)[_i]), (PG8_LAS unsigned*)(lds + (bufoff) + ldsw + _i * 8192), 16, 0, 0); } while (0)
#define PG8_LDA(dst, b, h) do { _Pragma("unroll") for (int m = 0; m < 4; ++m) _Pragma("unroll") for (int k = 0; k < 2; ++k) dst[m][k] = *(const PG8_LAS bf16x8*)(lds + PG8_SA(b, h) + aoff + m * 2048 + k * 1024); } while (0)
#define PG8_LDB(dst, b, h) do { _Pragma("unroll") for (int n = 0; n < 2; ++n) _Pragma("unroll") for (int k = 0; k < 2; ++k) dst[n][k] = *(const PG8_LAS bf16x8*)(lds + PG8_SB(b, h) + boff + n * 2048 + k * 1024); } while (0)
#define PG8_MMA(ai, bj, At, Bt) do { __builtin_amdgcn_s_setprio(1); _Pragma("unroll") for (int m = 0; m < 4; ++m) _Pragma("unroll") for (int n = 0; n < 2; ++n) _Pragma("unroll") for (int k = 0; k < 2; ++k) \
        acc[ai][bj][m][n] = mma16<I8>(Bt[n][k], At[m][k], acc[ai][bj][m][n]); __builtin_amdgcn_s_setprio(0); } while (0)
#define PG8_WAIT_V(n) asm volatile("s_waitcnt vmcnt(" #n ")" ::: "memory")
#define PG8_WAIT_L(n) asm volatile("s_waitcnt lgkmcnt(" #n ")" ::: "memory")
#define PG8_BAR __builtin_amdgcn_s_barrier()
#define PG8_SCHED __builtin_amdgcn_sched_barrier(0)
    Unit cur, nxt; int ui = 0;
    if (!S.next(0, cur)) return;
    f32x4 acc[2][2][4][2];
    if constexpr (Epi::AFTER_DRAIN) E.init(acc, cur, wr, wc, fr, fq);
    else {
#pragma unroll
    for (int a = 0; a < 2; ++a)
#pragma unroll
        for (int b = 0; b < 2; ++b)
#pragma unroll
            for (int m = 0; m < 4; ++m)
#pragma unroll
                for (int n = 0; n < 2; ++n) acc[a][b][m][n] = (f32x4){0.f, 0.f, 0.f, 0.f};
    }
    bf16x8 At[4][2], B0[2][2], B1[2][2];
    const char* cA = (const char*)g.A + (size_t)cur.pm * tstep; const char* cB = (const char*)g.Bt + (size_t)cur.pn * tstep;
    S.a_ready(cur);
    if constexpr (SP2) {
        PG8_STAGE(PG8_SB(0, 0), cB, voffB); PG8_STAGE(PG8_SB(0, 1), cB + hstep, voffB); PG8_STAGE(PG8_SA(0, 0), cA, voffA); PG8_STAGE(PG8_SA(0, 1), cA + hstep, voffA);
        if (wr == 1) PG8_BAR;
        PG8_WAIT_V(2); PG8_BAR;
        PG8_STAGE(PG8_SB(1, 0), cB + kstep, voffB); PG8_STAGE(PG8_SA(1, 0), cA + kstep, voffA); PG8_STAGE(PG8_SB(1, 1), cB + hstep + kstep, voffB);
        PG8_WAIT_V(6); PG8_BAR;
    } else {
        PG8_STAGE(PG8_SB(0, 0), cB, voffB); PG8_STAGE(PG8_SA(0, 0), cA, voffA); PG8_STAGE(PG8_SB(0, 1), cB + hstep, voffB); PG8_STAGE(PG8_SA(0, 1), cA + hstep, voffA);
        if (wr == 1) PG8_BAR;
        PG8_WAIT_V(4); PG8_BAR;
        PG8_STAGE(PG8_SB(1, 0), cB + kstep, voffB); PG8_STAGE(PG8_SA(1, 0), cA + kstep, voffA); PG8_STAGE(PG8_SB(1, 1), cB + hstep + kstep, voffB);
        PG8_WAIT_V(6); PG8_BAR;
    }
    for (;;) {
        const bool has_next = S.next(ui + 1, nxt);
        const char* nA = has_next ? (const char*)g.A + (size_t)nxt.pm * tstep : cA; const char* nB = has_next ? (const char*)g.Bt + (size_t)nxt.pn * tstep : cB;
        for (int t = 0; t < nt; t += 2) {
            const bool last = (t == nt - 2);
            const char* a1 = cA + (size_t)(t + 1) * kstep;
            const char* a2 = last ? nA : cA + (size_t)(t + 2) * kstep; const char* b2 = last ? nB : cB + (size_t)(t + 2) * kstep;
            const char* a3 = a2 + kstep; const char* b3 = b2 + kstep;
            if (last && has_next) S.a_ready(nxt);
            if constexpr (SP2) {
            PG8_LDB(B0, 0, 0); PG8_LDB(B1, 0, 1); PG8_SCHED; PG8_LDA(At, 0, 0); PG8_STAGE(PG8_SA(1, 1), a1 + hstep, voffA);
            PG8_WAIT_V(8); PG8_WAIT_L(0); PG8_BAR; PG8_MMA(0, 0, At, B0); PG8_MMA(0, 1, At, B1); PG8_BAR; PG8_SCHED;
            PG8_LDA(At, 0, 1); PG8_STAGE(PG8_SB(0, 0), b2, voffB); PG8_STAGE(PG8_SB(0, 1), b2 + hstep, voffB); PG8_STAGE(PG8_SA(0, 0), a2, voffA);
            PG8_WAIT_V(8); PG8_WAIT_L(0); PG8_BAR; PG8_MMA(1, 0, At, B0); PG8_MMA(1, 1, At, B1); PG8_BAR; PG8_SCHED;
            PG8_LDB(B0, 1, 0); PG8_LDB(B1, 1, 1); PG8_SCHED; PG8_LDA(At, 1, 0); PG8_STAGE(PG8_SA(0, 1), a2 + hstep, voffA);
            PG8_WAIT_V(8); PG8_WAIT_L(0); PG8_BAR; PG8_MMA(0, 0, At, B0); PG8_MMA(0, 1, At, B1); PG8_BAR; PG8_SCHED;
            PG8_LDA(At, 1, 1); PG8_STAGE(PG8_SB(1, 0), b3, voffB); PG8_STAGE(PG8_SB(1, 1), b3 + hstep, voffB); PG8_STAGE(PG8_SA(1, 0), a3, voffA);
            PG8_WAIT_V(8); PG8_WAIT_L(0); PG8_BAR; PG8_MMA(1, 0, At, B0); PG8_MMA(1, 1, At, B1); PG8_BAR; PG8_SCHED;
            } else {
            PG8_LDB(B0, 0, 0); PG8_SCHED; PG8_LDA(At, 0, 0); PG8_STAGE(PG8_SA(1, 1), a1 + hstep, voffA);
            PG8_WAIT_L(8); PG8_BAR; PG8_WAIT_L(0); PG8_MMA(0, 0, At, B0); PG8_BAR; PG8_SCHED;
            PG8_LDB(B1, 0, 1); PG8_STAGE(PG8_SB(0, 0), b2, voffB);
            PG8_BAR; PG8_WAIT_L(0); PG8_MMA(0, 1, At, B1); PG8_BAR;
            PG8_LDA(At, 0, 1); PG8_STAGE(PG8_SA(0, 0), a2, voffA);
            PG8_BAR; PG8_WAIT_L(0); PG8_MMA(1, 0, At, B0); PG8_BAR; PG8_SCHED;
            PG8_STAGE(PG8_SB(0, 1), b2 + hstep, voffB);
            PG8_WAIT_V(6); PG8_BAR; PG8_MMA(1, 1, At, B1); PG8_BAR;
            PG8_LDB(B0, 1, 0); PG8_SCHED; PG8_LDA(At, 1, 0); PG8_STAGE(PG8_SA(0, 1), a2 + hstep, voffA);
            PG8_WAIT_L(8); PG8_BAR; PG8_WAIT_L(0); PG8_MMA(0, 0, At, B0); PG8_BAR; PG8_SCHED;
            PG8_LDB(B1, 1, 1); PG8_STAGE(PG8_SB(1, 0), b3, voffB);
            PG8_BAR; PG8_WAIT_L(0); PG8_MMA(0, 1, At, B1); PG8_BAR;
            PG8_LDA(At, 1, 1); PG8_STAGE(PG8_SA(1, 0), a3, voffA);
            PG8_BAR; PG8_WAIT_L(0); PG8_MMA(1, 0, At, B0); PG8_BAR; PG8_SCHED;
            PG8_STAGE(PG8_SB(1, 1), b3 + hstep, voffB);
            PG8_WAIT_V(6); PG8_BAR; PG8_MMA(1, 1, At, B1); PG8_BAR;
            }
        }
        if constexpr (ALIGN_EPI) { if (wr == 0) PG8_BAR; }
        if constexpr (!Epi::AFTER_DRAIN) { E(acc, cur, wr, wc, fr, fq); S.done(cur); }
        if (!has_next) break;
#pragma unroll
        for (int a = 0; a < 2; ++a)
#pragma unroll
            for (int b = 0; b < 2; ++b)
#pragma unroll
                for (int m = 0; m < 4; ++m)
#pragma unroll
                    for (int n = 0; n < 2; ++n) acc[a][b][m][n] = (f32x4){0.f, 0.f, 0.f, 0.f};
        cur = nxt; cA = nA; cB = nB; ++ui;
        if constexpr (ALIGN_EPI) { if (wr == 1) PG8_BAR; }
    }
    PG8_WAIT_V(0);
    if constexpr (!ALIGN_EPI) { if (wr == 0) PG8_BAR; }
    PG8_BAR;
    if constexpr (Epi::AFTER_DRAIN) { E.fused(acc, cur, wr, wc, fr, fq, lds, wid, lane); S.done(cur); }
#undef PG8_SA
#undef PG8_SB
#undef PG8_STAGE
#undef PG8_LDA
#undef PG8_LDB
#undef PG8_MMA
#undef PG8_WAIT_V
#undef PG8_WAIT_L
#undef PG8_BAR
#undef PG8_SCHED
}
}
constexpr size_t KiB = 1024, MiB = 1u << 20;
constexpr size_t WS_CTL = 0, CTL_BYTES = 1 * MiB;
constexpr size_t WS_W = 1 * MiB, WBUF_BYTES = 42 * MiB;
constexpr size_t WO_GU1 = 0, WO_D1 = 11 * MiB, WO_IN = 16896 * KiB, WO_OUT = 23 * MiB, WO_GU2 = 25 * MiB, WO_D2 = 36 * MiB;
constexpr size_t WS_XB = 85 * MiB;
constexpr size_t WS_Z = 117 * MiB;
constexpr size_t WS_MIX = 221 * MiB;
constexpr size_t WS_ACT = 253 * MiB;
constexpr size_t WS_OP = 253 * MiB;
constexpr size_t WS_LSE = 301 * MiB;
constexpr size_t WS_SEL = 303 * MiB;
constexpr size_t WS_KV = 304 * MiB;
constexpr size_t WS_PREV = 310 * MiB;
constexpr size_t WS_KM = 313 * MiB;
constexpr size_t WS_RT = 341 * MiB, WS_MT = 345 * MiB;
constexpr size_t WS_SSQ = 346 * MiB;
constexpr size_t WS_X8 = 347 * MiB;
constexpr size_t WS_RF = 363 * MiB;
constexpr size_t WS_EX = WS_RF + 512 * KiB;
constexpr size_t WS_END = 364 * MiB;
constexpr size_t WO_IN8 = 7 * MiB, WO_SWIN = 10752 * KiB;
constexpr size_t WO_SW = 6 * MiB;
static_assert(WS_KM + 1 * MiB <= WS_ACT + 88 * MiB && WS_ACT + 88 * MiB <= WS_RT, "d_ws map");
constexpr int CW_TMO = 8, CW_XT = 1024  , CW_LB = 2048  , CW_BAR = 4096, CW_Q = 16384, CW_HC = 32768, CW_PC = 65536  ;

constexpr int RING_BYTES = 131072, LDSCTL_OFF = RING_BYTES, MISC_OFF = LDSCTL_OFF + 320, LDS_BYTES = 147456;

#define LAS __attribute__((address_space(3)))
#define GAS __attribute__((address_space(1)))
typedef unsigned short bf16;
typedef unsigned u32x4 __attribute__((ext_vector_type(4)));
typedef unsigned u32x2 __attribute__((ext_vector_type(2)));
typedef float f32x4 __attribute__((ext_vector_type(4)));
typedef float f32x2 __attribute__((ext_vector_type(2)));
typedef float f32x16 __attribute__((ext_vector_type(16)));
typedef short bf16x8 __attribute__((ext_vector_type(8)));
typedef short s16x4 __attribute__((ext_vector_type(4)));
typedef short v4i16_t __attribute__((ext_vector_type(4)));
typedef __bf16 bf16x2_t __attribute__((ext_vector_type(2)));
#define LDS_WAIT() asm volatile("s_waitcnt lgkmcnt(0)" ::: "memory")
__device__ __forceinline__ unsigned pk2(float lo, float hi) { const f32x2 v = {lo, hi}; const bf16x2_t b = __builtin_convertvector(v, bf16x2_t); return __builtin_bit_cast(unsigned, b); }
__device__ __forceinline__ float bflo(unsigned w) { return __uint_as_float(w << 16); }
__device__ __forceinline__ float bfhi(unsigned w) { return __uint_as_float(w & 0xffff0000u); }
__device__ __forceinline__ float ex2(float x) { return __builtin_amdgcn_exp2f(x); }
__device__ __forceinline__ float silu1(float x) { return x * __builtin_amdgcn_rcpf(1.0f + ex2(-1.4426950408889634f * x)); }
__device__ __forceinline__ float sigm1(float x) { return __builtin_amdgcn_rcpf(1.0f + ex2(-1.4426950408889634f * x)); }
__device__ __forceinline__ float wave_sum(float v) {
#pragma unroll
    for (int o = 1; o < 64; o <<= 1) v += __shfl_xor(v, o);
    return v;
}
__device__ __forceinline__ f32x16 mfma32(bf16x8 a, bf16x8 b, f32x16 c) { return __builtin_amdgcn_mfma_f32_32x32x16_bf16(a, b, c, 0, 0, 0); }
__device__ __forceinline__ int crow(int i, int h) { return (i & 3) + 8 * (i >> 2) + 4 * h; }
__device__ __forceinline__ s16x4 vtr(LAS const unsigned char* p) { return __builtin_bit_cast(s16x4, __builtin_amdgcn_ds_read_tr16_b64_v4i16((LAS v4i16_t*)p)); }
__device__ __forceinline__ bf16x8 cat8(s16x4 lo, s16x4 hi) { return __builtin_shufflevector(lo, hi, 0, 1, 2, 3, 4, 5, 6, 7); }
__device__ __forceinline__ bf16x8 ldsrow(LAS const unsigned char* p) { return *(const LAS bf16x8*)p; }
__device__ __forceinline__ f32x16 zero16() { f32x16 z;
#pragma unroll
    for (int i = 0; i < 16; ++i) z[i] = 0.f;
    return z; }
__device__ __forceinline__ bf16x8 pack8(const f32x16& x, int s) {
    u32x4 p; p.x = pk2(x[8 * s], x[8 * s + 1]); p.y = pk2(x[8 * s + 2], x[8 * s + 3]); p.z = pk2(x[8 * s + 4], x[8 * s + 5]); p.w = pk2(x[8 * s + 6], x[8 * s + 7]);
    return __builtin_bit_cast(bf16x8, p);
}
constexpr int PIT = 144;
constexpr int IMG = 256 * PIT;
template <int NR> __device__ __forceinline__ void stage64(LAS unsigned char* dst, const bf16* src, int gp, int tid) {
    constexpr int N = (NR * 8 + 511) / 512; u32x4 v[N];
#pragma unroll
    for (int i = 0; i < N; ++i) { const int c = tid + 512 * i, row = c >> 3, ch = c & 7; if (NR * 8 % 512 == 0 || c < NR * 8) v[i] = *(const u32x4*)(src + (size_t)row * gp + ch * 8); }
#pragma unroll
    for (int i = 0; i < N; ++i) { const int c = tid + 512 * i, row = c >> 3, ch = c & 7; if (NR * 8 % 512 == 0 || c < NR * 8) *(LAS u32x4*)(dst + row * PIT + ch * 16) = v[i]; }
}

template <int NI> __device__ __forceinline__ void stage256n(LAS unsigned char* const (&dst)[NI], const bf16* const (&src)[NI], int gp, int tid) {
    u32x4 v[NI][4];
#pragma unroll
    for (int k = 0; k < NI; ++k)
#pragma unroll
        for (int i = 0; i < 4; ++i) { const int c = tid + 512 * i, row = c >> 3, ch = c & 7; v[k][i] = *(const u32x4*)(src[k] + (size_t)row * gp + ch * 8); }
#pragma unroll
    for (int k = 0; k < NI; ++k)
#pragma unroll
        for (int i = 0; i < 4; ++i) { const int c = tid + 512 * i, row = c >> 3, ch = c & 7; *(LAS u32x4*)(dst[k] + row * PIT + ch * 16) = v[k][i]; }
}

__device__ __forceinline__ void sincos_acc(float angf, float& c, float& s) {
    const double a = (double)angf, kq = rint(a * 0.63661977236758134308), r = a - kq * 1.57079632679489661923, r2 = r * r;
    const double sn = r * (1.0 + r2 * (-1.0 / 6.0 + r2 * (1.0 / 120.0 + r2 * (-1.0 / 5040.0 + r2 * (1.0 / 362880.0 + r2 * (-1.0 / 39916800.0))))));
    const double cs = 1.0 + r2 * (-0.5 + r2 * (1.0 / 24.0 + r2 * (-1.0 / 720.0 + r2 * (1.0 / 40320.0 + r2 * (-1.0 / 3628800.0 + r2 * (1.0 / 479001600.0))))));
    const int q = ((int)kq) & 3;
    const double cc = (q == 0) ? cs : (q == 1) ? -sn : (q == 2) ? -cs : sn, ssv = (q == 0) ? sn : (q == 1) ? cs : (q == 2) ? -sn : -cs;
    c = (float)cc; s = (float)ssv;
}
__device__ __forceinline__ int cvt_tgt(int mode, int c, float& sc) {
    sc = 1.f;
    if (mode == 0) return c;
    if (mode == 1) return 256 * (c >> 7) + (c & 127);
    if (mode == 2) return 256 * (c >> 7) + 128 + (c & 127);
    if (c < 768) { const int sec = c >= 384, w = c - 384 * sec, hh = w >> 6, o = w & 63; if (sec) sc = 0.125f; return (sec ? Z_RK : Z_RQ) + hh * 64 + (o < 32 ? 2 * o : 2 * (o - 32) + 1); }
    if (c < 1152) return Z_RV + (c - 768);
    if (c < 1536) return Z_RG + (c - 1152);
    if (c < 2304) { const int sec = c >= 1920, w = c - 1536 - 384 * sec, hh = w >> 6, o = w & 63; if (!sec) sc = C2; return (sec ? Z_MK : Z_MQ) + hh * 64 + (o < 8 ? 2 * o : o < 16 ? 2 * (o - 8) + 1 : o); }
    if (c < 2688) return Z_MV + (c - 2304);
    if (c < 2944) return Z_CA + (c - 2688);
    return Z_CG + (c - 2944);
}
__device__ __forceinline__ void cvt_item(const float* W, const float* gain, bf16* dst, int K, int NS, int mode, int item, LAS float* scr, int lane) {
    const int nblk = NS >> 5, kb = item / nblk, nb = item - kb * nblk, k0 = kb << 6, c0 = nb << 5;
    const int ksub = lane >> 3, n4 = lane & 7;
    f32x4 v[8]; float gv[8];
#pragma unroll
    for (int i = 0; i < 8; ++i) v[i] = *(const f32x4*)(W + (size_t)(k0 + ksub + 8 * i) * NS + c0 + 4 * n4);
#pragma unroll
    for (int i = 0; i < 8; ++i) gv[i] = gain ? gain[k0 + ksub + 8 * i] : 1.f;
    float sc; (void)cvt_tgt(mode, c0, sc);
#pragma unroll
    for (int i = 0; i < 8; ++i) { const float g = gv[i] * sc; LAS float* s = scr + (ksub + 8 * i) * 33 + 4 * n4; s[0] = v[i][0] * g; s[1] = v[i][1] * g; s[2] = v[i][2] * g; s[3] = v[i][3] * g; }
    LDS_WAIT(); asm volatile("" ::: "memory");
    const int c = lane & 7;
#pragma unroll
    for (int j = 0; j < 4; ++j) { const int n = (lane >> 3) + 8 * j; const LAS float* s = scr + (8 * c) * 33 + n; float dummy;
        u32x4 o; o.x = pk2(s[0 * 33], s[1 * 33]); o.y = pk2(s[2 * 33], s[3 * 33]); o.z = pk2(s[4 * 33], s[5 * 33]); o.w = pk2(s[6 * 33], s[7 * 33]);
        *(u32x4*)(dst + (size_t)cvt_tgt(mode, c0 + n, dummy) * K + k0 + 8 * c) = o; }
    LDS_WAIT(); asm volatile("" ::: "memory");
}
__device__ __forceinline__ void cvt_q8_batch(const float* W, const float* gain, signed char* dst, float* SWt, int NS, int mode, int nb, LAS unsigned char* lds, int wave, int lane) {
    LAS float* scr = (LAS float*)(lds + wave * 16384); LAS float* red = (LAS float*)(lds + wave * 16384 + 12288);
    const int c0 = nb << 5, ksub = lane >> 3, n4 = lane & 7;
    f32x4 v[2][8]; float gv[2][8];
#pragma unroll
    for (int h = 0; h < 2; ++h)
#pragma unroll
        for (int i = 0; i < 8; ++i) v[h][i] = *(const f32x4*)(W + (size_t)(64 * (wave + 8 * h) + ksub + 8 * i) * NS + c0 + 4 * n4);
#pragma unroll
    for (int h = 0; h < 2; ++h)
#pragma unroll
        for (int i = 0; i < 8; ++i) gv[h][i] = gain[64 * (wave + 8 * h) + ksub + 8 * i];
    float sc0; (void)cvt_tgt(mode, c0, sc0);
    f32x4 am = {0.f, 0.f, 0.f, 0.f};
#pragma unroll
    for (int h = 0; h < 2; ++h)
#pragma unroll
        for (int i = 0; i < 8; ++i) { v[h][i] = v[h][i] * (gv[h][i] * sc0);
#pragma unroll
            for (int e = 0; e < 4; ++e) am[e] = fmaxf(am[e], fabsf(v[h][i][e])); }
#pragma unroll
    for (int o = 8; o < 64; o <<= 1)
#pragma unroll
        for (int e = 0; e < 4; ++e) am[e] = fmaxf(am[e], __shfl_xor(am[e], o));
    if (lane < 8) *(LAS f32x4*)(red + 4 * n4) = am;
    __syncthreads();
    f32x4 cm = {0.f, 0.f, 0.f, 0.f};
#pragma unroll
    for (int w = 0; w < 8; ++w) { const f32x4 t = *(const LAS f32x4*)(lds + w * 16384 + 12288 + 16 * n4);
#pragma unroll
        for (int e = 0; e < 4; ++e) cm[e] = fmaxf(cm[e], t[e]); }
    f32x4 inv;
#pragma unroll
    for (int e = 0; e < 4; ++e) inv[e] = cm[e] > 0.f ? 127.0f / cm[e] : 0.f;
    float dummy;
#pragma unroll
    for (int h = 0; h < 2; ++h) {
#pragma unroll
        for (int i = 0; i < 8; ++i) { LAS float* s = scr + (ksub + 8 * i) * 33 + 4 * n4;
#pragma unroll
            for (int e = 0; e < 4; ++e) s[e] = __builtin_rintf(v[h][i][e] * inv[e]); }
        LDS_WAIT(); asm volatile("" ::: "memory");
        const int c = lane & 7;
#pragma unroll
        for (int j = 0; j < 4; ++j) { const int n = (lane >> 3) + 8 * j; const LAS float* s = scr + (8 * c) * 33 + n; unsigned q[8];
#pragma unroll
            for (int t = 0; t < 8; ++t) q[t] = (unsigned)(int)s[t * 33] & 0xffu;
            u32x2 o; o.x = q[0] | (q[1] << 8) | (q[2] << 16) | (q[3] << 24); o.y = q[4] | (q[5] << 8) | (q[6] << 16) | (q[7] << 24);
            *(u32x2*)(dst + (size_t)cvt_tgt(mode, c0 + n, dummy) * DM + 64 * (wave + 8 * h) + 8 * c) = o; }
        LDS_WAIT(); asm volatile("" ::: "memory");
    }
    if (wave == 0 && lane < 8) {
#pragma unroll
        for (int e = 0; e < 4; ++e) SWt[cvt_tgt(mode, c0 + 4 * n4 + e, dummy)] = cm[e] * (1.0f / 127.0f); }
}
constexpr int I_D = (FF / 64) * (DM / 32), I_IN = (DM / 64) * (ZN / 32), I_OUT = (DM / 64) * (DM / 32);
constexpr int B_G = FF / 32, B_D = I_D / 8, B_IN = I_IN / 8, B_IN8 = ZN / 32, B_OUT = I_OUT / 8;
static_assert(I_D % 8 == 0 && I_IN % 8 == 0 && I_OUT % 8 == 0, "whole batches");
constexpr int WIN8_FROM = 0;
__host__ __device__ constexpr int b_in(int l) { return l >= WIN8_FROM ? B_IN8 : B_IN; }
constexpr int B_EARLY0 = 2 * B_G + B_D, B_LATE = 2 * B_G + B_D + B_OUT;
__host__ __device__ constexpr int b_early(int l) { return B_EARLY0 + b_in(l); }
__host__ __device__ constexpr int b_layer(int l) { return b_early(l) + B_LATE; }
struct Args { const float* in[18]; float* out; unsigned char* ws; float invf[40]; int ph_lo, ph_hi; };
#define AIN(k) ((const float*)(GAS const float*)A.in[(k) + zi])
__device__ __forceinline__ void cvt_layer_batch(const Args& A, int zi, int l, unsigned char* wb, int bt, LAS unsigned char* lds, int wave, int lane) {
    const size_t lgu = (size_t)l * DM * FF, lw = (size_t)l * DM; LAS float* scr = (LAS float*)(lds + wave * 16384);
    int r = bt;
    if (r < B_G) { cvt_q8_batch(AIN(3) + lgu, AIN(2) + lw, (signed char*)(wb + WO_GU1), (float*)(wb + WO_GU1 + WO_SW), FF, 1, r, lds, wave, lane); return; } r -= B_G;
    if (r < B_G) { cvt_q8_batch(AIN(4) + lgu, AIN(2) + lw, (signed char*)(wb + WO_GU1), (float*)(wb + WO_GU1 + WO_SW), FF, 2, r, lds, wave, lane); return; } r -= B_G;
    if (r < B_D) { cvt_item(AIN(5) + lgu, nullptr, (bf16*)(wb + WO_D1), FF, DM, 0, 8 * r + wave, scr, lane); return; } r -= B_D;
    if (r < b_in(l)) { if (l >= WIN8_FROM) cvt_q8_batch(AIN(7) + (size_t)l * DM * ZN, AIN(6) + lw, (signed char*)(wb + WO_IN8), (float*)(wb + WO_SWIN), ZN, 3, r, lds, wave, lane);
        else cvt_item(AIN(7) + (size_t)l * DM * ZN, AIN(6) + lw, (bf16*)(wb + WO_IN), DM, ZN, 3, 8 * r + wave, scr, lane); return; } r -= b_in(l);
    if (r < B_G) { cvt_q8_batch(AIN(14) + lgu, AIN(13) + lw, (signed char*)(wb + WO_GU2), (float*)(wb + WO_GU2 + WO_SW), FF, 1, r, lds, wave, lane); return; } r -= B_G;
    if (r < B_G) { cvt_q8_batch(AIN(15) + lgu, AIN(13) + lw, (signed char*)(wb + WO_GU2), (float*)(wb + WO_GU2 + WO_SW), FF, 2, r, lds, wave, lane); return; } r -= B_G;
    if (r < B_D) { cvt_item(AIN(16) + lgu, nullptr, (bf16*)(wb + WO_D2), FF, DM, 0, 8 * r + wave, scr, lane); return; } r -= B_D;
    cvt_item(AIN(12) + (size_t)l * DM * DM, nullptr, (bf16*)(wb + WO_OUT), DM, DM, 0, 8 * r + wave, scr, lane);
}
#define XB_TMO      128
#define XB_XCNT(j)  (256  + 64 * (j))
#define XB_XSUB(j)  (1280 + 64 * (j))
#define XB_XGEN(j)  (2304 + 64 * (j))
#define XB_TOP      3328
#define XB_TOPGEN   3392
#define XCD_BAR_WORDS 3456
#define XB_SPIN_CAP (1u << 18)

__device__ __forceinline__ unsigned xb_ld(unsigned* p)              { return __hip_atomic_load(p, __ATOMIC_RELAXED, __HIP_MEMORY_SCOPE_AGENT); }
__device__ __forceinline__ unsigned xb_add(unsigned* p, unsigned v) { return __hip_atomic_fetch_add(p, v, __ATOMIC_RELAXED, __HIP_MEMORY_SCOPE_AGENT); }
__device__ __forceinline__ unsigned xb_xcc_id() { return (unsigned)__builtin_amdgcn_s_getreg((3 << 11) | 20) & 0xFu; }
#define XB_SPIN(cond, bar) do { unsigned _sp = 0; while (cond) { __builtin_amdgcn_s_sleep(1); \
    if ((++_sp & 255u) == 0u) { if (xb_ld(&(bar)[XB_TMO])) break; if (_sp > XB_SPIN_CAP) { atomicAdd(&(bar)[XB_TMO], 1u); break; } } } } while (0)

struct XcdBarrier {
    unsigned* bar; unsigned x;
    volatile LAS unsigned* st;
};

__device__ __forceinline__ XcdBarrier xcd_barrier_post(unsigned* bar, volatile LAS unsigned* st) {
    XcdBarrier b; b.bar = bar; b.x = xb_xcc_id(); b.st = st;
    if (threadIdx.x == 0) (void)xb_add(&bar[XB_XCNT(b.x)], 1u);
    return b;
}
__device__ __forceinline__ void xcd_barrier_complete(unsigned* bar, unsigned x, unsigned& nloc, unsigned& nx) {
    const unsigned G = gridDim.x * gridDim.y * gridDim.z;
    unsigned sum, cnt, mine, sp = 0u;
    for (;;) {
        sum = 0u; cnt = 0u; mine = 0u;
#pragma unroll
        for (unsigned j = 0; j < 16; ++j) { const unsigned c = xb_ld(&bar[XB_XCNT(j)]); sum += c; cnt += (c > 0u) ? 1u : 0u; mine = (j == x) ? c : mine; }
        if (sum == G) break;
        __builtin_amdgcn_s_sleep(1);
        if ((++sp & 255u) == 0u) { if (xb_ld(&bar[XB_TMO])) break; if (sp > XB_SPIN_CAP) { atomicAdd(&bar[XB_TMO], 1u); break; } }
    }
    nloc = mine > 0u ? mine : 1u; nx = cnt > 0u ? cnt : 1u;
}

__device__ __forceinline__ void xcd_barrier(const XcdBarrier& b) {
    asm volatile("s_waitcnt vmcnt(0)" ::: "memory");
    __syncthreads();
    if (threadIdx.x == 0) {
        unsigned* bar = b.bar;
        __builtin_amdgcn_s_waitcnt(0);
        unsigned nloc = b.st[0], nx = b.st[1];
        if (nloc == 0u) { xcd_barrier_complete(bar, b.x, nloc, nx); b.st[0] = nloc; b.st[1] = nx; }
        const unsigned old = xb_add(&bar[XB_XSUB(b.x)], 1u);
        const unsigned gen = old / nloc;
        if (old + 1u == (gen + 1u) * nloc) {
            __builtin_amdgcn_fence(__ATOMIC_RELEASE, "agent");
            asm volatile("s_waitcnt vmcnt(0)" ::: "memory");
            const unsigned og = xb_add(&bar[XB_TOP], 1u);
            const unsigned tg = og / nx;
            if (og + 1u == (tg + 1u) * nx) xb_add(&bar[XB_TOPGEN], 1u);
            else XB_SPIN(xb_ld(&bar[XB_TOPGEN]) == tg, bar);
            __builtin_amdgcn_fence(__ATOMIC_ACQUIRE, "agent");
            xb_add(&bar[XB_XGEN(b.x)], 1u);
            asm volatile("s_waitcnt vmcnt(0)" ::: "memory");
        } else {
            XB_SPIN(xb_ld(&bar[XB_XGEN(b.x)]) == gen, bar);
            __builtin_amdgcn_fence(__ATOMIC_ACQUIRE, "agent");
            asm volatile("s_waitcnt vmcnt(0)" ::: "memory");
        }
    }
    __syncthreads();
}
__device__ __forceinline__ void xcd_local_barrier(unsigned* lb, unsigned x, unsigned nloc, unsigned* tmo) {
    asm volatile("s_waitcnt vmcnt(0)" ::: "memory");
    __syncthreads();
    if (threadIdx.x == 0) {
        __builtin_amdgcn_s_waitcnt(0);
        const unsigned old = xb_add(&lb[64 * x], 1u), gen = old / nloc;
        if (old + 1u == (gen + 1u) * nloc) xb_add(&lb[64 * (16 + x)], 1u);
        else { unsigned sp = 0u; while (xb_ld(&lb[64 * (16 + x)]) == gen) { __builtin_amdgcn_s_sleep(1); if (++sp > (1u << 22)) { __hip_atomic_store(tmo, 1u, __ATOMIC_RELAXED, __HIP_MEMORY_SCOPE_AGENT); break; } } }
        __builtin_amdgcn_fence(__ATOMIC_ACQUIRE, "agent");
        asm volatile("s_waitcnt vmcnt(0)" ::: "memory");
    }
    __syncthreads();
}
__device__ __forceinline__ void conv_item(int it, const bf16* z, bf16* mix, const float* cw, const float* cb, const float* lg, const float* lb, LAS unsigned char* lds, int tid, int wave, int lane) {
    LAS float* U = (LAS float*)lds;
    const int t0 = it * 64, s0 = t0 & (SEQ - 1);
    u32x4 av[6], gv[6];
#pragma unroll
    for (int i = 0; i < 6; ++i) { const int c = tid + 512 * i, row = c >> 5, ch = c & 31; av[i] = (u32x4){0u, 0u, 0u, 0u}; gv[i] = av[i];
        if (c < 94 * 32 && s0 - 30 + row >= 0) { const bf16* zr = z + (size_t)(t0 - 30 + row) * ZP; av[i] = *(const u32x4*)(zr + Z_CA + 8 * ch); gv[i] = *(const u32x4*)(zr + Z_CG + 8 * ch); } }
#pragma unroll
    for (int i = 0; i < 6; ++i) { const int c = tid + 512 * i, row = c >> 5, ch = c & 31; const u32x4 a = av[i], g = gv[i]; f32x4 o0, o1;
        o0[0] = bflo(a.x) * sigm1(bflo(g.x)); o0[1] = bfhi(a.x) * sigm1(bfhi(g.x)); o0[2] = bflo(a.y) * sigm1(bflo(g.y)); o0[3] = bfhi(a.y) * sigm1(bfhi(g.y));
        o1[0] = bflo(a.z) * sigm1(bflo(g.z)); o1[1] = bfhi(a.z) * sigm1(bfhi(g.z)); o1[2] = bflo(a.w) * sigm1(bflo(g.w)); o1[3] = bfhi(a.w) * sigm1(bfhi(g.w));
        if (c < 94 * 32) { *(LAS f32x4*)(U + row * 256 + 8 * ch) = o0; *(LAS f32x4*)(U + row * 256 + 8 * ch + 4) = o1; } }
    __syncthreads();
    const int g = wave & 3, half = wave >> 2, c = 64 * g + lane;
    float w[31];
#pragma unroll
    for (int j = 0; j < 31; ++j) w[j] = cw[j * 256 + c];
    const float bias = cb[c], gg = lg[c], bb = lb[c];
    float uw[62];
#pragma unroll
    for (int i = 0; i < 62; ++i) uw[i] = U[(32 * half + i) * 256 + c];
#pragma unroll
    for (int tb = 0; tb < 32; tb += 4) {
        float y[4], mu[4], var[4];
#pragma unroll
        for (int k = 0; k < 4; ++k) { y[k] = bias;
#pragma unroll
            for (int j = 0; j < 31; ++j) y[k] += w[j] * uw[tb + k + j]; }
#pragma unroll
        for (int k = 0; k < 4; ++k) mu[k] = y[k];
#pragma unroll
        for (int o = 1; o < 64; o <<= 1) {
#pragma unroll
            for (int k = 0; k < 4; ++k) mu[k] += __shfl_xor(mu[k], o); }
#pragma unroll
        for (int k = 0; k < 4; ++k) { mu[k] *= (1.f / 64.f); y[k] -= mu[k]; var[k] = y[k] * y[k]; }
#pragma unroll
        for (int o = 1; o < 64; o <<= 1) {
#pragma unroll
            for (int k = 0; k < 4; ++k) var[k] += __shfl_xor(var[k], o); }
#pragma unroll
        for (int k = 0; k < 4; ++k) { const float yn = y[k] * __builtin_amdgcn_rsqf(var[k] * (1.f / 64.f) + RMS_EPS) * gg + bb;
            mix[(size_t)(t0 + 32 * half + tb + k) * DM + X_CONV + c] = (bf16)(pk2(silu1(yn), 0.f) & 0xffffu); }
    }
    __syncthreads();
}
#define RLX_AGENT __ATOMIC_RELAXED, __HIP_MEMORY_SCOPE_AGENT
__device__ __forceinline__ void st_wt(float* p, float v) { __hip_atomic_store(p, v, RLX_AGENT); }
__device__ __forceinline__ void st_wt(unsigned* p, unsigned v) { __hip_atomic_store(p, v, RLX_AGENT); }
__device__ __forceinline__ void st_wt(unsigned long long* p, unsigned long long v) { __hip_atomic_store(p, v, RLX_AGENT); }
__device__ __forceinline__ float ld_wt(const float* p) { return __hip_atomic_load(p, RLX_AGENT); }
__device__ __forceinline__ unsigned ld_wt(const unsigned* p) { return __hip_atomic_load(p, RLX_AGENT); }
__device__ __forceinline__ unsigned long long ld_wt(const unsigned long long* p) { return __hip_atomic_load(p, RLX_AGENT); }
__device__ __forceinline__ void publish_wave(unsigned* ctr, int lane) { asm volatile("s_waitcnt vmcnt(0)" ::: "memory"); if (lane == 0) __hip_atomic_fetch_add(ctr, 1u, RLX_AGENT); }
__device__ __forceinline__ void wait_count(unsigned* ctr, unsigned need, unsigned* tmo, int tid) {
    if (tid == 0) { unsigned sp = 0u;
        while (__hip_atomic_load(ctr, RLX_AGENT) < need) { __builtin_amdgcn_s_sleep(2); if (++sp > (1u << 20)) { __hip_atomic_store(tmo, 1u, RLX_AGENT); break; } } }
    __syncthreads();
}
__device__ __forceinline__ void kv_item(int it2, const bf16* z, float* KV, unsigned* kvc, LAS unsigned char* lds, int tid, int wave, int lane) {
    const int team = wave >> 2, it = 2 * it2 + team, tt = tid & 255;
    const int bh = it >> 5, n = it & 31, b = bh / NHM, hh = bh - b * NHM; const size_t tok0 = (size_t)b * SEQ + 256 * n;
    const float lg2 = log2f(1.0f - ex2(-5.0f - (float)hh));
    LAS unsigned char* Ki = lds + team * 65536; LAS unsigned char* Vw = Ki + 32768;
    { u32x4 kk[8], vv[8];
#pragma unroll
    for (int i = 0; i < 8; ++i) { const int c = tt + 256 * i, row = c >> 3, ch = c & 7; kk[i] = *(const u32x4*)(z + (tok0 + row) * ZP + Z_RK + 64 * hh + ch * 8); vv[i] = *(const u32x4*)(z + (tok0 + row) * ZP + Z_RV + 64 * hh + ch * 8); }
#pragma unroll
    for (int i = 0; i < 8; ++i) { const int c = tt + 256 * i, row = c >> 3, ch = c & 7; const u32x4 v = vv[i];
        const float wg = ex2((float)(255 - row) * lg2); u32x4 o;
        o.x = pk2(bflo(v.x) * wg, bfhi(v.x) * wg); o.y = pk2(bflo(v.y) * wg, bfhi(v.y) * wg); o.z = pk2(bflo(v.z) * wg, bfhi(v.z) * wg); o.w = pk2(bflo(v.w) * wg, bfhi(v.w) * wg);
        *(LAS u32x4*)(Ki + row * 128 + ch * 16) = kk[i]; *(LAS u32x4*)(Vw + row * 128 + ch * 16) = o; } }
    __syncthreads();
    const int tl = wave & 3, ce = tl >> 1, cd = tl & 1, r = lane & 31, h = lane >> 5, blk = (lane >> 4) & 1, q4 = (lane & 15) >> 2, p = lane & 3;
    f32x16 acc = zero16();
#pragma unroll
    for (int kk = 0; kk < 16; ++kk) { const int rowa = 16 * kk + 8 * h + q4; const int ofa = rowa * 128 + 32 * blk + 8 * p;
        const bf16x8 a = cat8(vtr(Vw + ofa + 64 * ce), vtr(Vw + ofa + 4 * 128 + 64 * ce));
        const bf16x8 bb = cat8(vtr(Ki + ofa + 64 * cd), vtr(Ki + ofa + 4 * 128 + 64 * cd));
        acc = mfma32(a, bb, acc); }
    float* o = KV + (size_t)it * 4096;
#pragma unroll
    for (int i = 0; i < 16; ++i) st_wt(o + (32 * ce + crow(i, h)) * 64 + 32 * cd + r, acc[i]);
    publish_wave(kvc + 64 * bh, lane);
    __syncthreads();
}
__device__ __forceinline__ void kmean_item(int it8, const bf16* z, float* KM, unsigned* kmc, LAS unsigned char* lds, int wave, int lane) {
    const int it = 8 * it8 + wave, bh = it >> 5, j = it & 31, b = bh / NHM, hh = bh - b * NHM; const size_t tok0 = (size_t)b * SEQ + 256 * j;
    LAS float* S = (LAS float*)(lds + wave * 2048);
    const int g = lane >> 3, ch = lane & 7; float a[8];
#pragma unroll
    for (int k = 0; k < 8; ++k) a[k] = 0.f;
#pragma unroll
    for (int q = 0; q < 4; ++q) { u32x4 v[8];
#pragma unroll
        for (int i = 0; i < 8; ++i) v[i] = *(const u32x4*)(z + (tok0 + g + 8 * (8 * q + i)) * ZP + Z_MK + 64 * hh + ch * 8);
#pragma unroll
        for (int i = 0; i < 8; ++i) { a[0] += bflo(v[i].x); a[1] += bfhi(v[i].x); a[2] += bflo(v[i].y); a[3] += bfhi(v[i].y); a[4] += bflo(v[i].z); a[5] += bfhi(v[i].z); a[6] += bflo(v[i].w); a[7] += bfhi(v[i].w); } }
    *(LAS f32x4*)(S + g * 64 + ch * 8) = (f32x4){a[0], a[1], a[2], a[3]}; *(LAS f32x4*)(S + g * 64 + ch * 8 + 4) = (f32x4){a[4], a[5], a[6], a[7]};
    LDS_WAIT(); asm volatile("" ::: "memory");
    float s = 0.f;
#pragma unroll
    for (int q = 0; q < 8; ++q) s += S[q * 64 + lane];
    st_wt(KM + (size_t)it * 64 + lane, s * (1.f / 256.f)); publish_wave(kmc + 64 * bh, lane);
    LDS_WAIT(); asm volatile("" ::: "memory");
}
__device__ __forceinline__ void scan_item(int it, const float* KV, bf16* PREV, unsigned* kvc, unsigned* scc, unsigned* tmo, int tid, int lane) {
    const int bh = it >> 1, part = it & 1, hh = bh % NHM; const int idx = part * 2048 + 4 * tid;
    wait_count(kvc + 64 * bh, 128u, tmo, tid);
    const float g256 = ex2(256.0f * log2f(1.0f - ex2(-5.0f - (float)hh)));
    float k0[NCH], k1[NCH], k2[NCH], k3[NCH];
#pragma unroll
    for (int n = 0; n < NCH; ++n) { const float* p = KV + ((size_t)bh * NCH + n) * 4096 + idx; k0[n] = ld_wt(p); k1[n] = ld_wt(p + 1); k2[n] = ld_wt(p + 2); k3[n] = ld_wt(p + 3); }
    float s0 = 0.f, s1 = 0.f, s2 = 0.f, s3 = 0.f;
#pragma unroll
    for (int n = 0; n < NCH; ++n) { st_wt((unsigned long long*)(PREV + ((size_t)bh * NCH + n) * 4096 + idx), (unsigned long long)pk2(s0, s1) | ((unsigned long long)pk2(s2, s3) << 32));
        s0 = s0 * g256 + k0[n]; s1 = s1 * g256 + k1[n]; s2 = s2 * g256 + k2[n]; s3 = s3 * g256 + k3[n]; }
    publish_wave(scc + 64 * bh, lane);
}
__device__ __forceinline__ void gate_item(int it, const bf16* z, const float* KM, unsigned* SEL, unsigned* kmc, unsigned* gtc, unsigned* tmo, LAS unsigned char* lds, int tid, int lane) {
    const int bh = it >> 4, ip = it & 15, b = bh / NHM, hh = bh - b * NHM;
    wait_count(kmc + 64 * bh, 32u, tmo, tid);
    LAS float* km = (LAS float*)lds;
#pragma unroll
    for (int i = 0; i < 4; ++i) km[tid + 512 * i] = ld_wt(KM + (size_t)bh * 2048 + tid + 512 * i);
    __syncthreads();
    const int i = 2 * ip + (tid >> 8), s = 256 * i + (tid & 255);
    const bf16* qp = z + ((size_t)b * SEQ + s) * ZP + Z_MQ + 64 * hh;
    float q[64];
#pragma unroll
    for (int c = 0; c < 8; ++c) { const u32x4 v = *(const u32x4*)(qp + 8 * c);
        q[8 * c] = bflo(v.x); q[8 * c + 1] = bfhi(v.x); q[8 * c + 2] = bflo(v.y); q[8 * c + 3] = bfhi(v.y); q[8 * c + 4] = bflo(v.z); q[8 * c + 5] = bfhi(v.z); q[8 * c + 6] = bflo(v.w); q[8 * c + 7] = bfhi(v.w); }
    const float ninf = -__builtin_inff();
    float v0 = ninf, v1 = ninf, v2 = ninf; int i0 = 0, i1 = 0, i2 = 0;
    for (int j = 0; j < i; ++j) { float g = 0.f;
#pragma unroll
        for (int d = 0; d < 64; d += 4) { const f32x4 k4 = *(const LAS f32x4*)(km + j * 64 + d); g += q[d] * k4[0] + q[d + 1] * k4[1] + q[d + 2] * k4[2] + q[d + 3] * k4[3]; }
        if (g > v0) { v2 = v1; i2 = i1; v1 = v0; i1 = i0; v0 = g; i0 = j; }
        else if (g > v1) { v2 = v1; i2 = i1; v1 = g; i1 = j; }
        else if (g > v2) { v2 = g; i2 = j; } }
    unsigned mask = 0u;
    if (i > 0) mask |= 1u << i0;
    if (i > 1) mask |= 1u << i1;
    if (i > 2) mask |= 1u << i2;
    st_wt(SEL + (size_t)bh * SEQ + s, mask);
    publish_wave(gtc + 64 * bh, lane);
    __syncthreads();
}
__device__ __forceinline__ void attn_wave(LAS const unsigned char* Ki, LAS const unsigned char* Vi, const bf16x8 (&qf)[4], int nkt, int diag, int qloc, int lane, f32x16 (&o)[2], float& m, float& l) {
    const int r = lane & 31, h = lane >> 5, blk = (lane >> 4) & 1, q4 = (lane & 15) >> 2, p = lane & 3;
    o[0] = zero16(); o[1] = zero16(); l = 0.f; m = 0.f;
    f32x16 negm = zero16();
    bf16x8 kf[4];
#pragma unroll
    for (int s = 0; s < 4; ++s) kf[s] = ldsrow(Ki + r * PIT + 32 * s + 16 * h);
    for (int kt = 0; kt < nkt; ++kt) {
        f32x16 x = negm;
        asm volatile("" : "+v"(kf[0]), "+v"(kf[1]), "+v"(kf[2]), "+v"(kf[3]));
#pragma unroll
        for (int s = 0; s < 4; ++s) x = mfma32(kf[s], qf[s], x);
        const int ktn = (kt + 1 < nkt) ? kt + 1 : kt;
#pragma unroll
        for (int s = 0; s < 4; ++s) kf[s] = ldsrow(Ki + (32 * ktn + r) * PIT + 32 * s + 16 * h);
        bf16x8 vf[2][2];
#pragma unroll
        for (int s2 = 0; s2 < 2; ++s2) { const int ofv = (32 * kt + 16 * s2 + 4 * h + q4) * PIT + 32 * blk + 8 * p;
#pragma unroll
            for (int c = 0; c < 2; ++c) vf[s2][c] = cat8(vtr(Vi + ofv + 64 * c), vtr(Vi + ofv + 8 * PIT + 64 * c)); }
        __builtin_amdgcn_sched_barrier(0);
        if (kt == diag) {
#pragma unroll
            for (int i = 0; i < 16; ++i) if (32 * kt + crow(i, h) > qloc) x[i] = -__builtin_inff(); }
        float tm = x[0];
#pragma unroll
        for (int i = 1; i < 16; ++i) tm = fmaxf(tm, x[i]);
        tm = fmaxf(tm, __shfl_xor(tm, 32));
        if (kt == 0) { m = tm;
#pragma unroll
            for (int i = 0; i < 16; ++i) { x[i] -= tm; negm[i] = -tm; } }
        else if (__any(tm > 8.0f)) {
            const float dm = fmaxf(tm, 0.f), sc = ex2(-dm);
            l *= sc; o[0] = o[0] * sc; o[1] = o[1] * sc; m += dm;
#pragma unroll
            for (int i = 0; i < 16; ++i) { x[i] -= dm; negm[i] = -m; } }
#pragma unroll
        for (int i = 0; i < 16; ++i) { x[i] = ex2(x[i]); l += x[i]; }
        const bf16x8 pf0 = pack8(x, 0), pf1 = pack8(x, 1);
        __builtin_amdgcn_sched_barrier(0);
        o[0] = mfma32(vf[0][0], pf0, o[0]); o[1] = mfma32(vf[0][1], pf0, o[1]); o[0] = mfma32(vf[1][0], pf1, o[0]); o[1] = mfma32(vf[1][1], pf1, o[1]);
    }
}
__device__ __forceinline__ void store_partial(const f32x16 (&o)[2], float m, float l, bf16* OP, float* LSE, int bh, int slot, int qidx, bool valid, int lane, LAS unsigned char* ot) {
    const int r = lane & 31, h = lane >> 5; const float lt = l + __shfl_xor(l, 32), inv = 1.0f / lt;
    LAS int* rowdst = (LAS int*)(ot + 32 * 80);
    const int dst = valid ? (bh * 4 + slot) * SEQ + qidx : -1;
    if (h == 0) rowdst[r] = dst;
#pragma unroll
    for (int c = 0; c < 2; ++c)
#pragma unroll
        for (int g = 0; g < 4; ++g) { int w = __builtin_amdgcn_cvt_pk_fp8_f32(o[c][4 * g] * inv, o[c][4 * g + 1] * inv, 0, false); w = __builtin_amdgcn_cvt_pk_fp8_f32(o[c][4 * g + 2] * inv, o[c][4 * g + 3] * inv, w, true);
            *(LAS int*)(ot + r * 80 + 32 * c + 8 * g + 4 * h) = w; }
    if (valid && h == 0) LSE[(size_t)dst] = m + log2f(lt);
    LDS_WAIT(); asm volatile("" ::: "memory");
    u32x4 v[2]; int d[2];
#pragma unroll
    for (int k = 0; k < 2; ++k) { const int row = 16 * k + (lane >> 2); v[k] = *(const LAS u32x4*)(ot + row * 80 + (lane & 3) * 16); d[k] = rowdst[row]; }
#pragma unroll
    for (int k = 0; k < 2; ++k) if (d[k] >= 0) *(u32x4*)((unsigned char*)OP + (size_t)d[k] * 64 + 16 * (lane & 3)) = v[k];
    LDS_WAIT(); asm volatile("" ::: "memory");
}
__device__ __forceinline__ void moba_item(int bh, int j, bool own, int i0, int i1, const bf16* z, const unsigned* SEL, bf16* OP, float* LSE, unsigned* gtc, unsigned* tmo, LAS unsigned char* lds, int tid, int wave, int lane) {
    const int b = bh / NHM, hh = bh - b * NHM; const size_t tokb = (size_t)b * SEQ;
    wait_count(gtc + 64 * bh, 128u, tmo, tid);
    LAS unsigned char* Ki = lds; LAS unsigned char* Vi = lds + IMG; LAS unsigned short* list = (LAS unsigned short*)(lds + 2 * IMG); LAS int* wtot = (LAS int*)(lds + 2 * IMG + 4096);
    const int ncand = 256 * (i1 - i0), c0 = 4 * tid; int f[4] = {0, 0, 0, 0};
    u32x4 mk = {0u, 0u, 0u, 0u};
    if (c0 < ncand) { const unsigned* sp = SEL + (size_t)bh * SEQ + 256 * i0 + c0; mk = (u32x4){ld_wt(sp), ld_wt(sp + 1), ld_wt(sp + 2), ld_wt(sp + 3)}; }
    const int r = lane & 31, h = lane >> 5, qt = wave < 4 ? wave : 11 - wave;
    { LAS unsigned char* const d_[2] = {Ki, Vi}; const bf16* const s_[2] = {z + (tokb + 256 * j) * ZP + Z_MK + 64 * hh, z + (tokb + 256 * j) * ZP + Z_MV + 64 * hh}; stage256n<2>(d_, s_, ZP, tid); }
    f[0] = (mk.x >> j) & 1; f[1] = (mk.y >> j) & 1; f[2] = (mk.z >> j) & 1; f[3] = (mk.w >> j) & 1;
    const int mine = f[0] + f[1] + f[2] + f[3]; int inc = mine;
#pragma unroll
    for (int o = 1; o < 64; o <<= 1) { const int t = __shfl_up(inc, o); if (lane >= o) inc += t; }
    if (lane == 63) wtot[wave] = inc;
    __syncthreads();
    int base = 0, cnt = 0;
#pragma unroll
    for (int w = 0; w < 8; ++w) { const int t = wtot[w]; if (w < wave) base += t; cnt += t; }
    int pos = base + inc - mine;
#pragma unroll
    for (int k = 0; k < 4; ++k) if (f[k]) { list[pos] = (unsigned short)(256 * i0 + c0 + k); ++pos; }
    __syncthreads();
    const int ntl = (cnt + 255) >> 8, Tfirst = own ? -1 : 0;
    int qidx = 0; bool valid = false; unsigned mq = 0u; bf16x8 qn[4];
#define MOBA_LOADQ(Tn) do { if ((Tn) < 0) { qidx = 256 * j + 32 * qt + r; valid = true; } else { const int li_ = 256 * (Tn) + 32 * wave + r; valid = li_ < cnt; qidx = list[valid ? li_ : cnt - 1]; } \
        _Pragma("unroll") for (int s = 0; s < 4; ++s) qn[s] = *(const bf16x8*)(z + (tokb + qidx) * ZP + Z_MQ + 64 * hh + 16 * s + 8 * h); \
        mq = ld_wt(SEL + (size_t)bh * SEQ + qidx); } while (0)
    if (Tfirst < 0 || 32 * wave < cnt) MOBA_LOADQ(Tfirst);
    for (int T = Tfirst; T < ntl; ++T) {
        if (T >= 0 && 256 * T + 32 * wave >= cnt) break;
        bf16x8 qf[4];
#pragma unroll
        for (int s = 0; s < 4; ++s) qf[s] = qn[s];
        const int qcur = qidx, slot = (T < 0) ? 3 : __builtin_popcount(mq & ((1u << j) - 1u)); const bool vcur = valid;
        if (T + 1 < ntl && 256 * (T + 1) + 32 * wave < cnt) MOBA_LOADQ(T + 1);
        f32x16 o[2]; float m, l;
        attn_wave(Ki, Vi, qf, (T < 0) ? qt + 1 : 8, (T < 0) ? qt : -1, 32 * qt + r, lane, o, m, l);
        store_partial(o, m, l, OP, LSE, bh, slot, qcur, vcur, lane, lds + 2 * IMG + 8192 + wave * 3072);
    }
#undef MOBA_LOADQ
    __syncthreads();
}
__device__ __forceinline__ void ret_item(int it, const bf16* z, const bf16* PREV, bf16* mix, unsigned* scc, unsigned* tmo, LAS unsigned char* lds, int tid, int wave, int lane) {
    const int bh = it >> 5, n = it & 31, b = bh / NHM, hh = bh - b * NHM; const size_t tok0 = (size_t)b * SEQ + 256 * n;
    wait_count(scc + 64 * bh, 16u, tmo, tid);
    const float lg2 = log2f(1.0f - ex2(-5.0f - (float)hh));
    LAS unsigned char* Qi = lds; LAS unsigned char* Ki = lds + IMG; LAS unsigned char* Vi = lds + 2 * IMG; LAS unsigned char* Pi = lds + 3 * IMG;
    { const unsigned* pp_ = (const unsigned*)(PREV + (size_t)it * 4096 + (size_t)(tid >> 3) * 64 + (tid & 7) * 8);
      const u32x4 pv_ = {ld_wt(pp_), ld_wt(pp_ + 1), ld_wt(pp_ + 2), ld_wt(pp_ + 3)};
      LAS unsigned char* const d_[3] = {Qi, Ki, Vi}; const bf16* const s_[3] = {z + tok0 * ZP + Z_RQ + 64 * hh, z + tok0 * ZP + Z_RK + 64 * hh, z + tok0 * ZP + Z_RV + 64 * hh}; stage256n<3>(d_, s_, ZP, tid);
      *(LAS u32x4*)(Pi + (tid >> 3) * PIT + (tid & 7) * 16) = pv_; }
    __syncthreads();
    const int qt = wave < 4 ? wave : 11 - wave, r = lane & 31, h = lane >> 5, blk = (lane >> 4) & 1, q4 = (lane & 15) >> 2, p = lane & 3, qloc = 32 * qt + r;
    const bf16* gp = z + (tok0 + qloc) * ZP + Z_RG + 64 * hh;
    u32x2 gvv[2][4];
#pragma unroll
    for (int c = 0; c < 2; ++c)
#pragma unroll
        for (int g = 0; g < 4; ++g) gvv[c][g] = (hh < 4) ? *(const u32x2*)(gp + 32 * c + 8 * g + 4 * h) : (u32x2){0u, 0u};
    bf16x8 qf[4];
#pragma unroll
    for (int s = 0; s < 4; ++s) qf[s] = ldsrow(Qi + qloc * PIT + 32 * s + 16 * h);
    f32x16 cx[2], o[2]; cx[0] = zero16(); cx[1] = zero16(); o[0] = zero16(); o[1] = zero16();
#pragma unroll
    for (int c = 0; c < 2; ++c)
#pragma unroll
        for (int s = 0; s < 4; ++s) cx[c] = mfma32(ldsrow(Pi + (32 * c + r) * PIT + 32 * s + 16 * h), qf[s], cx[c]);
    float grel[16];
#pragma unroll
    for (int i = 0; i < 16; ++i) grel[i] = ex2((float)(r - crow(i, h)) * lg2);
    bf16x8 kf[4];
#pragma unroll
    for (int s = 0; s < 4; ++s) kf[s] = ldsrow(Ki + r * PIT + 32 * s + 16 * h);
    for (int kt = 0; kt <= qt; ++kt) {
        f32x16 x = zero16();
        asm volatile("" : "+v"(kf[0]), "+v"(kf[1]), "+v"(kf[2]), "+v"(kf[3]));
#pragma unroll
        for (int s = 0; s < 4; ++s) x = mfma32(kf[s], qf[s], x);
        const int ktn = (kt < qt) ? kt + 1 : kt;
#pragma unroll
        for (int s = 0; s < 4; ++s) kf[s] = ldsrow(Ki + (32 * ktn + r) * PIT + 32 * s + 16 * h);
        bf16x8 vf[2][2];
#pragma unroll
        for (int s2 = 0; s2 < 2; ++s2) { const int ofv = (32 * kt + 16 * s2 + 4 * h + q4) * PIT + 32 * blk + 8 * p;
#pragma unroll
            for (int c = 0; c < 2; ++c) vf[s2][c] = cat8(vtr(Vi + ofv + 64 * c), vtr(Vi + ofv + 8 * PIT + 64 * c)); }
        __builtin_amdgcn_sched_barrier(0);
        { const float ts = ex2((float)(32 * (qt - kt)) * lg2);
#pragma unroll
        for (int i = 0; i < 16; ++i) { const float wv = grel[i] * ts; x[i] = (kt < qt || r >= crow(i, h)) ? x[i] * wv : 0.f; } }
        const bf16x8 pf0 = pack8(x, 0), pf1 = pack8(x, 1);
        __builtin_amdgcn_sched_barrier(0);
        o[0] = mfma32(vf[0][0], pf0, o[0]); o[1] = mfma32(vf[0][1], pf0, o[1]); o[0] = mfma32(vf[1][0], pf1, o[0]); o[1] = mfma32(vf[1][1], pf1, o[1]);
    }
    const float wcr = ex2((float)(qloc + 1) * lg2); float ss = 0.f;
#pragma unroll
    for (int c = 0; c < 2; ++c)
#pragma unroll
        for (int i = 0; i < 16; ++i) { const float y = o[c][i] + wcr * cx[c][i]; o[c][i] = y; ss += y * y; }
    ss += __shfl_xor(ss, 32);
    const float rn = __builtin_amdgcn_rsqf(ss * (1.f / 64.f) + RMS_EPS);
    bf16* mp = mix + (tok0 + qloc) * DM + X_RET + 64 * hh;
#pragma unroll
    for (int c = 0; c < 2; ++c)
#pragma unroll
        for (int g = 0; g < 4; ++g) { const int e0 = 32 * c + 8 * g + 4 * h; const u32x2 gv = gvv[c][g]; u32x2 w;
            if (hh < 4) { w.x = pk2(silu1(bflo(gv.x)) * o[c][4 * g] * rn, silu1(bfhi(gv.x)) * o[c][4 * g + 1] * rn); w.y = pk2(silu1(bflo(gv.y)) * o[c][4 * g + 2] * rn, silu1(bfhi(gv.y)) * o[c][4 * g + 3] * rn); }
            else { w.x = pk2(o[c][4 * g] * rn, o[c][4 * g + 1] * rn); w.y = pk2(o[c][4 * g + 2] * rn, o[c][4 * g + 3] * rn); }
            *(u32x2*)(mp + e0) = w; }
    __syncthreads();
}
struct CombIn { unsigned selw; float ls[4]; u32x2 ov[4]; };
__device__ __forceinline__ void combine_load(int idx, const bf16* OP, const float* LSE, const unsigned* SEL, CombIn& c) {
    const int ch = idx & 7, th = idx >> 3, hh = th % NHM, tok = th / NHM, b = tok >> 13, s = tok & (SEQ - 1), bh = b * NHM + hh;
    c.selw = SEL[(size_t)bh * SEQ + s];
#pragma unroll
    for (int k = 0; k < 4; ++k) { c.ls[k] = LSE[((size_t)bh * 4 + k) * SEQ + s]; c.ov[k] = *(const u32x2*)((const unsigned char*)OP + (((size_t)bh * 4 + k) * SEQ + s) * 64 + 8 * ch); }
}
__device__ __forceinline__ void combine_store(int idx, const CombIn& c, bf16* mix) {
    const int ch = idx & 7, th = idx >> 3, hh = th % NHM, tok = th / NHM;
    const int ns = __builtin_popcount(c.selw); float mx = -__builtin_inff(); float ls[4];
#pragma unroll
    for (int k = 0; k < 4; ++k) { const bool on = (k == 3) || (k < ns); ls[k] = on ? c.ls[k] : -__builtin_inff(); mx = fmaxf(mx, ls[k]); }
    float a[8], wsum = 0.f;
#pragma unroll
    for (int k = 0; k < 8; ++k) a[k] = 0.f;
#pragma unroll
    for (int k = 0; k < 4; ++k) { const bool on = (k == 3) || (k < ns); const float wg = on ? ex2(ls[k] - mx) : 0.f; wsum += wg;
        u32x2 v = c.ov[k]; if (!on) v = (u32x2){0u, 0u};
        const f32x2 p0 = __builtin_amdgcn_cvt_pk_f32_fp8((int)v.x, false), p1 = __builtin_amdgcn_cvt_pk_f32_fp8((int)v.x, true), p2 = __builtin_amdgcn_cvt_pk_f32_fp8((int)v.y, false), p3 = __builtin_amdgcn_cvt_pk_f32_fp8((int)v.y, true);
        a[0] += wg * p0[0]; a[1] += wg * p0[1]; a[2] += wg * p1[0]; a[3] += wg * p1[1]; a[4] += wg * p2[0]; a[5] += wg * p2[1]; a[6] += wg * p3[0]; a[7] += wg * p3[1]; }
    const float inv = 1.0f / wsum; u32x4 w; w.x = pk2(a[0] * inv, a[1] * inv); w.y = pk2(a[2] * inv, a[3] * inv); w.z = pk2(a[4] * inv, a[5] * inv); w.w = pk2(a[6] * inv, a[7] * inv);
    *(u32x4*)(mix + (size_t)tok * DM + X_MOBA + 64 * hh + 8 * ch) = w;
}
__device__ __forceinline__ void rgate_item2(int idx0, int idx1, const bf16* z, bf16* mix) {
    u32x4 g[2], v[2]; bf16* mp[2];
#pragma unroll
    for (int k = 0; k < 2; ++k) { const int idx = k ? idx1 : idx0, ch = idx & 7, th = idx >> 3, hh = 4 + (th & 1), tok = th >> 1;
        g[k] = *(const u32x4*)(z + (size_t)tok * ZP + Z_RG + 64 * hh + 8 * ch); mp[k] = mix + (size_t)tok * DM + X_RET + 64 * hh + 8 * ch; v[k] = *(const u32x4*)mp[k]; }
#pragma unroll
    for (int k = 0; k < 2; ++k) { if (k == 1 && idx1 == idx0) break; u32x4 w;
        w.x = pk2(silu1(bflo(g[k].x)) * bflo(v[k].x), silu1(bfhi(g[k].x)) * bfhi(v[k].x)); w.y = pk2(silu1(bflo(g[k].y)) * bflo(v[k].y), silu1(bfhi(g[k].y)) * bfhi(v[k].y));
        w.z = pk2(silu1(bflo(g[k].z)) * bflo(v[k].z), silu1(bfhi(g[k].z)) * bfhi(v[k].z)); w.w = pk2(silu1(bflo(g[k].w)) * bflo(v[k].w), silu1(bfhi(g[k].w)) * bfhi(v[k].w));
        *(u32x4*)mp[k] = w; }
}
#ifndef MK_PER_PHASE
#define MK_PER_PHASE 0
#endif
constexpr int N_PHASES = 1 + DEPTH * 8;
constexpr int T_KM = NBH * NCH / 8, T_KV = T_KM + NBH * NCH / 2, T_GT = T_KV + NBH * 16, T_SC = T_GT + NBH * 2, T_CV = T_SC + 256, T_G13 = T_CV + M / 256, MIXC_LIST = NBH * 76, T_MB = T_G13 + MIXC_LIST, T_RT = T_MB + NBH * NCH, MIXC_ITEMS = T_RT + NBH;

__global__ void __launch_bounds__(512, 2) fwd(Args args) {
    extern __shared__ __attribute__((aligned(16))) unsigned char lds_raw[];
    LAS unsigned char* lds = (LAS unsigned char*)lds_raw;
    volatile LAS unsigned* MISC = (volatile LAS unsigned*)(lds + MISC_OFF);
    const int tid0 = threadIdx.x, wave0 = __builtin_amdgcn_readfirstlane(tid0 >> 6);
    const int G = gridDim.x, bid = blockIdx.x, NGW = G * 8;
    unsigned char* const ws0 = args.ws;
    unsigned* ctl = (unsigned*)(ws0 + WS_CTL);
    for (int u = tid0; u < (LDS_BYTES - LDSCTL_OFF) / 4; u += 512) ((LAS unsigned*)(lds + LDSCTL_OFF))[u] = 0u;
    __syncthreads();
    XcdBarrier bar; bar.bar = ctl + CW_BAR; bar.x = 0; bar.st = nullptr;
    if (!MK_PER_PHASE) bar = xcd_barrier_post(ctl + CW_BAR, MISC + 8);
    if (tid0 == 0) __hip_atomic_store(ctl + CW_XT + bid, xb_xcc_id() + 1u, __ATOMIC_RELAXED, __HIP_MEMORY_SCOPE_AGENT);
    int lok = 0;
    const int lo = args.ph_lo, hi = args.ph_hi; int pc = 0;
#define RUN (pc >= lo && pc < hi)
#define SEAM do { ++pc; if (!MK_PER_PHASE && pc > lo && pc < hi) xcd_barrier(bar); } while (0)
#define SEAM_LOCAL do { ++pc; if (!MK_PER_PHASE && pc > lo && pc < hi) { if (lok) xcd_local_barrier(ctl + CW_LB, bar.x, 32u, ctl + CW_TMO); else xcd_barrier(bar); } } while (0)

#define ENV unsigned sd_ = 0u; asm volatile("" : "+s"(sd_)); int tid = wave0 * 64 + (int)__builtin_amdgcn_mbcnt_hi(~0u, __builtin_amdgcn_mbcnt_lo(~0u, sd_)); asm volatile("" : "+v"(tid)); const int lane = tid & 63, wave = __builtin_amdgcn_readfirstlane(tid >> 6), gw = bid * 8 + wave; (void)lane; (void)gw; \
    GAS unsigned char* wsl = (GAS unsigned char*)ws0; asm volatile("" : "+s"(wsl)); unsigned char* ws = (unsigned char*)wsl; int zi = 0; asm volatile("" : "+s"(zi)); GAS float* xresl = (GAS float*)args.out; asm volatile("" : "+s"(xresl)); float* xres = (float*)xresl; \
    bf16* XB = (bf16*)(ws + WS_XB); bf16* Z = (bf16*)(ws + WS_Z); bf16* ACT = (bf16*)(ws + WS_ACT); bf16* MIX = (bf16*)(ws + WS_MIX); \
    bf16* OP = (bf16*)(ws + WS_OP); float* LSE = (float*)(ws + WS_LSE); unsigned* SEL = (unsigned*)(ws + WS_SEL); \
    float* RT = (float*)(ws + WS_RT); float* MT = (float*)(ws + WS_MT); float* SSQ = (float*)(ws + WS_SSQ); \
    float* KV = (float*)(ws + WS_KV); bf16* PREV = (bf16*)(ws + WS_PREV); float* KM = (float*)(ws + WS_KM); \
    LAS float* scr = (LAS float*)(lds + wave * 16384); (void)scr; (void)XB; (void)Z; (void)ACT; (void)MIX; (void)OP; (void)LSE; (void)SEL; (void)RT; (void)MT; (void)SSQ; (void)KV; (void)PREV; (void)KM; (void)xres
#define INP(k) ((const float*)(GAS const float*)args.in[(k) + zi])

#define CVT_PULL_L(hd, L_, blo, bhi) do { unsigned* cvh = (unsigned*)(ws + WS_CTL) + CW_Q + 64 * (hd); \
        for (;;) { __syncthreads(); if (tid == 0) MISC[1] = __hip_atomic_fetch_add(cvh, 1u, __ATOMIC_RELAXED, __HIP_MEMORY_SCOPE_AGENT); __syncthreads(); \
            const int bt = (blo) + (int)MISC[1]; if (bt >= (bhi)) break; \
            cvt_layer_batch(args, zi, (L_), ws + WS_W + (size_t)((L_) & 1) * WBUF_BYTES, bt, lds, wave, lane); } } while (0)
#define CVT_PULL(qi, blo, bhi) do { if (l + 1 < DEPTH) CVT_PULL_L(8 + 2 * l + (qi), l + 1, blo, bhi); } while (0)

    if (RUN) { ENV; const float* x_in = INP(0);
        CVT_PULL_L(14, 0, 0, b_layer(0));
        for (int m = gw; m < M; m += 2 * NGW) {
            const int m1 = (m + NGW < M) ? m + NGW : m;
            const f32x4* xr0 = (const f32x4*)(x_in + (size_t)m * DM) + lane; const f32x4* xr1 = (const f32x4*)(x_in + (size_t)m1 * DM) + lane; f32x4 v0[4], v1[4]; float s0[4], s1[4];
#pragma unroll
            for (int j = 0; j < 4; ++j) { v0[j] = xr0[64 * j]; v1[j] = xr1[64 * j]; }
#pragma unroll
            for (int j = 0; j < 4; ++j) { s0[j] = (v0[j][0] * v0[j][0] + v0[j][1] * v0[j][1]) + (v0[j][2] * v0[j][2] + v0[j][3] * v0[j][3]); s1[j] = (v1[j][0] * v1[j][0] + v1[j][1] * v1[j][1]) + (v1[j][2] * v1[j][2] + v1[j][3] * v1[j][3]); }
            float am0 = 0.f, am1 = 0.f;
#pragma unroll
            for (int j = 0; j < 4; ++j) { am0 = fmaxf(am0, fmaxf(fmaxf(fabsf(v0[j][0]), fabsf(v0[j][1])), fmaxf(fabsf(v0[j][2]), fabsf(v0[j][3])))); am1 = fmaxf(am1, fmaxf(fmaxf(fabsf(v1[j][0]), fabsf(v1[j][1])), fmaxf(fabsf(v1[j][2]), fabsf(v1[j][3])))); }
#pragma unroll
            for (int o = 1; o < 64; o <<= 1) {
#pragma unroll
                for (int j = 0; j < 4; ++j) { s0[j] += __shfl_xor(s0[j], o); s1[j] += __shfl_xor(s1[j], o); }
                am0 = fmaxf(am0, __shfl_xor(am0, o)); am1 = fmaxf(am1, __shfl_xor(am1, o)); }
            unsigned long long* o0 = (unsigned long long*)(XB + (size_t)m * DM) + lane; unsigned long long* o1 = (unsigned long long*)(XB + (size_t)m1 * DM) + lane;
#pragma unroll
            for (int j = 0; j < 4; ++j) { o0[64 * j] = (unsigned long long)pk2(v0[j][0], v0[j][1]) | ((unsigned long long)pk2(v0[j][2], v0[j][3]) << 32); o1[64 * j] = (unsigned long long)pk2(v1[j][0], v1[j][1]) | ((unsigned long long)pk2(v1[j][2], v1[j][3]) << 32); }
            { const float iv0 = am0 > 0.f ? 127.0f / am0 : 0.f, iv1 = am1 > 0.f ? 127.0f / am1 : 0.f; unsigned* q0 = (unsigned*)(ws + WS_X8 + (size_t)m * DM) + lane; unsigned* q1 = (unsigned*)(ws + WS_X8 + (size_t)m1 * DM) + lane;
#pragma unroll
              for (int j = 0; j < 4; ++j) { q0[64 * j] = pg8::q8x4(v0[j][0], v0[j][1], v0[j][2], v0[j][3], iv0); q1[64 * j] = pg8::q8x4(v1[j][0], v1[j][1], v1[j][2], v1[j][3], iv1); } }
            if (lane == 0) { *(f32x4*)(SSQ + (size_t)m * 4) = (f32x4){s0[0], s0[1], s0[2], s0[3]}; *(f32x4*)(SSQ + (size_t)m1 * 4) = (f32x4){s1[0], s1[1], s1[2], s1[3]};
                float* RF = (float*)(ws + WS_RF); RF[m] = __builtin_amdgcn_rsqf(((s0[0] + s0[1]) + (s0[2] + s0[3])) * (1.0f / 1024.0f) + RMS_EPS) * am0 * (1.0f / 127.0f); RF[m1] = __builtin_amdgcn_rsqf(((s1[0] + s1[1]) + (s1[2] + s1[3])) * (1.0f / 1024.0f) + RMS_EPS) * am1 * (1.0f / 127.0f); } }
        const int* pos = (const int*)INP(1);
        for (int i = bid * 512 + tid; i < M * 40; i += G * 512) { const int row = i / 40, k = i - row * 40; float c, s; sincos_acc((float)pos[row] * args.invf[k], c, s);
            float* t = (k < 32) ? RT + (size_t)row * 64 + 2 * k : MT + (size_t)row * 16 + 2 * (k - 32); *(f32x2*)t = (f32x2){c, s}; }
    }
    SEAM;
    if (!MK_PER_PHASE && lo == 0 && hi > 1) {
        int ok = (G == 256);
        if (tid0 < G) { const unsigned v = __hip_atomic_load(ctl + CW_XT + tid0, __ATOMIC_RELAXED, __HIP_MEMORY_SCOPE_AGENT), r = __hip_atomic_load(ctl + CW_XT + (tid0 & 7), __ATOMIC_RELAXED, __HIP_MEMORY_SCOPE_AGENT); ok &= (v == r) && (v != 0u); }
        unsigned seen = 0u;
#pragma unroll
        for (int q = 0; q < 8; ++q) seen |= 1u << (__hip_atomic_load(ctl + CW_XT + q, __ATOMIC_RELAXED, __HIP_MEMORY_SCOPE_AGENT) & 31u);
        ok &= (__builtin_popcount(seen) == 8);
        lok = __syncthreads_and(ok);
    }

    for (int l = 0; l < DEPTH; ++l) {
        for (int hf = 0; hf < 2; ++hf) {
            if (RUN) { ENV; unsigned char* wb = ws + WS_W + (size_t)(l & 1) * WBUF_BYTES; unsigned char* wgu = wb + (hf ? WO_GU2 : WO_GU1);
                pg8::Gemm g{(const bf16*)(ws + WS_X8), (const bf16*)wgu, M, NGU, DM / 2}; pg8::StaticOrder S; S.init(M, NGU, G, bid);
                pg8::EpiGU8 E{ACT, (const LAS float*)(lds + LDSCTL_OFF + 1024), (const LAS float*)(lds + LDSCTL_OFF + 7168)};
                { LAS float* rt_ = (LAS float*)(lds + LDSCTL_OFF + 1024); LAS float* ct_ = (LAS float*)(lds + LDSCTL_OFF + 7168); const float* RF = (const float*)(ws + WS_RF); const float* SWt = (const float*)(wgu + WO_SW);
                  pg8::Unit u_; for (int i_ = 0; S.next(i_, u_); ++i_) if (tid < 256) { rt_[i_ * 256 + tid] = RF[u_.pm * 256 + tid]; ct_[i_ * 256 + tid] = SWt[u_.pn * 256 + tid]; } __syncthreads(); }
                pg8::gemm_phase<pg8::EpiGU8, pg8::StaticOrder, true, true, true>(lds, g, S, E, tid);
                if (hf == 0) CVT_PULL(0, 0, b_early(l + 1)); else CVT_PULL(1, b_early(l + 1), b_layer(l + 1)); }
            SEAM_LOCAL;
            if (RUN) { ENV; unsigned char* wb = ws + WS_W + (size_t)(l & 1) * WBUF_BYTES; pg8::Gemm g{ACT, (const bf16*)(wb + (hf ? WO_D2 : WO_D1)), M, DM, FF}; pg8::StaticOrder S; S.init(M, DM, G, bid);
                const bool q8_ = hf == 1 && l + 1 < DEPTH, fin_ = hf == 1 && l + 1 == DEPTH;
                pg8::EpiRes E{XB, SSQ, 0.5f, 2.0f, (q8_ || (hf == 0 && l >= WIN8_FROM)) ? (signed char*)(ws + WS_X8) : nullptr, (float*)(ws + WS_RF), (float*)(ws + WS_EX), (unsigned*)(ws + WS_CTL) + CW_PC + 16 * 64 * (3 * l + (hf ? 2 : 0)), (unsigned*)(ws + WS_CTL) + CW_TMO, fin_ ? xres : nullptr, INP(17)};
                pg8::gemm_phase<pg8::EpiRes, pg8::StaticOrder, false, true>(lds, g, S, E, tid); }
            SEAM_LOCAL;
            if (hf == 0) {
                if (RUN && l < WIN8_FROM) { ENV; unsigned char* wb = ws + WS_W + (size_t)(l & 1) * WBUF_BYTES; pg8::Gemm g{XB, (const bf16*)(wb + WO_IN), M, ZN1, DM}; pg8::StaticOrder S; S.init(M, ZN1, G, bid);
                    pg8::EpiWin E{Z, (const LAS float*)(lds + LDSCTL_OFF + 1024), RT, MT};
                    { LAS float* rt_ = (LAS float*)(lds + LDSCTL_OFF + 1024); pg8::Unit u_; for (int i_ = 0; S.next(i_, u_); ++i_) if (tid < 256) rt_[i_ * 256 + tid] = pg8::row_rstd(SSQ, u_.pm * 256 + tid); __syncthreads(); }
                pg8::gemm_phase<pg8::EpiWin, pg8::StaticOrder, true, true>(lds, g, S, E, tid); }
                if (RUN && l >= WIN8_FROM) { ENV; unsigned char* wb = ws + WS_W + (size_t)(l & 1) * WBUF_BYTES; pg8::Gemm g{(const bf16*)(ws + WS_X8), (const bf16*)(wb + WO_IN8), M, ZN1, DM / 2}; pg8::StaticOrder S; S.init(M, ZN1, G, bid);
                    pg8::EpiWin8 E{Z, (const LAS float*)(lds + LDSCTL_OFF + 1024), RT, MT, (const LAS float*)(lds + LDSCTL_OFF + 7168)};
                    { LAS float* rt_ = (LAS float*)(lds + LDSCTL_OFF + 1024); LAS float* ct_ = (LAS float*)(lds + LDSCTL_OFF + 7168); const float* RF = (const float*)(ws + WS_RF); const float* SWt = (const float*)(wb + WO_SWIN);
                      pg8::Unit u_; for (int i_ = 0; S.next(i_, u_); ++i_) if (tid < 256) { rt_[i_ * 256 + tid] = RF[u_.pm * 256 + tid]; ct_[i_ * 256 + tid] = SWt[u_.pn * 256 + tid]; } __syncthreads(); }
                pg8::gemm_phase<pg8::EpiWin8, pg8::StaticOrder, true, true, true>(lds, g, S, E, tid); }
                SEAM;
                if (RUN) { ENV;
                    unsigned* head = (unsigned*)(ws + WS_CTL) + CW_Q + 64 * l;
                    unsigned nxt = (unsigned)bid;
                    for (;;) {
                        __syncthreads();
                        if (tid == 0) MISC[0] = nxt;
                        __syncthreads();
                        int it = (int)MISC[0];
                        if (it >= MIXC_ITEMS) break;
                        int tq = tid; asm volatile("" : "+v"(tq)); const int lq = tq & 63;
                        if (tid == 0) nxt = (unsigned)G + __hip_atomic_fetch_add(head, 1u, __ATOMIC_RELAXED, __HIP_MEMORY_SCOPE_AGENT);
                        unsigned* hc = (unsigned*)(ws + WS_CTL) + CW_HC + 64 * 16 * 4 * l; unsigned* kmc = hc, * kvc = hc + 64 * 16, * gtc = hc + 64 * 32, * scc = hc + 64 * 48; unsigned* tmo = (unsigned*)(ws + WS_CTL) + CW_TMO;
                        if (it < T_KM) kmean_item(it, Z, KM, kmc, lds, wave, lq);
                        else if (it < T_KV) kv_item(it - T_KM, Z, KV, kvc, lds, tq, wave, lq);
                        else if (it < T_GT) gate_item(it - T_KV, Z, KM, SEL, kmc, gtc, tmo, lds, tq, lq);
                        else if (it < T_SC) scan_item(it - T_GT, KV, PREV, kvc, scc, tmo, tq, lq);
                        else if (it < T_CV) conv_item(it - T_SC, Z, MIX, INP(8) + (size_t)l * 31 * 256, INP(9) + l * 256, INP(10) + l * 256, INP(11) + l * 256, lds, tq, wave, lq);
                        else if (it < T_G13) {
                            const int pm_ = it - T_CV;
                            if (l < WIN8_FROM) {
                            unsigned char* wb = ws + WS_W + (size_t)(l & 1) * WBUF_BYTES; pg8::Gemm g{XB, (const bf16*)(wb + WO_IN), M, ZNP, DM}; pg8::OneUnit S{pm_, ZN1 / 256};
                            pg8::EpiWin E{Z, (const LAS float*)(lds + LDSCTL_OFF + 1024), RT, MT};
                            { LAS float* rt_ = (LAS float*)(lds + LDSCTL_OFF + 1024); if (tq < 256) rt_[tq] = pg8::row_rstd(SSQ, pm_ * 256 + tq); __syncthreads(); }
                            pg8::gemm_phase<pg8::EpiWin, pg8::OneUnit, false, true>(lds, g, S, E, tq); }
                            else {
                            unsigned char* wb = ws + WS_W + (size_t)(l & 1) * WBUF_BYTES; pg8::Gemm g{(const bf16*)(ws + WS_X8), (const bf16*)(wb + WO_IN8), M, ZNP, DM / 2}; pg8::OneUnit S{pm_, ZN1 / 256};
                            pg8::EpiWin8 E{Z, (const LAS float*)(lds + LDSCTL_OFF + 1024), RT, MT, (const LAS float*)(lds + LDSCTL_OFF + 7168)};
                            { LAS float* rt_ = (LAS float*)(lds + LDSCTL_OFF + 1024); LAS float* ct_ = (LAS float*)(lds + LDSCTL_OFF + 7168);
                              if (tq < 256) { rt_[tq] = ((const float*)(ws + WS_RF))[pm_ * 256 + tq]; ct_[tq] = ((const float*)(wb + WO_SWIN))[ZN1 + tq]; } __syncthreads(); }
                            pg8::gemm_phase<pg8::EpiWin8, pg8::OneUnit, false, true, true>(lds, g, S, E, tq); } }
                        else if (it >= T_MB && it < T_RT) ret_item(it - T_MB, Z, PREV, MIX, scc, tmo, lds, tq, wave, lq);
                        else { int bh, j, i0, i1; bool own;
                            if (it < T_MB) { const int rank = (it - T_G13) / NBH; bh = (it - T_G13) - rank * NBH; i0 = 1; int rem = rank;
                                while (rem >= ((i0 - 1) >> 3) + 1) { rem -= ((i0 - 1) >> 3) + 1; ++i0; }
                                j = i0 - 1 - 8 * rem; i1 = (i0 + 8 < NCH) ? i0 + 8 : NCH; own = rem == 0; }
                            else { bh = it - T_RT; j = NCH - 1; i0 = NCH; i1 = NCH; own = true; }
                            moba_item(bh, j, own, i0, i1, Z, SEL, OP, LSE, gtc, tmo, lds, tq, wave, lq); }
                    }
                }
                SEAM;
                if (RUN) { ENV; { constexpr int NCMB = M * NHM * 8; const int st_ = G * 512;
                    for (int i = bid * 512 + tid; i < NCMB; i += 3 * st_) { CombIn c0, c1, c2; const int i1 = (i + st_ < NCMB) ? i + st_ : i, i2 = (i + 2 * st_ < NCMB) ? i + 2 * st_ : i;
                        combine_load(i, OP, LSE, SEL, c0); combine_load(i1, OP, LSE, SEL, c1); combine_load(i2, OP, LSE, SEL, c2);
                        combine_store(i, c0, MIX); combine_store(i1, c1, MIX); combine_store(i2, c2, MIX); } }
                    { constexpr int NRG = M * 2 * 8; const int st_ = G * 512; for (int i = bid * 512 + tid; i < NRG; i += 2 * st_) rgate_item2(i, (i + st_ < NRG) ? i + st_ : i, Z, MIX); } }
                SEAM;
                if (RUN) { ENV; unsigned char* wb = ws + WS_W + (size_t)(l & 1) * WBUF_BYTES; pg8::Gemm g{MIX, (const bf16*)(wb + WO_OUT), M, DM, DM}; pg8::StaticOrder S; S.init(M, DM, G, bid);
                    pg8::EpiRes E{XB, SSQ, 1.0f, 1.0f, (signed char*)(ws + WS_X8), (float*)(ws + WS_RF), (float*)(ws + WS_EX), (unsigned*)(ws + WS_CTL) + CW_PC + 16 * 64 * (3 * l + 1), (unsigned*)(ws + WS_CTL) + CW_TMO, nullptr, nullptr};
                    pg8::gemm_phase<pg8::EpiRes, pg8::StaticOrder, false, true>(lds, g, S, E, tid); }
                SEAM_LOCAL;
            }
        }
    }
#undef RUN
#undef SEAM
}

extern "C" void kernel_launch(void* const* d_in, const int* in_sizes, int n_in, void* d_out, int out_size, void* d_ws, size_t ws_size, hipStream_t stream) {
    static int grid = 0;
    if (grid == 0) {
        if (n_in != 18 || in_sizes[0] != M * DM || out_size != M * DM || ws_size < WS_END) { fprintf(stderr, "kernel_launch: unexpected problem shape (n_in %d, in0 %d, out %d, ws %zu); nothing launched\n", n_in, n_in > 0 ? in_sizes[0] : -1, out_size, ws_size); grid = -1; return; }
        int dev = 0, cus = 0, per_cu = 0;
        if (hipGetDevice(&dev) != hipSuccess || hipDeviceGetAttribute(&cus, hipDeviceAttributeMultiprocessorCount, dev) != hipSuccess) { grid = -1; return; }
        if (hipFuncSetAttribute((const void*)fwd, hipFuncAttributeMaxDynamicSharedMemorySize, LDS_BYTES) != hipSuccess) { fprintf(stderr, "kernel_launch: hipFuncSetAttribute failed\n"); grid = -1; return; }
        if (hipOccupancyMaxActiveBlocksPerMultiprocessor(&per_cu, (const void*)fwd, 512, LDS_BYTES) != hipSuccess || per_cu < 1) { fprintf(stderr, "kernel_launch: occupancy query reports %d blocks per CU\n", per_cu); }
        (void)hipGetLastError();
        grid = cus;
        if (grid != 256) fprintf(stderr, "kernel_launch: %d CUs; the N = 1024 GEMM phases assume a 256-workgroup grid\n", grid);
        if (grid > 256) grid = 256;
    }
    if (grid < 0) return;
    if (hipMemsetAsync((char*)d_ws + WS_CTL, 0, CTL_BYTES, stream) != hipSuccess) return;
    Args a{};
    for (int i = 0; i < 18; ++i) a.in[i] = (const float*)d_in[i];
    a.out = (float*)d_out; a.ws = (unsigned char*)d_ws;
    for (int i = 0; i < 32; ++i) { const float t = (float)i / 31.0f; a.invf[i] = (float)pow(10000.0, -(double)t); }
    for (int i = 0; i < 8; ++i) { const float t = (float)i / 8.0f; a.invf[32 + i] = (float)pow(500000.0, -(double)t); }
#if MK_PER_PHASE
    for (int p = 0; p < N_PHASES; ++p) { a.ph_lo = p; a.ph_hi = p + 1; hipLaunchKernelGGL(fwd, dim3(grid), dim3(512), LDS_BYTES, stream, a); }
#else
    a.ph_lo = 0; a.ph_hi = N_PHASES;
    hipLaunchKernelGGL(fwd, dim3(grid), dim3(512), LDS_BYTES, stream, a);
#endif
}
```

```cpp
#include <hip/hip_runtime.h>
#include <cstdio>
#include <cstdint>
#include <cmath>

constexpr int BATCH = 2, SEQ = 8192, DM = 1024, DEPTH = 4, HD = 64, NHM = 6;
constexpr int M = BATCH * SEQ, FF = 2816, NGU = 2 * FF, ZN = 3200, ZNP = 3328, ZP = ZNP, NCH = SEQ / 256, NBH = BATCH * NHM;
constexpr float RMS_EPS = 1e-6f;
constexpr float C2 = 0.125f * 1.4426950408889634f;
constexpr int Z_RQ = 0, Z_RK = 384, Z_MQ = 768, Z_MK = 1152, Z_RV = 1536, Z_MV = 1920, Z_CA = 2304, Z_CG = 2560, Z_RG = 2816;
constexpr int ZN1 = 3072;
constexpr int X_RET = 0, X_MOBA = 384, X_CONV = 768;

namespace pg8 {
#define PG8_LAS __attribute__((address_space(3)))
typedef unsigned short bf16_t;
typedef short bf16x8 __attribute__((ext_vector_type(8)));
typedef float f32x4 __attribute__((ext_vector_type(4)));
typedef unsigned u32x4 __attribute__((ext_vector_type(4)));
constexpr int BM = 256, BK = 64, HALF = 128, HTB = HALF * BK * 2  , STAGE_BYTES = 8 * HTB, NXCD = 8, WGM = 8;

__host__ __device__ __forceinline__ int lds_byte(int r, int c) { const int st = (r >> 4) * 2 + (c >> 5), rr = r & 15, cc = c & 31, ob = rr * 64 + cc * 2; return st * 1024 + (ob ^ (((ob >> 9) & 1) << 5)); }
__host__ __device__ __forceinline__ void stage_rc(int b, int& R, int& C) { const int st = b / 1024, sb = b % 1024, swz = sb ^ (((sb >> 9) & 1) << 5); R = (st >> 1) * 16 + swz / 64; C = (st & 1) * 32 + (swz % 64) / 2; }
__host__ __device__ __forceinline__ int perm32(int rho) { const int n = rho >> 4, i = rho & 15; return 8 * (i >> 2) + 4 * n + (i & 3); }

struct Unit { int pm, pn, ord; };
struct Gemm { const bf16_t* A; const bf16_t* Bt; int M, N, K; };

struct StaticOrder {
    int nM, nN, nwg, G, c;
    __host__ __device__ __forceinline__ void init(int M, int N, int G_, int c_) { nM = M / BM; nN = N / BM; nwg = nM * nN; G = G_; c = c_; }
    __host__ __device__ __forceinline__ bool next(int i, Unit& u) const {
        const long L = (long)i * G + c; if (L >= nwg) return false;
        int wgid = (int)L; { const int q = nwg / NXCD, r = nwg % NXCD, xcd = wgid % NXCD, off = wgid / NXCD; wgid = (xcd < r ? xcd * (q + 1) : r * (q + 1) + (xcd - r) * q) + off; }
        const int nig = WGM * nN, gid = wgid / nig, fm = gid * WGM, gsz = (nM - fm) < WGM ? (nM - fm) : WGM;
        u.pm = fm + ((wgid % nig) % gsz); u.pn = (wgid % nig) / gsz; u.ord = i; return true;
    }
    __device__ __forceinline__ void a_ready(const Unit&) const {}
    __device__ __forceinline__ void done(const Unit&) const {}
};

struct OneUnit { int pm, pn;
    __device__ __forceinline__ bool next(int i, Unit& u) const { if (i) return false; u.pm = pm; u.pn = pn; u.ord = 0; return true; }
    __device__ __forceinline__ void a_ready(const Unit&) const {}
    __device__ __forceinline__ void done(const Unit&) const {} };
__device__ __forceinline__ unsigned cvt_pk_bf16(float lo, float hi) { unsigned r; asm volatile("v_cvt_pk_bf16_f32 %0, %1, %2" : "=v"(r) : "v"(lo), "v"(hi)); return r; }
typedef float f32x2 __attribute__((ext_vector_type(2)));
typedef unsigned u32x2 __attribute__((ext_vector_type(2)));
typedef __bf16 bf16x2v __attribute__((ext_vector_type(2)));
__device__ __forceinline__ unsigned pkb(float lo, float hi) { const f32x2 v = {lo, hi}; const bf16x2v b = __builtin_convertvector(v, bf16x2v); return __builtin_bit_cast(unsigned, b); }
__device__ __forceinline__ float silu_f(float x) { return x * __builtin_amdgcn_rcpf(1.0f + __builtin_amdgcn_exp2f(-1.4426950408889634f * x)); }
__device__ __forceinline__ float row_rstd(const float* ssq, int row) { const f32x4 s = *(const f32x4*)(ssq + (size_t)row * 4); return __builtin_amdgcn_rsqf(((s[0] + s[1]) + (s[2] + s[3])) * (1.0f / 1024.0f) + RMS_EPS); }
struct EpiGU {
    static constexpr bool PERM = true, AFTER_DRAIN = false;
    bf16_t* act; const PG8_LAS float* rstab;
    __device__ __forceinline__ void operator()(const f32x4 (&acc)[2][2][4][2], const Unit& u, int wr, int wc, int fr, int fq) const {
        const int row0 = u.pm * BM + wr * 64 + fr, col0 = u.pn * HALF + wc * 32 + 8 * fq; const PG8_LAS float* T = rstab + u.ord * 256 + wr * 64 + fr;
#pragma unroll
        for (int ai = 0; ai < 2; ++ai)
#pragma unroll
            for (int m = 0; m < 4; ++m) { const int row = row0 + ai * HALF + m * 16; const float rs = T[ai * HALF + m * 16];
                const f32x4 g0 = acc[ai][0][m][0] * rs, g1 = acc[ai][0][m][1] * rs, u0 = acc[ai][1][m][0] * rs, u1 = acc[ai][1][m][1] * rs;
                u32x4 w; w.x = pkb(silu_f(g0[0]) * u0[0], silu_f(g0[1]) * u0[1]); w.y = pkb(silu_f(g0[2]) * u0[2], silu_f(g0[3]) * u0[3]);
                w.z = pkb(silu_f(g1[0]) * u1[0], silu_f(g1[1]) * u1[1]); w.w = pkb(silu_f(g1[2]) * u1[2], silu_f(g1[3]) * u1[3]);
                *(u32x4*)(act + (size_t)row * FF + col0) = w; }
    }
};
typedef int i32x4e __attribute__((ext_vector_type(4)));
__device__ __forceinline__ f32x4 cvt_i4(const f32x4 a) { const i32x4e v = __builtin_bit_cast(i32x4e, a); return __builtin_convertvector(v, f32x4); }
struct EpiGU8 {
    static constexpr bool PERM = true, AFTER_DRAIN = false;
    bf16_t* act; const PG8_LAS float* rstab; const PG8_LAS float* ctab;
    __device__ __forceinline__ void operator()(const f32x4 (&acc)[2][2][4][2], const Unit& u, int wr, int wc, int fr, int fq) const {
        const int row0 = u.pm * BM + wr * 64 + fr, col0 = u.pn * HALF + wc * 32 + 8 * fq; const PG8_LAS float* T = rstab + u.ord * 256 + wr * 64 + fr;
        const PG8_LAS float* C = ctab + u.ord * 256 + wc * 32 + 8 * fq;
        const f32x4 sg0 = *(const PG8_LAS f32x4*)C, sg1 = *(const PG8_LAS f32x4*)(C + 4), su0 = *(const PG8_LAS f32x4*)(C + HALF), su1 = *(const PG8_LAS f32x4*)(C + HALF + 4);
#pragma unroll
        for (int ai = 0; ai < 2; ++ai)
#pragma unroll
            for (int m = 0; m < 4; ++m) { const int row = row0 + ai * HALF + m * 16; const float rs = T[ai * HALF + m * 16];
                const f32x4 g0 = cvt_i4(acc[ai][0][m][0]) * (sg0 * rs), g1 = cvt_i4(acc[ai][0][m][1]) * (sg1 * rs), u0 = cvt_i4(acc[ai][1][m][0]) * (su0 * rs), u1 = cvt_i4(acc[ai][1][m][1]) * (su1 * rs);
                u32x4 w; w.x = pkb(silu_f(g0[0]) * u0[0], silu_f(g0[1]) * u0[1]); w.y = pkb(silu_f(g0[2]) * u0[2], silu_f(g0[3]) * u0[3]);
                w.z = pkb(silu_f(g1[0]) * u1[0], silu_f(g1[1]) * u1[1]); w.w = pkb(silu_f(g1[2]) * u1[2], silu_f(g1[3]) * u1[3]);
                *(u32x4*)(act + (size_t)row * FF + col0) = w; }
    }
};
struct EpiWin {
    static constexpr bool PERM = true, AFTER_DRAIN = false;
    bf16_t* z; const PG8_LAS float* rstab; const float* RT; const float* MT;
    __device__ __forceinline__ void operator()(const f32x4 (&acc)[2][2][4][2], const Unit& u, int wr, int wc, int fr, int fq) const {
        const int row0 = u.pm * BM + wr * 64 + fr; const PG8_LAS float* T = rstab + u.ord * 256 + wr * 64 + fr;
        const int hc = (wc * 32 + 8 * fq) & 63;
        const bool rot_tile = u.pn < 6, use = (u.pn < 3) || (hc < 16);
        const float* tbase = (u.pn < 3) ? RT + hc : MT + (hc & 8); const int tpitch = (u.pn < 3) ? 64 : 16;
#pragma unroll
        for (int ai = 0; ai < 2; ++ai) {
            f32x4 t0[4], t1[4];
#pragma unroll
            for (int m = 0; m < 4; ++m) { t0[m] = (f32x4){1.f, 0.f, 1.f, 0.f}; t1[m] = t0[m]; }
            if (rot_tile) {
#pragma unroll
                for (int m = 0; m < 4; ++m) { const float* tb = tbase + (size_t)(row0 + ai * HALF + m * 16) * tpitch; t0[m] = *(const f32x4*)tb; t1[m] = *(const f32x4*)(tb + 4); }
#pragma unroll
                for (int m = 0; m < 4; ++m) { asm volatile("" : "+v"(t0[m]), "+v"(t1[m]));
                    t0[m] = use ? t0[m] : (f32x4){1.f, 0.f, 1.f, 0.f}; t1[m] = use ? t1[m] : (f32x4){1.f, 0.f, 1.f, 0.f}; } }
#pragma unroll
            for (int m = 0; m < 4; ++m) { const int row = row0 + ai * HALF + m * 16; const float rs = T[ai * HALF + m * 16];
#pragma unroll
                for (int bj = 0; bj < 2; ++bj) { const int colb = (2 * u.pn + bj) * HALF + wc * 32 + 8 * fq;
                    const f32x4 a = acc[ai][bj][m][0] * rs, b = acc[ai][bj][m][1] * rs; const f32x4 c0 = t0[m], c1 = t1[m]; f32x4 v0, v1;
                    v0[0] = a[0] * c0[0] - a[1] * c0[1]; v0[1] = a[1] * c0[0] + a[0] * c0[1]; v0[2] = a[2] * c0[2] - a[3] * c0[3]; v0[3] = a[3] * c0[2] + a[2] * c0[3];
                    v1[0] = b[0] * c1[0] - b[1] * c1[1]; v1[1] = b[1] * c1[0] + b[0] * c1[1]; v1[2] = b[2] * c1[2] - b[3] * c1[3]; v1[3] = b[3] * c1[2] + b[2] * c1[3];
                    u32x4 w; w.x = pkb(v0[0], v0[1]); w.y = pkb(v0[2], v0[3]); w.z = pkb(v1[0], v1[1]); w.w = pkb(v1[2], v1[3]);
                    *(u32x4*)(z + (size_t)row * ZP + colb) = w; } } }
    }
};
struct EpiWin8 {
    static constexpr bool PERM = true, AFTER_DRAIN = false;
    bf16_t* z; const PG8_LAS float* rstab; const float* RT; const float* MT; const PG8_LAS float* ctab;
    __device__ __forceinline__ void operator()(const f32x4 (&acc)[2][2][4][2], const Unit& u, int wr, int wc, int fr, int fq) const {
        const int row0 = u.pm * BM + wr * 64 + fr; const PG8_LAS float* T = rstab + u.ord * 256 + wr * 64 + fr;
        const int hc = (wc * 32 + 8 * fq) & 63;
        const bool rot_tile = u.pn < 6, use = (u.pn < 3) || (hc < 16);
        const float* tbase = (u.pn < 3) ? RT + hc : MT + (hc & 8); const int tpitch = (u.pn < 3) ? 64 : 16;
#pragma unroll
        for (int ai = 0; ai < 2; ++ai) {
            f32x4 t0[4], t1[4];
#pragma unroll
            for (int m = 0; m < 4; ++m) { t0[m] = (f32x4){1.f, 0.f, 1.f, 0.f}; t1[m] = t0[m]; }
            if (rot_tile) {
#pragma unroll
                for (int m = 0; m < 4; ++m) { const float* tb = tbase + (size_t)(row0 + ai * HALF + m * 16) * tpitch; t0[m] = *(const f32x4*)tb; t1[m] = *(const f32x4*)(tb + 4); }
#pragma unroll
                for (int m = 0; m < 4; ++m) { asm volatile("" : "+v"(t0[m]), "+v"(t1[m]));
                    t0[m] = use ? t0[m] : (f32x4){1.f, 0.f, 1.f, 0.f}; t1[m] = use ? t1[m] : (f32x4){1.f, 0.f, 1.f, 0.f}; } }
#pragma unroll
            for (int m = 0; m < 4; ++m) { const int row = row0 + ai * HALF + m * 16; const float rs = T[ai * HALF + m * 16];
#pragma unroll
                for (int bj = 0; bj < 2; ++bj) { const int colb = (2 * u.pn + bj) * HALF + wc * 32 + 8 * fq; const PG8_LAS float* C = ctab + u.ord * 256 + bj * HALF + wc * 32 + 8 * fq;
                    const f32x4 a = cvt_i4(acc[ai][bj][m][0]) * (*(const PG8_LAS f32x4*)C * rs), b = cvt_i4(acc[ai][bj][m][1]) * (*(const PG8_LAS f32x4*)(C + 4) * rs); const f32x4 c0 = t0[m], c1 = t1[m]; f32x4 v0, v1;
                    v0[0] = a[0] * c0[0] - a[1] * c0[1]; v0[1] = a[1] * c0[0] + a[0] * c0[1]; v0[2] = a[2] * c0[2] - a[3] * c0[3]; v0[3] = a[3] * c0[2] + a[2] * c0[3];
                    v1[0] = b[0] * c1[0] - b[1] * c1[1]; v1[1] = b[1] * c1[0] + b[0] * c1[1]; v1[2] = b[2] * c1[2] - b[3] * c1[3]; v1[3] = b[3] * c1[2] + b[2] * c1[3];
                    u32x4 w; w.x = pkb(v0[0], v0[1]); w.y = pkb(v0[2], v0[3]); w.z = pkb(v1[0], v1[1]); w.w = pkb(v1[2], v1[3]);
                    *(u32x4*)(z + (size_t)row * ZP + colb) = w; } } }
    }
};
__device__ __forceinline__ unsigned q8x4(float a, float b, float c, float d, float inv) {
    const float M_ = 12582912.0f; const unsigned ya = __float_as_uint(__builtin_fmaf(a, inv, M_)), yb = __float_as_uint(__builtin_fmaf(b, inv, M_)), yc = __float_as_uint(__builtin_fmaf(c, inv, M_)), yd = __float_as_uint(__builtin_fmaf(d, inv, M_));
    return __builtin_amdgcn_perm(yb, ya, 0x0c0c0400u) | __builtin_amdgcn_perm(yd, yc, 0x04000c0cu);
}
struct EpiRes {
    static constexpr bool PERM = true, AFTER_DRAIN = true;
    bf16_t* xb; float* ssq; float alpha, ralpha;
    signed char* x8; float* rf; float* ex; unsigned* pctr; unsigned* tmo; float* fout; const float* fgain;
    __device__ __forceinline__ void init(f32x4 (&acc)[2][2][4][2], const Unit& u, int wr, int wc, int fr, int fq) const {
        const int col0 = u.pn * BM + wc * 32 + 8 * fq;
#pragma unroll
        for (int ai = 0; ai < 2; ++ai)
#pragma unroll
            for (int m = 0; m < 4; ++m)
#pragma unroll
                for (int bj = 0; bj < 2; ++bj) { const u32x4 x4 = *(const u32x4*)(xb + (size_t)(u.pm * BM + ai * HALF + wr * 64 + m * 16 + fr) * DM + col0 + bj * HALF);
                    acc[ai][bj][m][0] = (f32x4){__uint_as_float(x4.x << 16), __uint_as_float(x4.x & 0xffff0000u), __uint_as_float(x4.y << 16), __uint_as_float(x4.y & 0xffff0000u)} * ralpha;
                    acc[ai][bj][m][1] = (f32x4){__uint_as_float(x4.z << 16), __uint_as_float(x4.z & 0xffff0000u), __uint_as_float(x4.w << 16), __uint_as_float(x4.w & 0xffff0000u)} * ralpha; }
    }
    __device__ __forceinline__ void fused(f32x4 (&acc)[2][2][4][2], const Unit& u, int wr, int wc, int fr, int fq, PG8_LAS unsigned char* lds, int wid, int lane) const {
        PG8_LAS float* P = (PG8_LAS float*)lds;
        PG8_LAS float* Q = P + 1024; PG8_LAS float* IV = P + 2048;
        const bool fin = fout != nullptr, q8 = x8 != nullptr || fin; unsigned* const pc = pctr + 16 * u.pm;
        const int col0 = u.pn * BM + wc * 32 + 8 * fq;
#pragma unroll
        for (int ai = 0; ai < 2; ++ai)
#pragma unroll
            for (int m = 0; m < 4; ++m) { const int r = ai * HALF + wr * 64 + m * 16 + fr; bf16_t* xp = xb + (size_t)(u.pm * BM + r) * DM + col0; float ss = 0.f, am = 0.f;
#pragma unroll
                for (int bj = 0; bj < 2; ++bj) { const f32x4 a0 = acc[ai][bj][m][0] * alpha, a1 = acc[ai][bj][m][1] * alpha;
                    ss += ((a0[0] * a0[0] + a0[1] * a0[1]) + (a0[2] * a0[2] + a0[3] * a0[3])) + ((a1[0] * a1[0] + a1[1] * a1[1]) + (a1[2] * a1[2] + a1[3] * a1[3]));
                    am = fmaxf(am, fmaxf(fmaxf(fmaxf(fabsf(a0[0]), fabsf(a0[1])), fmaxf(fabsf(a0[2]), fabsf(a0[3]))), fmaxf(fmaxf(fabsf(a1[0]), fabsf(a1[1])), fmaxf(fabsf(a1[2]), fabsf(a1[3])))));
                    u32x4 w; w.x = pkb(a0[0], a0[1]); w.y = pkb(a0[2], a0[3]); w.z = pkb(a1[0], a1[1]); w.w = pkb(a1[2], a1[3]); if (!fin) *(u32x4*)(xp + bj * HALF) = w; }
                ss += __shfl_xor(ss, 16); ss += __shfl_xor(ss, 32); am = fmaxf(am, __shfl_xor(am, 16)); am = fmaxf(am, __shfl_xor(am, 32));
                if (fq == 0) { P[r * 4 + wc] = ss; Q[r * 4 + wc] = am; } }
        __syncthreads();
        const int tid = wid * 64 + lane;
        if (tid < 256) { const f32x4 p = *(const PG8_LAS f32x4*)(P + tid * 4); const float ts = (p[0] + p[1]) + (p[2] + p[3]); ssq[(size_t)(u.pm * BM + tid) * 4 + u.pn] = ts;
            if (q8) { const f32x4 q = *(const PG8_LAS f32x4*)(Q + tid * 4); float* e = ex + ((size_t)(u.pm * BM + tid) * 4 + u.pn) * 2;
                __hip_atomic_store(e, ts, __ATOMIC_RELAXED, __HIP_MEMORY_SCOPE_AGENT); __hip_atomic_store(e + 1, fmaxf(fmaxf(q[0], q[1]), fmaxf(q[2], q[3])), __ATOMIC_RELAXED, __HIP_MEMORY_SCOPE_AGENT); } }
        if (q8) {
            if (wid < 4) { asm volatile("s_waitcnt vmcnt(0)" ::: "memory"); if (lane == 0) __hip_atomic_fetch_add(pc, 1u, __ATOMIC_RELAXED, __HIP_MEMORY_SCOPE_AGENT); }
            if (tid == 0) { unsigned sp = 0u; while (__hip_atomic_load(pc, __ATOMIC_RELAXED, __HIP_MEMORY_SCOPE_AGENT) < 16u) { __builtin_amdgcn_s_sleep(1); if (++sp > (1u << 22)) { __hip_atomic_store(tmo, 1u, __ATOMIC_RELAXED, __HIP_MEMORY_SCOPE_AGENT); break; } } }
            __syncthreads();
            if (tid < 256) { const float* e = ex + (size_t)(u.pm * BM + tid) * 8; float s4 = 0.f, a4 = 0.f;
#pragma unroll
                for (int k = 0; k < 4; ++k) { s4 += __hip_atomic_load(e + 2 * k, __ATOMIC_RELAXED, __HIP_MEMORY_SCOPE_AGENT); a4 = fmaxf(a4, __hip_atomic_load(e + 2 * k + 1, __ATOMIC_RELAXED, __HIP_MEMORY_SCOPE_AGENT)); }
                IV[tid] = fin ? __builtin_amdgcn_rsqf(s4 * (1.0f / 1024.0f) + RMS_EPS) : (a4 > 0.f ? 127.0f / a4 : 0.f);
                if (u.pn == 0 && !fin) rf[u.pm * BM + tid] = __builtin_amdgcn_rsqf(s4 * (1.0f / 1024.0f) + RMS_EPS) * a4 * (1.0f / 127.0f); }
            __syncthreads();
            if (fin) {
                f32x4 gn[2][2];
#pragma unroll
                for (int bj = 0; bj < 2; ++bj) { gn[bj][0] = *(const f32x4*)(fgain + col0 + bj * HALF); gn[bj][1] = *(const f32x4*)(fgain + col0 + bj * HALF + 4); }
#pragma unroll
                for (int ai = 0; ai < 2; ++ai)
#pragma unroll
                    for (int m = 0; m < 4; ++m) { const int r = ai * HALF + wr * 64 + m * 16 + fr; const float rs = IV[r] * alpha; float* op = fout + (size_t)(u.pm * BM + r) * DM + col0;
#pragma unroll
                        for (int bj = 0; bj < 2; ++bj) { *(f32x4*)(op + bj * HALF) = acc[ai][bj][m][0] * rs * gn[bj][0]; *(f32x4*)(op + bj * HALF + 4) = acc[ai][bj][m][1] * rs * gn[bj][1]; } }
                return; }
#pragma unroll
            for (int ai = 0; ai < 2; ++ai)
#pragma unroll
                for (int m = 0; m < 4; ++m) { const int r = ai * HALF + wr * 64 + m * 16 + fr; const float inv = IV[r] * alpha; signed char* qp = x8 + (size_t)(u.pm * BM + r) * DM + col0;
#pragma unroll
                    for (int bj = 0; bj < 2; ++bj) { const f32x4 a0 = acc[ai][bj][m][0], a1 = acc[ai][bj][m][1]; u32x2 w; w.x = q8x4(a0[0], a0[1], a0[2], a0[3], inv); w.y = q8x4(a1[0], a1[1], a1[2], a1[3], inv); *(u32x2*)(qp + bj * HALF) = w; } }
        }
    }
};

typedef int i32x4 __attribute__((ext_vector_type(4)));
template <bool I8> __device__ __forceinline__ f32x4 mma16(const bf16x8 a, const bf16x8 b, const f32x4 c) {
    if constexpr (I8) return __builtin_bit_cast(f32x4, __builtin_amdgcn_mfma_i32_16x16x64_i8(__builtin_bit_cast(i32x4, a), __builtin_bit_cast(i32x4, b), __builtin_bit_cast(i32x4, c), 0, 0, 0));
    else return __builtin_amdgcn_mfma_f32_16x16x32_bf16(a, b, c, 0, 0, 0);
}
template <class Epi, class Sched, bool ALIGN_EPI = false, bool SP2 = false, bool I8 = false>
__device__ __forceinline__ void gemm_phase(PG8_LAS unsigned char* lds, const Gemm g, const Sched& S, const Epi& E, const int tid) {
    const int wid = __builtin_amdgcn_readfirstlane(tid >> 6), lane = tid & 63, wr = wid >> 2, wc = wid & 3, fr = lane & 15, fq = lane >> 4;
    const int K = g.K, nt = K / BK;
    unsigned voffA[2], voffB[2];
#pragma unroll
    for (int i = 0; i < 2; ++i) { int R, C; stage_rc(tid * 16 + i * 8192, R, C); const int Rb = Epi::PERM ? ((R & ~31) + perm32(R & 31)) : R;
        voffA[i] = (unsigned)(R * K + C) * 2u; voffB[i] = (unsigned)(Rb * K + C) * 2u; }
    const size_t kstep = (size_t)(BK * 2);
    const size_t hstep = (size_t)HALF * K * 2;
    const size_t tstep = 2 * hstep;
    const unsigned ldsw = (unsigned)wid * 1024u;
    const int aoff = lds_byte(wr * 64 + fr, fq * 8), boff = lds_byte(wc * 32 + fr, fq * 8);
#define PG8_SA(b, h) (((b) * 2 + (h)) * HTB)
#define PG8_SB(b, h) ((4 + (b) * 2 + (h)) * HTB)
#define PG8_STAGE(bufoff, gbase, voff) do { const char* gb_ = (const char*)(gbase); asm volatile("" : "+s"(gb_));     \
        _Pragma("unroll") for (int _i = 0; _i < 2; ++_i) { unsigned vo_ = (voff)[_i]; asm volatile("" : "+v"(vo_)); \
        __builtin_amdgcn_global_load_lds((const unsigned*)(gb_ + vo_), (PG8_LAS unsigned*)(lds + (bufoff) + ldsw + _i * 8192), 16, 0, 0); } } while (0)
#define PG8_LDA(dst, b, h) do { _Pragma("unroll") for (int m = 0; m < 4; ++m) _Pragma("unroll") for (int k = 0; k < 2; ++k) dst[m][k] = *(const PG8_LAS bf16x8*)(lds + PG8_SA(b, h) + aoff + m * 2048 + k * 1024); } while (0)
#define PG8_LDB(dst, b, h) do { _Pragma("unroll") for (int n = 0; n < 2; ++n) _Pragma("unroll") for (int k = 0; k < 2; ++k) dst[n][k] = *(const PG8_LAS bf16x8*)(lds + PG8_SB(b, h) + boff + n * 2048 + k * 1024); } while (0)
#define PG8_MMA(ai, bj, At, Bt) do { __builtin_amdgcn_s_setprio(1); _Pragma("unroll") for (int m = 0; m < 4; ++m) _Pragma("unroll") for (int n = 0; n < 2; ++n) _Pragma("unroll") for (int k = 0; k < 2; ++k) \
        acc[ai][bj][m][n] = mma16<I8>(Bt[n][k], At[m][k], acc[ai][bj][m][n]); __builtin_amdgcn_s_setprio(0); } while (0)
#define PG8_WAIT_V(n) asm volatile("s_waitcnt vmcnt(" #n ")" ::: "memory")
#define PG8_WAIT_L(n) asm volatile("s_waitcnt lgkmcnt(" #n ")" ::: "memory")
#define PG8_BAR __builtin_amdgcn_s_barrier()
#define PG8_SCHED __builtin_amdgcn_sched_barrier(0)
    Unit cur, nxt; int ui = 0;
    if (!S.next(0, cur)) return;
    f32x4 acc[2][2][4][2];
    if constexpr (Epi::AFTER_DRAIN) E.init(acc, cur, wr, wc, fr, fq);
    else {
#pragma unroll
    for (int a = 0; a < 2; ++a)
#pragma unroll
        for (int b = 0; b < 2; ++b)
#pragma unroll
            for (int m = 0; m < 4; ++m)
#pragma unroll
                for (int n = 0; n < 2; ++n) acc[a][b][m][n] = (f32x4){0.f, 0.f, 0.f, 0.f};
    }
    bf16x8 At[4][2], B0[2][2], B1[2][2];
    const char* cA = (const char*)g.A + (size_t)cur.pm * tstep; const char* cB = (const char*)g.Bt + (size_t)cur.pn * tstep;
    S.a_ready(cur);
    if constexpr (SP2) {
        PG8_STAGE(PG8_SB(0, 0), cB, voffB); PG8_STAGE(PG8_SB(0, 1), cB + hstep, voffB); PG8_STAGE(PG8_SA(0, 0), cA, voffA); PG8_STAGE(PG8_SA(0, 1), cA + hstep, voffA);
        if (wr == 1) PG8_BAR;
        PG8_WAIT_V(2); PG8_BAR;
        PG8_STAGE(PG8_SB(1, 0), cB + kstep, voffB); PG8_STAGE(PG8_SA(1, 0), cA + kstep, voffA); PG8_STAGE(PG8_SB(1, 1), cB + hstep + kstep, voffB);
        PG8_WAIT_V(6); PG8_BAR;
    } else {
        PG8_STAGE(PG8_SB(0, 0), cB, voffB); PG8_STAGE(PG8_SA(0, 0), cA, voffA); PG8_STAGE(PG8_SB(0, 1), cB + hstep, voffB); PG8_STAGE(PG8_SA(0, 1), cA + hstep, voffA);
        if (wr == 1) PG8_BAR;
        PG8_WAIT_V(4); PG8_BAR;
        PG8_STAGE(PG8_SB(1, 0), cB + kstep, voffB); PG8_STAGE(PG8_SA(1, 0), cA + kstep, voffA); PG8_STAGE(PG8_SB(1, 1), cB + hstep + kstep, voffB);
        PG8_WAIT_V(6); PG8_BAR;
    }
    for (;;) {
        const bool has_next = S.next(ui + 1, nxt);
        const char* nA = has_next ? (const char*)g.A + (size_t)nxt.pm * tstep : cA; const char* nB = has_next ? (const char*)g.Bt + (size_t)nxt.pn * tstep : cB;
        for (int t = 0; t < nt; t += 2) {
            const bool last = (t == nt - 2);
            const char* a1 = cA + (size_t)(t + 1) * kstep;
            const char* a2 = last ? nA : cA + (size_t)(t + 2) * kstep; const char* b2 = last ? nB : cB + (size_t)(t + 2) * kstep;
            const char* a3 = a2 + kstep; const char* b3 = b2 + kstep;
            if (last && has_next) S.a_ready(nxt);
            if constexpr (SP2) {
            PG8_LDB(B0, 0, 0); PG8_LDB(B1, 0, 1); PG8_SCHED; PG8_LDA(At, 0, 0); PG8_STAGE(PG8_SA(1, 1), a1 + hstep, voffA);
            PG8_WAIT_V(8); PG8_WAIT_L(0); PG8_BAR; PG8_MMA(0, 0, At, B0); PG8_MMA(0, 1, At, B1); PG8_BAR; PG8_SCHED;
            PG8_LDA(At, 0, 1); PG8_STAGE(PG8_SB(0, 0), b2, voffB); PG8_STAGE(PG8_SB(0, 1), b2 + hstep, voffB); PG8_STAGE(PG8_SA(0, 0), a2, voffA);
            PG8_WAIT_V(8); PG8_WAIT_L(0); PG8_BAR; PG8_MMA(1, 0, At, B0); PG8_MMA(1, 1, At, B1); PG8_BAR; PG8_SCHED;
            PG8_LDB(B0, 1, 0); PG8_LDB(B1, 1, 1); PG8_SCHED; PG8_LDA(At, 1, 0); PG8_STAGE(PG8_SA(0, 1), a2 + hstep, voffA);
            PG8_WAIT_V(8); PG8_WAIT_L(0); PG8_BAR; PG8_MMA(0, 0, At, B0); PG8_MMA(0, 1, At, B1); PG8_BAR; PG8_SCHED;
            PG8_LDA(At, 1, 1); PG8_STAGE(PG8_SB(1, 0), b3, voffB); PG8_STAGE(PG8_SB(1, 1), b3 + hstep, voffB); PG8_STAGE(PG8_SA(1, 0), a3, voffA);
            PG8_WAIT_V(8); PG8_WAIT_L(0); PG8_BAR; PG8_MMA(1, 0, At, B0); PG8_MMA(1, 1, At, B1); PG8_BAR; PG8_SCHED;
            } else {
            PG8_LDB(B0, 0, 0); PG8_SCHED; PG8_LDA(At, 0, 0); PG8_STAGE(PG8_SA(1, 1), a1 + hstep, voffA);
            PG8_WAIT_L(8); PG8_BAR; PG8_WAIT_L(0); PG8_MMA(0, 0, At, B0); PG8_BAR; PG8_SCHED;
            PG8_LDB(B1, 0, 1); PG8_STAGE(PG8_SB(0, 0), b2, voffB);
            PG8_BAR; PG8_WAIT_L(0); PG8_MMA(0, 1, At, B1); PG8_BAR;
            PG8_LDA(At, 0, 1); PG8_STAGE(PG8_SA(0, 0), a2, voffA);
            PG8_BAR; PG8_WAIT_L(0); PG8_MMA(1, 0, At, B0); PG8_BAR; PG8_SCHED;
            PG8_STAGE(PG8_SB(0, 1), b2 + hstep, voffB);
            PG8_WAIT_V(6); PG8_BAR; PG8_MMA(1, 1, At, B1); PG8_BAR;
            PG8_LDB(B0, 1, 0); PG8_SCHED; PG8_LDA(At, 1, 0); PG8_STAGE(PG8_SA(0, 1), a2 + hstep, voffA);
            PG8_WAIT_L(8); PG8_BAR; PG8_WAIT_L(0); PG8_MMA(0, 0, At, B0); PG8_BAR; PG8_SCHED;
            PG8_LDB(B1, 1, 1); PG8_STAGE(PG8_SB(1, 0), b3, voffB);
            PG8_BAR; PG8_WAIT_L(0); PG8_MMA(0, 1, At, B1); PG8_BAR;
            PG8_LDA(At, 1, 1); PG8_STAGE(PG8_SA(1, 0), a3, voffA);
            PG8_BAR; PG8_WAIT_L(0); PG8_MMA(1, 0, At, B0); PG8_BAR; PG8_SCHED;
            PG8_STAGE(PG8_SB(1, 1), b3 + hstep, voffB);
            PG8_WAIT_V(6); PG8_BAR; PG8_MMA(1, 1, At, B1); PG8_BAR;
            }
        }
        if constexpr (ALIGN_EPI) { if (wr == 0) PG8_BAR; }
        if constexpr (!Epi::AFTER_DRAIN) { E(acc, cur, wr, wc, fr, fq); S.done(cur); }
        if (!has_next) break;
#pragma unroll
        for (int a = 0; a < 2; ++a)
#pragma unroll
            for (int b = 0; b < 2; ++b)
#pragma unroll
                for (int m = 0; m < 4; ++m)
#pragma unroll
                    for (int n = 0; n < 2; ++n) acc[a][b][m][n] = (f32x4){0.f, 0.f, 0.f, 0.f};
        cur = nxt; cA = nA; cB = nB; ++ui;
        if constexpr (ALIGN_EPI) { if (wr == 1) PG8_BAR; }
    }
    PG8_WAIT_V(0);
    if constexpr (!ALIGN_EPI) { if (wr == 0) PG8_BAR; }
    PG8_BAR;
    if constexpr (Epi::AFTER_DRAIN) { E.fused(acc, cur, wr, wc, fr, fq, lds, wid, lane); S.done(cur); }
#undef PG8_SA
#undef PG8_SB
#undef PG8_STAGE
#undef PG8_LDA
#undef PG8_LDB
#undef PG8_MMA
#undef PG8_WAIT_V
#undef PG8_WAIT_L
#undef PG8_BAR
#undef PG8_SCHED
}
}
constexpr size_t KiB = 1024, MiB = 1u << 20;
constexpr size_t WS_CTL = 0, CTL_BYTES = 1 * MiB;
constexpr size_t WS_W = 1 * MiB, WBUF_BYTES = 42 * MiB;
constexpr size_t WO_GU1 = 0, WO_D1 = 11 * MiB, WO_IN = 16896 * KiB, WO_OUT = 23 * MiB, WO_GU2 = 25 * MiB, WO_D2 = 36 * MiB;
constexpr size_t WS_XB = 85 * MiB;
constexpr size_t WS_Z = 117 * MiB;
constexpr size_t WS_MIX = 221 * MiB;
constexpr size_t WS_ACT = 253 * MiB;
constexpr size_t WS_OP = 253 * MiB;
constexpr size_t WS_LSE = 301 * MiB;
constexpr size_t WS_SEL = 303 * MiB;
constexpr size_t WS_KV = 304 * MiB;
constexpr size_t WS_PREV = 310 * MiB;
constexpr size_t WS_KM = 313 * MiB;
constexpr size_t WS_RT = 341 * MiB, WS_MT = 345 * MiB;
constexpr size_t WS_SSQ = 346 * MiB;
constexpr size_t WS_X8 = 347 * MiB;
constexpr size_t WS_RF = 363 * MiB;
constexpr size_t WS_EX = WS_RF + 512 * KiB;
constexpr size_t WS_END = 364 * MiB;
constexpr size_t WO_IN8 = 7 * MiB, WO_SWIN = 10752 * KiB;
constexpr size_t WO_SW = 6 * MiB;
static_assert(WS_KM + 1 * MiB <= WS_ACT + 88 * MiB && WS_ACT + 88 * MiB <= WS_RT, "d_ws map");
constexpr int CW_TMO = 8, CW_XT = 1024  , CW_LB = 2048  , CW_BAR = 4096, CW_Q = 16384, CW_HC = 32768, CW_PC = 65536  ;

constexpr int RING_BYTES = 131072, LDSCTL_OFF = RING_BYTES, MISC_OFF = LDSCTL_OFF + 320, LDS_BYTES = 147456;

#define LAS __attribute__((address_space(3)))
#define GAS __attribute__((address_space(1)))
typedef unsigned short bf16;
typedef unsigned u32x4 __attribute__((ext_vector_type(4)));
typedef unsigned u32x2 __attribute__((ext_vector_type(2)));
typedef float f32x4 __attribute__((ext_vector_type(4)));
typedef float f32x2 __attribute__((ext_vector_type(2)));
typedef float f32x16 __attribute__((ext_vector_type(16)));
typedef short bf16x8 __attribute__((ext_vector_type(8)));
typedef short s16x4 __attribute__((ext_vector_type(4)));
typedef short v4i16_t __attribute__((ext_vector_type(4)));
typedef __bf16 bf16x2_t __attribute__((ext_vector_type(2)));
#define LDS_WAIT() asm volatile("s_waitcnt lgkmcnt(0)" ::: "memory")
__device__ __forceinline__ unsigned pk2(float lo, float hi) { const f32x2 v = {lo, hi}; const bf16x2_t b = __builtin_convertvector(v, bf16x2_t); return __builtin_bit_cast(unsigned, b); }
__device__ __forceinline__ float bflo(unsigned w) { return __uint_as_float(w << 16); }
__device__ __forceinline__ float bfhi(unsigned w) { return __uint_as_float(w & 0xffff0000u); }
__device__ __forceinline__ float ex2(float x) { return __builtin_amdgcn_exp2f(x); }
__device__ __forceinline__ float silu1(float x) { return x * __builtin_amdgcn_rcpf(1.0f + ex2(-1.4426950408889634f * x)); }
__device__ __forceinline__ float sigm1(float x) { return __builtin_amdgcn_rcpf(1.0f + ex2(-1.4426950408889634f * x)); }
__device__ __forceinline__ float wave_sum(float v) {
#pragma unroll
    for (int o = 1; o < 64; o <<= 1) v += __shfl_xor(v, o);
    return v;
}
__device__ __forceinline__ f32x16 mfma32(bf16x8 a, bf16x8 b, f32x16 c) { return __builtin_amdgcn_mfma_f32_32x32x16_bf16(a, b, c, 0, 0, 0); }
__device__ __forceinline__ int crow(int i, int h) { return (i & 3) + 8 * (i >> 2) + 4 * h; }
__device__ __forceinline__ s16x4 vtr(LAS const unsigned char* p) { return __builtin_bit_cast(s16x4, __builtin_amdgcn_ds_read_tr16_b64_v4i16((LAS v4i16_t*)p)); }
__device__ __forceinline__ bf16x8 cat8(s16x4 lo, s16x4 hi) { return __builtin_shufflevector(lo, hi, 0, 1, 2, 3, 4, 5, 6, 7); }
__device__ __forceinline__ bf16x8 ldsrow(LAS const unsigned char* p) { return *(const LAS bf16x8*)p; }
__device__ __forceinline__ f32x16 zero16() { f32x16 z;
#pragma unroll
    for (int i = 0; i < 16; ++i) z[i] = 0.f;
    return z; }
__device__ __forceinline__ bf16x8 pack8(const f32x16& x, int s) {
    u32x4 p; p.x = pk2(x[8 * s], x[8 * s + 1]); p.y = pk2(x[8 * s + 2], x[8 * s + 3]); p.z = pk2(x[8 * s + 4], x[8 * s + 5]); p.w = pk2(x[8 * s + 6], x[8 * s + 7]);
    return __builtin_bit_cast(bf16x8, p);
}
constexpr int PIT = 144;
constexpr int IMG = 256 * PIT;
template <int NR> __device__ __forceinline__ void stage64(LAS unsigned char* dst, const bf16* src, int gp, int tid) {
    constexpr int N = (NR * 8 + 511) / 512; u32x4 v[N];
#pragma unroll
    for (int i = 0; i < N; ++i) { const int c = tid + 512 * i, row = c >> 3, ch = c & 7; if (NR * 8 % 512 == 0 || c < NR * 8) v[i] = *(const u32x4*)(src + (size_t)row * gp + ch * 8); }
#pragma unroll
    for (int i = 0; i < N; ++i) { const int c = tid + 512 * i, row = c >> 3, ch = c & 7; if (NR * 8 % 512 == 0 || c < NR * 8) *(LAS u32x4*)(dst + row * PIT + ch * 16) = v[i]; }
}

template <int NI> __device__ __forceinline__ void stage256n(LAS unsigned char* const (&dst)[NI], const bf16* const (&src)[NI], int gp, int tid) {
    u32x4 v[NI][4];
#pragma unroll
    for (int k = 0; k < NI; ++k)
#pragma unroll
        for (int i = 0; i < 4; ++i) { const int c = tid + 512 * i, row = c >> 3, ch = c & 7; v[k][i] = *(const u32x4*)(src[k] + (size_t)row * gp + ch * 8); }
#pragma unroll
    for (int k = 0; k < NI; ++k)
#pragma unroll
        for (int i = 0; i < 4; ++i) { const int c = tid + 512 * i, row = c >> 3, ch = c & 7; *(LAS u32x4*)(dst[k] + row * PIT + ch * 16) = v[k][i]; }
}

__device__ __forceinline__ void sincos_acc(float angf, float& c, float& s) {
    const double a = (double)angf, kq = rint(a * 0.63661977236758134308), r = a - kq * 1.57079632679489661923, r2 = r * r;
    const double sn = r * (1.0 + r2 * (-1.0 / 6.0 + r2 * (1.0 / 120.0 + r2 * (-1.0 / 5040.0 + r2 * (1.0 / 362880.0 + r2 * (-1.0 / 39916800.0))))));
    const double cs = 1.0 + r2 * (-0.5 + r2 * (1.0 / 24.0 + r2 * (-1.0 / 720.0 + r2 * (1.0 / 40320.0 + r2 * (-1.0 / 3628800.0 + r2 * (1.0 / 479001600.0))))));
    const int q = ((int)kq) & 3;
    const double cc = (q == 0) ? cs : (q == 1) ? -sn : (q == 2) ? -cs : sn, ssv = (q == 0) ? sn : (q == 1) ? cs : (q == 2) ? -sn : -cs;
    c = (float)cc; s = (float)ssv;
}
__device__ __forceinline__ int cvt_tgt(int mode, int c, float& sc) {
    sc = 1.f;
    if (mode == 0) return c;
    if (mode == 1) return 256 * (c >> 7) + (c & 127);
    if (mode == 2) return 256 * (c >> 7) + 128 + (c & 127);
    if (c < 768) { const int sec = c >= 384, w = c - 384 * sec, hh = w >> 6, o = w & 63; if (sec) sc = 0.125f; return (sec ? Z_RK : Z_RQ) + hh * 64 + (o < 32 ? 2 * o : 2 * (o - 32) + 1); }
    if (c < 1152) return Z_RV + (c - 768);
    if (c < 1536) return Z_RG + (c - 1152);
    if (c < 2304) { const int sec = c >= 1920, w = c - 1536 - 384 * sec, hh = w >> 6, o = w & 63; if (!sec) sc = C2; return (sec ? Z_MK : Z_MQ) + hh * 64 + (o < 8 ? 2 * o : o < 16 ? 2 * (o - 8) + 1 : o); }
    if (c < 2688) return Z_MV + (c - 2304);
    if (c < 2944) return Z_CA + (c - 2688);
    return Z_CG + (c - 2944);
}
__device__ __forceinline__ void cvt_item(const float* W, const float* gain, bf16* dst, int K, int NS, int mode, int item, LAS float* scr, int lane) {
    const int nblk = NS >> 5, kb = item / nblk, nb = item - kb * nblk, k0 = kb << 6, c0 = nb << 5;
    const int ksub = lane >> 3, n4 = lane & 7;
    f32x4 v[8]; float gv[8];
#pragma unroll
    for (int i = 0; i < 8; ++i) v[i] = *(const f32x4*)(W + (size_t)(k0 + ksub + 8 * i) * NS + c0 + 4 * n4);
#pragma unroll
    for (int i = 0; i < 8; ++i) gv[i] = gain ? gain[k0 + ksub + 8 * i] : 1.f;
    float sc; (void)cvt_tgt(mode, c0, sc);
#pragma unroll
    for (int i = 0; i < 8; ++i) { const float g = gv[i] * sc; LAS float* s = scr + (ksub + 8 * i) * 33 + 4 * n4; s[0] = v[i][0] * g; s[1] = v[i][1] * g; s[2] = v[i][2] * g; s[3] = v[i][3] * g; }
    LDS_WAIT(); asm volatile("" ::: "memory");
    const int c = lane & 7;
#pragma unroll
    for (int j = 0; j < 4; ++j) { const int n = (lane >> 3) + 8 * j; const LAS float* s = scr + (8 * c) * 33 + n; float dummy;
        u32x4 o; o.x = pk2(s[0 * 33], s[1 * 33]); o.y = pk2(s[2 * 33], s[3 * 33]); o.z = pk2(s[4 * 33], s[5 * 33]); o.w = pk2(s[6 * 33], s[7 * 33]);
        *(u32x4*)(dst + (size_t)cvt_tgt(mode, c0 + n, dummy) * K + k0 + 8 * c) = o; }
    LDS_WAIT(); asm volatile("" ::: "memory");
}
__device__ __forceinline__ void cvt_q8_batch(const float* W, const float* gain, signed char* dst, float* SWt, int NS, int mode, int nb, LAS unsigned char* lds, int wave, int lane) {
    LAS float* scr = (LAS float*)(lds + wave * 16384); LAS float* red = (LAS float*)(lds + wave * 16384 + 12288);
    const int c0 = nb << 5, ksub = lane >> 3, n4 = lane & 7;
    f32x4 v[2][8]; float gv[2][8];
#pragma unroll
    for (int h = 0; h < 2; ++h)
#pragma unroll
        for (int i = 0; i < 8; ++i) v[h][i] = *(const f32x4*)(W + (size_t)(64 * (wave + 8 * h) + ksub + 8 * i) * NS + c0 + 4 * n4);
#pragma unroll
    for (int h = 0; h < 2; ++h)
#pragma unroll
        for (int i = 0; i < 8; ++i) gv[h][i] = gain[64 * (wave + 8 * h) + ksub + 8 * i];
    float sc0; (void)cvt_tgt(mode, c0, sc0);
    f32x4 am = {0.f, 0.f, 0.f, 0.f};
#pragma unroll
    for (int h = 0; h < 2; ++h)
#pragma unroll
        for (int i = 0; i < 8; ++i) { v[h][i] = v[h][i] * (gv[h][i] * sc0);
#pragma unroll
            for (int e = 0; e < 4; ++e) am[e] = fmaxf(am[e], fabsf(v[h][i][e])); }
#pragma unroll
    for (int o = 8; o < 64; o <<= 1)
#pragma unroll
        for (int e = 0; e < 4; ++e) am[e] = fmaxf(am[e], __shfl_xor(am[e], o));
    if (lane < 8) *(LAS f32x4*)(red + 4 * n4) = am;
    __syncthreads();
    f32x4 cm = {0.f, 0.f, 0.f, 0.f};
#pragma unroll
    for (int w = 0; w < 8; ++w) { const f32x4 t = *(const LAS f32x4*)(lds + w * 16384 + 12288 + 16 * n4);
#pragma unroll
        for (int e = 0; e < 4; ++e) cm[e] = fmaxf(cm[e], t[e]); }
    f32x4 inv;
#pragma unroll
    for (int e = 0; e < 4; ++e) inv[e] = cm[e] > 0.f ? 127.0f / cm[e] : 0.f;
    float dummy;
#pragma unroll
    for (int h = 0; h < 2; ++h) {
#pragma unroll
        for (int i = 0; i < 8; ++i) { LAS float* s = scr + (ksub + 8 * i) * 33 + 4 * n4;
#pragma unroll
            for (int e = 0; e < 4; ++e) s[e] = __builtin_rintf(v[h][i][e] * inv[e]); }
        LDS_WAIT(); asm volatile("" ::: "memory");
        const int c = lane & 7;
#pragma unroll
        for (int j = 0; j < 4; ++j) { const int n = (lane >> 3) + 8 * j; const LAS float* s = scr + (8 * c) * 33 + n; unsigned q[8];
#pragma unroll
            for (int t = 0; t < 8; ++t) q[t] = (unsigned)(int)s[t * 33] & 0xffu;
            u32x2 o; o.x = q[0] | (q[1] << 8) | (q[2] << 16) | (q[3] << 24); o.y = q[4] | (q[5] << 8) | (q[6] << 16) | (q[7] << 24);
            *(u32x2*)(dst + (size_t)cvt_tgt(mode, c0 + n, dummy) * DM + 64 * (wave + 8 * h) + 8 * c) = o; }
        LDS_WAIT(); asm volatile("" ::: "memory");
    }
    if (wave == 0 && lane < 8) {
#pragma unroll
        for (int e = 0; e < 4; ++e) SWt[cvt_tgt(mode, c0 + 4 * n4 + e, dummy)] = cm[e] * (1.0f / 127.0f); }
}
constexpr int I_D = (FF / 64) * (DM / 32), I_IN = (DM / 64) * (ZN / 32), I_OUT = (DM / 64) * (DM / 32);
constexpr int B_G = FF / 32, B_D = I_D / 8, B_IN = I_IN / 8, B_IN8 = ZN / 32, B_OUT = I_OUT / 8;
static_assert(I_D % 8 == 0 && I_IN % 8 == 0 && I_OUT % 8 == 0, "whole batches");
constexpr int WIN8_FROM = 1;
__host__ __device__ constexpr int b_in(int l) { return l >= WIN8_FROM ? B_IN8 : B_IN; }
constexpr int B_EARLY0 = 2 * B_G + B_D, B_LATE = 2 * B_G + B_D + B_OUT;
__host__ __device__ constexpr int b_early(int l) { return B_EARLY0 + b_in(l); }
__host__ __device__ constexpr int b_layer(int l) { return b_early(l) + B_LATE; }
struct Args { const float* in[18]; float* out; unsigned char* ws; float invf[40]; int ph_lo, ph_hi; };
#define AIN(k) ((const float*)(GAS const float*)A.in[(k) + zi])
__device__ __forceinline__ void cvt_layer_batch(const Args& A, int zi, int l, unsigned char* wb, int bt, LAS unsigned char* lds, int wave, int lane) {
    const size_t lgu = (size_t)l * DM * FF, lw = (size_t)l * DM; LAS float* scr = (LAS float*)(lds + wave * 16384);
    int r = bt;
    if (r < B_G) { cvt_q8_batch(AIN(3) + lgu, AIN(2) + lw, (signed char*)(wb + WO_GU1), (float*)(wb + WO_GU1 + WO_SW), FF, 1, r, lds, wave, lane); return; } r -= B_G;
    if (r < B_G) { cvt_q8_batch(AIN(4) + lgu, AIN(2) + lw, (signed char*)(wb + WO_GU1), (float*)(wb + WO_GU1 + WO_SW), FF, 2, r, lds, wave, lane); return; } r -= B_G;
    if (r < B_D) { cvt_item(AIN(5) + lgu, nullptr, (bf16*)(wb + WO_D1), FF, DM, 0, 8 * r + wave, scr, lane); return; } r -= B_D;
    if (r < b_in(l)) { if (l >= WIN8_FROM) cvt_q8_batch(AIN(7) + (size_t)l * DM * ZN, AIN(6) + lw, (signed char*)(wb + WO_IN8), (float*)(wb + WO_SWIN), ZN, 3, r, lds, wave, lane);
        else cvt_item(AIN(7) + (size_t)l * DM * ZN, AIN(6) + lw, (bf16*)(wb + WO_IN), DM, ZN, 3, 8 * r + wave, scr, lane); return; } r -= b_in(l);
    if (r < B_G) { cvt_q8_batch(AIN(14) + lgu, AIN(13) + lw, (signed char*)(wb + WO_GU2), (float*)(wb + WO_GU2 + WO_SW), FF, 1, r, lds, wave, lane); return; } r -= B_G;
    if (r < B_G) { cvt_q8_batch(AIN(15) + lgu, AIN(13) + lw, (signed char*)(wb + WO_GU2), (float*)(wb + WO_GU2 + WO_SW), FF, 2, r, lds, wave, lane); return; } r -= B_G;
    if (r < B_D) { cvt_item(AIN(16) + lgu, nullptr, (bf16*)(wb + WO_D2), FF, DM, 0, 8 * r + wave, scr, lane); return; } r -= B_D;
    cvt_item(AIN(12) + (size_t)l * DM * DM, nullptr, (bf16*)(wb + WO_OUT), DM, DM, 0, 8 * r + wave, scr, lane);
}
#define XB_TMO      128
#define XB_XCNT(j)  (256  + 64 * (j))
#define XB_XSUB(j)  (1280 + 64 * (j))
#define XB_XGEN(j)  (2304 + 64 * (j))
#define XB_TOP      3328
#define XB_TOPGEN   3392
#define XCD_BAR_WORDS 3456
#define XB_SPIN_CAP (1u << 18)

__device__ __forceinline__ unsigned xb_ld(unsigned* p)              { return __hip_atomic_load(p, __ATOMIC_RELAXED, __HIP_MEMORY_SCOPE_AGENT); }
__device__ __forceinline__ unsigned xb_add(unsigned* p, unsigned v) { return __hip_atomic_fetch_add(p, v, __ATOMIC_RELAXED, __HIP_MEMORY_SCOPE_AGENT); }
__device__ __forceinline__ unsigned xb_xcc_id() { return (unsigned)__builtin_amdgcn_s_getreg((3 << 11) | 20) & 0xFu; }
#define XB_SPIN(cond, bar) do { unsigned _sp = 0; while (cond) { __builtin_amdgcn_s_sleep(1); \
    if ((++_sp & 255u) == 0u) { if (xb_ld(&(bar)[XB_TMO])) break; if (_sp > XB_SPIN_CAP) { atomicAdd(&(bar)[XB_TMO], 1u); break; } } } } while (0)

struct XcdBarrier {
    unsigned* bar; unsigned x;
    volatile LAS unsigned* st;
};

__device__ __forceinline__ XcdBarrier xcd_barrier_post(unsigned* bar, volatile LAS unsigned* st) {
    XcdBarrier b; b.bar = bar; b.x = xb_xcc_id(); b.st = st;
    if (threadIdx.x == 0) (void)xb_add(&bar[XB_XCNT(b.x)], 1u);
    return b;
}
__device__ __forceinline__ void xcd_barrier_complete(unsigned* bar, unsigned x, unsigned& nloc, unsigned& nx) {
    const unsigned G = gridDim.x * gridDim.y * gridDim.z;
    unsigned sum, cnt, mine, sp = 0u;
    for (;;) {
        sum = 0u; cnt = 0u; mine = 0u;
#pragma unroll
        for (unsigned j = 0; j < 16; ++j) { const unsigned c = xb_ld(&bar[XB_XCNT(j)]); sum += c; cnt += (c > 0u) ? 1u : 0u; mine = (j == x) ? c : mine; }
        if (sum == G) break;
        __builtin_amdgcn_s_sleep(1);
        if ((++sp & 255u) == 0u) { if (xb_ld(&bar[XB_TMO])) break; if (sp > XB_SPIN_CAP) { atomicAdd(&bar[XB_TMO], 1u); break; } }
    }
    nloc = mine > 0u ? mine : 1u; nx = cnt > 0u ? cnt : 1u;
}

__device__ __forceinline__ void xcd_barrier(const XcdBarrier& b) {
    asm volatile("s_waitcnt vmcnt(0)" ::: "memory");
    __syncthreads();
    if (threadIdx.x == 0) {
        unsigned* bar = b.bar;
        __builtin_amdgcn_s_waitcnt(0);
        unsigned nloc = b.st[0], nx = b.st[1];
        if (nloc == 0u) { xcd_barrier_complete(bar, b.x, nloc, nx); b.st[0] = nloc; b.st[1] = nx; }
        const unsigned old = xb_add(&bar[XB_XSUB(b.x)], 1u);
        const unsigned gen = old / nloc;
        if (old + 1u == (gen + 1u) * nloc) {
            __builtin_amdgcn_fence(__ATOMIC_RELEASE, "agent");
            asm volatile("s_waitcnt vmcnt(0)" ::: "memory");
            const unsigned og = xb_add(&bar[XB_TOP], 1u);
            const unsigned tg = og / nx;
            if (og + 1u == (tg + 1u) * nx) xb_add(&bar[XB_TOPGEN], 1u);
            else XB_SPIN(xb_ld(&bar[XB_TOPGEN]) == tg, bar);
            __builtin_amdgcn_fence(__ATOMIC_ACQUIRE, "agent");
            xb_add(&bar[XB_XGEN(b.x)], 1u);
            asm volatile("s_waitcnt vmcnt(0)" ::: "memory");
        } else {
            XB_SPIN(xb_ld(&bar[XB_XGEN(b.x)]) == gen, bar);
            __builtin_amdgcn_fence(__ATOMIC_ACQUIRE, "agent");
            asm volatile("s_waitcnt vmcnt(0)" ::: "memory");
        }
    }
    __syncthreads();
}
__device__ __forceinline__ void xcd_local_barrier(unsigned* lb, unsigned x, unsigned nloc, unsigned* tmo) {
    asm volatile("s_waitcnt vmcnt(0)" ::: "memory");
    __syncthreads();
    if (threadIdx.x == 0) {
        __builtin_amdgcn_s_waitcnt(0);
        const unsigned old = xb_add(&lb[64 * x], 1u), gen = old / nloc;
        if (old + 1u == (gen + 1u) * nloc) xb_add(&lb[64 * (16 + x)], 1u);
        else { unsigned sp = 0u; while (xb_ld(&lb[64 * (16 + x)]) == gen) { __builtin_amdgcn_s_sleep(1); if (++sp > (1u << 22)) { __hip_atomic_store(tmo, 1u, __ATOMIC_RELAXED, __HIP_MEMORY_SCOPE_AGENT); break; } } }
        __builtin_amdgcn_fence(__ATOMIC_ACQUIRE, "agent");
        asm volatile("s_waitcnt vmcnt(0)" ::: "memory");
    }
    __syncthreads();
}
__device__ __forceinline__ void conv_item(int it, const bf16* z, bf16* mix, const float* cw, const float* cb, const float* lg, const float* lb, LAS unsigned char* lds, int tid, int wave, int lane) {
    LAS float* U = (LAS float*)lds;
    const int t0 = it * 64, s0 = t0 & (SEQ - 1);
    u32x4 av[6], gv[6];
#pragma unroll
    for (int i = 0; i < 6; ++i) { const int c = tid + 512 * i, row = c >> 5, ch = c & 31; av[i] = (u32x4){0u, 0u, 0u, 0u}; gv[i] = av[i];
        if (c < 94 * 32 && s0 - 30 + row >= 0) { const bf16* zr = z + (size_t)(t0 - 30 + row) * ZP; av[i] = *(const u32x4*)(zr + Z_CA + 8 * ch); gv[i] = *(const u32x4*)(zr + Z_CG + 8 * ch); } }
#pragma unroll
    for (int i = 0; i < 6; ++i) { const int c = tid + 512 * i, row = c >> 5, ch = c & 31; const u32x4 a = av[i], g = gv[i]; f32x4 o0, o1;
        o0[0] = bflo(a.x) * sigm1(bflo(g.x)); o0[1] = bfhi(a.x) * sigm1(bfhi(g.x)); o0[2] = bflo(a.y) * sigm1(bflo(g.y)); o0[3] = bfhi(a.y) * sigm1(bfhi(g.y));
        o1[0] = bflo(a.z) * sigm1(bflo(g.z)); o1[1] = bfhi(a.z) * sigm1(bfhi(g.z)); o1[2] = bflo(a.w) * sigm1(bflo(g.w)); o1[3] = bfhi(a.w) * sigm1(bfhi(g.w));
        if (c < 94 * 32) { *(LAS f32x4*)(U + row * 256 + 8 * ch) = o0; *(LAS f32x4*)(U + row * 256 + 8 * ch + 4) = o1; } }
    __syncthreads();
    const int g = wave & 3, half = wave >> 2, c = 64 * g + lane;
    float w[31];
#pragma unroll
    for (int j = 0; j < 31; ++j) w[j] = cw[j * 256 + c];
    const float bias = cb[c], gg = lg[c], bb = lb[c];
    float uw[62];
#pragma unroll
    for (int i = 0; i < 62; ++i) uw[i] = U[(32 * half + i) * 256 + c];
#pragma unroll
    for (int tb = 0; tb < 32; tb += 4) {
        float y[4], mu[4], var[4];
#pragma unroll
        for (int k = 0; k < 4; ++k) { y[k] = bias;
#pragma unroll
            for (int j = 0; j < 31; ++j) y[k] += w[j] * uw[tb + k + j]; }
#pragma unroll
        for (int k = 0; k < 4; ++k) mu[k] = y[k];
#pragma unroll
        for (int o = 1; o < 64; o <<= 1) {
#pragma unroll
            for (int k = 0; k < 4; ++k) mu[k] += __shfl_xor(mu[k], o); }
#pragma unroll
        for (int k = 0; k < 4; ++k) { mu[k] *= (1.f / 64.f); y[k] -= mu[k]; var[k] = y[k] * y[k]; }
#pragma unroll
        for (int o = 1; o < 64; o <<= 1) {
#pragma unroll
            for (int k = 0; k < 4; ++k) var[k] += __shfl_xor(var[k], o); }
#pragma unroll
        for (int k = 0; k < 4; ++k) { const float yn = y[k] * __builtin_amdgcn_rsqf(var[k] * (1.f / 64.f) + RMS_EPS) * gg + bb;
            mix[(size_t)(t0 + 32 * half + tb + k) * DM + X_CONV + c] = (bf16)(pk2(silu1(yn), 0.f) & 0xffffu); }
    }
    __syncthreads();
}
#define RLX_AGENT __ATOMIC_RELAXED, __HIP_MEMORY_SCOPE_AGENT
__device__ __forceinline__ void st_wt(float* p, float v) { __hip_atomic_store(p, v, RLX_AGENT); }
__device__ __forceinline__ void st_wt(unsigned* p, unsigned v) { __hip_atomic_store(p, v, RLX_AGENT); }
__device__ __forceinline__ void st_wt(unsigned long long* p, unsigned long long v) { __hip_atomic_store(p, v, RLX_AGENT); }
__device__ __forceinline__ float ld_wt(const float* p) { return __hip_atomic_load(p, RLX_AGENT); }
__device__ __forceinline__ unsigned ld_wt(const unsigned* p) { return __hip_atomic_load(p, RLX_AGENT); }
__device__ __forceinline__ unsigned long long ld_wt(const unsigned long long* p) { return __hip_atomic_load(p, RLX_AGENT); }
__device__ __forceinline__ void publish_wave(unsigned* ctr, int lane) { asm volatile("s_waitcnt vmcnt(0)" ::: "memory"); if (lane == 0) __hip_atomic_fetch_add(ctr, 1u, RLX_AGENT); }
__device__ __forceinline__ void wait_count(unsigned* ctr, unsigned need, unsigned* tmo, int tid) {
    if (tid == 0) { unsigned sp = 0u;
        while (__hip_atomic_load(ctr, RLX_AGENT) < need) { __builtin_amdgcn_s_sleep(2); if (++sp > (1u << 20)) { __hip_atomic_store(tmo, 1u, RLX_AGENT); break; } } }
    __syncthreads();
}
__device__ __forceinline__ void kv_item(int it2, const bf16* z, float* KV, unsigned* kvc, LAS unsigned char* lds, int tid, int wave, int lane) {
    const int team = wave >> 2, it = 2 * it2 + team, tt = tid & 255;
    const int bh = it >> 5, n = it & 31, b = bh / NHM, hh = bh - b * NHM; const size_t tok0 = (size_t)b * SEQ + 256 * n;
    const float lg2 = log2f(1.0f - ex2(-5.0f - (float)hh));
    LAS unsigned char* Ki = lds + team * 65536; LAS unsigned char* Vw = Ki + 32768;
    { u32x4 kk[8], vv[8];
#pragma unroll
    for (int i = 0; i < 8; ++i) { const int c = tt + 256 * i, row = c >> 3, ch = c & 7; kk[i] = *(const u32x4*)(z + (tok0 + row) * ZP + Z_RK + 64 * hh + ch * 8); vv[i] = *(const u32x4*)(z + (tok0 + row) * ZP + Z_RV + 64 * hh + ch * 8); }
#pragma unroll
    for (int i = 0; i < 8; ++i) { const int c = tt + 256 * i, row = c >> 3, ch = c & 7; const u32x4 v = vv[i];
        const float wg = ex2((float)(255 - row) * lg2); u32x4 o;
        o.x = pk2(bflo(v.x) * wg, bfhi(v.x) * wg); o.y = pk2(bflo(v.y) * wg, bfhi(v.y) * wg); o.z = pk2(bflo(v.z) * wg, bfhi(v.z) * wg); o.w = pk2(bflo(v.w) * wg, bfhi(v.w) * wg);
        *(LAS u32x4*)(Ki + row * 128 + ch * 16) = kk[i]; *(LAS u32x4*)(Vw + row * 128 + ch * 16) = o; } }
    __syncthreads();
    const int tl = wave & 3, ce = tl >> 1, cd = tl & 1, r = lane & 31, h = lane >> 5, blk = (lane >> 4) & 1, q4 = (lane & 15) >> 2, p = lane & 3;
    f32x16 acc = zero16();
#pragma unroll
    for (int kk = 0; kk < 16; ++kk) { const int rowa = 16 * kk + 8 * h + q4; const int ofa = rowa * 128 + 32 * blk + 8 * p;
        const bf16x8 a = cat8(vtr(Vw + ofa + 64 * ce), vtr(Vw + ofa + 4 * 128 + 64 * ce));
        const bf16x8 bb = cat8(vtr(Ki + ofa + 64 * cd), vtr(Ki + ofa + 4 * 128 + 64 * cd));
        acc = mfma32(a, bb, acc); }
    float* o = KV + (size_t)it * 4096;
#pragma unroll
    for (int i = 0; i < 16; ++i) st_wt(o + (32 * ce + crow(i, h)) * 64 + 32 * cd + r, acc[i]);
    publish_wave(kvc + 64 * bh, lane);
    __syncthreads();
}
__device__ __forceinline__ void kmean_item(int it8, const bf16* z, float* KM, unsigned* kmc, LAS unsigned char* lds, int wave, int lane) {
    const int it = 8 * it8 + wave, bh = it >> 5, j = it & 31, b = bh / NHM, hh = bh - b * NHM; const size_t tok0 = (size_t)b * SEQ + 256 * j;
    LAS float* S = (LAS float*)(lds + wave * 2048);
    const int g = lane >> 3, ch = lane & 7; float a[8];
#pragma unroll
    for (int k = 0; k < 8; ++k) a[k] = 0.f;
#pragma unroll
    for (int q = 0; q < 4; ++q) { u32x4 v[8];
#pragma unroll
        for (int i = 0; i < 8; ++i) v[i] = *(const u32x4*)(z + (tok0 + g + 8 * (8 * q + i)) * ZP + Z_MK + 64 * hh + ch * 8);
#pragma unroll
        for (int i = 0; i < 8; ++i) { a[0] += bflo(v[i].x); a[1] += bfhi(v[i].x); a[2] += bflo(v[i].y); a[3] += bfhi(v[i].y); a[4] += bflo(v[i].z); a[5] += bfhi(v[i].z); a[6] += bflo(v[i].w); a[7] += bfhi(v[i].w); } }
    *(LAS f32x4*)(S + g * 64 + ch * 8) = (f32x4){a[0], a[1], a[2], a[3]}; *(LAS f32x4*)(S + g * 64 + ch * 8 + 4) = (f32x4){a[4], a[5], a[6], a[7]};
    LDS_WAIT(); asm volatile("" ::: "memory");
    float s = 0.f;
#pragma unroll
    for (int q = 0; q < 8; ++q) s += S[q * 64 + lane];
    st_wt(KM + (size_t)it * 64 + lane, s * (1.f / 256.f)); publish_wave(kmc + 64 * bh, lane);
    LDS_WAIT(); asm volatile("" ::: "memory");
}
__device__ __forceinline__ void scan_item(int it, const float* KV, bf16* PREV, unsigned* kvc, unsigned* scc, unsigned* tmo, int tid, int lane) {
    const int bh = it >> 1, part = it & 1, hh = bh % NHM; const int idx = part * 2048 + 4 * tid;
    wait_count(kvc + 64 * bh, 128u, tmo, tid);
    const float g256 = ex2(256.0f * log2f(1.0f - ex2(-5.0f - (float)hh)));
    float k0[NCH], k1[NCH], k2[NCH], k3[NCH];
#pragma unroll
    for (int n = 0; n < NCH; ++n) { const float* p = KV + ((size_t)bh * NCH + n) * 4096 + idx; k0[n] = ld_wt(p); k1[n] = ld_wt(p + 1); k2[n] = ld_wt(p + 2); k3[n] = ld_wt(p + 3); }
    float s0 = 0.f, s1 = 0.f, s2 = 0.f, s3 = 0.f;
#pragma unroll
    for (int n = 0; n < NCH; ++n) { st_wt((unsigned long long*)(PREV + ((size_t)bh * NCH + n) * 4096 + idx), (unsigned long long)pk2(s0, s1) | ((unsigned long long)pk2(s2, s3) << 32));
        s0 = s0 * g256 + k0[n]; s1 = s1 * g256 + k1[n]; s2 = s2 * g256 + k2[n]; s3 = s3 * g256 + k3[n]; }
    publish_wave(scc + 64 * bh, lane);
}
__device__ __forceinline__ void gate_item(int it, const bf16* z, const float* KM, unsigned* SEL, unsigned* kmc, unsigned* gtc, unsigned* tmo, LAS unsigned char* lds, int tid, int lane) {
    const int bh = it >> 4, ip = it & 15, b = bh / NHM, hh = bh - b * NHM;
    wait_count(kmc + 64 * bh, 32u, tmo, tid);
    LAS float* km = (LAS float*)lds;
#pragma unroll
    for (int i = 0; i < 4; ++i) km[tid + 512 * i] = ld_wt(KM + (size_t)bh * 2048 + tid + 512 * i);
    __syncthreads();
    const int i = 2 * ip + (tid >> 8), s = 256 * i + (tid & 255);
    const bf16* qp = z + ((size_t)b * SEQ + s) * ZP + Z_MQ + 64 * hh;
    float q[64];
#pragma unroll
    for (int c = 0; c < 8; ++c) { const u32x4 v = *(const u32x4*)(qp + 8 * c);
        q[8 * c] = bflo(v.x); q[8 * c + 1] = bfhi(v.x); q[8 * c + 2] = bflo(v.y); q[8 * c + 3] = bfhi(v.y); q[8 * c + 4] = bflo(v.z); q[8 * c + 5] = bfhi(v.z); q[8 * c + 6] = bflo(v.w); q[8 * c + 7] = bfhi(v.w); }
    const float ninf = -__builtin_inff();
    float v0 = ninf, v1 = ninf, v2 = ninf; int i0 = 0, i1 = 0, i2 = 0;
    for (int j = 0; j < i; ++j) { float g = 0.f;
#pragma unroll
        for (int d = 0; d < 64; d += 4) { const f32x4 k4 = *(const LAS f32x4*)(km + j * 64 + d); g += q[d] * k4[0] + q[d + 1] * k4[1] + q[d + 2] * k4[2] + q[d + 3] * k4[3]; }
        if (g > v0) { v2 = v1; i2 = i1; v1 = v0; i1 = i0; v0 = g; i0 = j; }
        else if (g > v1) { v2 = v1; i2 = i1; v1 = g; i1 = j; }
        else if (g > v2) { v2 = g; i2 = j; } }
    unsigned mask = 0u;
    if (i > 0) mask |= 1u << i0;
    if (i > 1) mask |= 1u << i1;
    if (i > 2) mask |= 1u << i2;
    st_wt(SEL + (size_t)bh * SEQ + s, mask);
    publish_wave(gtc + 64 * bh, lane);
    __syncthreads();
}
__device__ __forceinline__ void attn_wave(LAS const unsigned char* Ki, LAS const unsigned char* Vi, const bf16x8 (&qf)[4], int nkt, int diag, int qloc, int lane, f32x16 (&o)[2], float& m, float& l) {
    const int r = lane & 31, h = lane >> 5, blk = (lane >> 4) & 1, q4 = (lane & 15) >> 2, p = lane & 3;
    o[0] = zero16(); o[1] = zero16(); l = 0.f; m = 0.f;
    f32x16 negm = zero16();
    bf16x8 kf[4];
#pragma unroll
    for (int s = 0; s < 4; ++s) kf[s] = ldsrow(Ki + r * PIT + 32 * s + 16 * h);
    for (int kt = 0; kt < nkt; ++kt) {
        f32x16 x = negm;
        asm volatile("" : "+v"(kf[0]), "+v"(kf[1]), "+v"(kf[2]), "+v"(kf[3]));
#pragma unroll
        for (int s = 0; s < 4; ++s) x = mfma32(kf[s], qf[s], x);
        const int ktn = (kt + 1 < nkt) ? kt + 1 : kt;
#pragma unroll
        for (int s = 0; s < 4; ++s) kf[s] = ldsrow(Ki + (32 * ktn + r) * PIT + 32 * s + 16 * h);
        bf16x8 vf[2][2];
#pragma unroll
        for (int s2 = 0; s2 < 2; ++s2) { const int ofv = (32 * kt + 16 * s2 + 4 * h + q4) * PIT + 32 * blk + 8 * p;
#pragma unroll
            for (int c = 0; c < 2; ++c) vf[s2][c] = cat8(vtr(Vi + ofv + 64 * c), vtr(Vi + ofv + 8 * PIT + 64 * c)); }
        __builtin_amdgcn_sched_barrier(0);
        if (kt == diag) {
#pragma unroll
            for (int i = 0; i < 16; ++i) if (32 * kt + crow(i, h) > qloc) x[i] = -__builtin_inff(); }
        float tm = x[0];
#pragma unroll
        for (int i = 1; i < 16; ++i) tm = fmaxf(tm, x[i]);
        tm = fmaxf(tm, __shfl_xor(tm, 32));
        if (kt == 0) { m = tm;
#pragma unroll
            for (int i = 0; i < 16; ++i) { x[i] -= tm; negm[i] = -tm; } }
        else if (__any(tm > 8.0f)) {
            const float dm = fmaxf(tm, 0.f), sc = ex2(-dm);
            l *= sc; o[0] = o[0] * sc; o[1] = o[1] * sc; m += dm;
#pragma unroll
            for (int i = 0; i < 16; ++i) { x[i] -= dm; negm[i] = -m; } }
#pragma unroll
        for (int i = 0; i < 16; ++i) { x[i] = ex2(x[i]); l += x[i]; }
        const bf16x8 pf0 = pack8(x, 0), pf1 = pack8(x, 1);
        __builtin_amdgcn_sched_barrier(0);
        o[0] = mfma32(vf[0][0], pf0, o[0]); o[1] = mfma32(vf[0][1], pf0, o[1]); o[0] = mfma32(vf[1][0], pf1, o[0]); o[1] = mfma32(vf[1][1], pf1, o[1]);
    }
}
__device__ __forceinline__ void store_partial(const f32x16 (&o)[2], float m, float l, bf16* OP, float* LSE, int bh, int slot, int qidx, bool valid, int lane, LAS unsigned char* ot) {
    const int r = lane & 31, h = lane >> 5; const float lt = l + __shfl_xor(l, 32), inv = 1.0f / lt;
    LAS int* rowdst = (LAS int*)(ot + 32 * 80);
    const int dst = valid ? (bh * 4 + slot) * SEQ + qidx : -1;
    if (h == 0) rowdst[r] = dst;
#pragma unroll
    for (int c = 0; c < 2; ++c)
#pragma unroll
        for (int g = 0; g < 4; ++g) { int w = __builtin_amdgcn_cvt_pk_fp8_f32(o[c][4 * g] * inv, o[c][4 * g + 1] * inv, 0, false); w = __builtin_amdgcn_cvt_pk_fp8_f32(o[c][4 * g + 2] * inv, o[c][4 * g + 3] * inv, w, true);
            *(LAS int*)(ot + r * 80 + 32 * c + 8 * g + 4 * h) = w; }
    if (valid && h == 0) LSE[(size_t)dst] = m + log2f(lt);
    LDS_WAIT(); asm volatile("" ::: "memory");
    u32x4 v[2]; int d[2];
#pragma unroll
    for (int k = 0; k < 2; ++k) { const int row = 16 * k + (lane >> 2); v[k] = *(const LAS u32x4*)(ot + row * 80 + (lane & 3) * 16); d[k] = rowdst[row]; }
#pragma unroll
    for (int k = 0; k < 2; ++k) if (d[k] >= 0) *(u32x4*)((unsigned char*)OP + (size_t)d[k] * 64 + 16 * (lane & 3)) = v[k];
    LDS_WAIT(); asm volatile("" ::: "memory");
}
__device__ __forceinline__ void moba_item(int bh, int j, bool own, int i0, int i1, const bf16* z, const unsigned* SEL, bf16* OP, float* LSE, unsigned* gtc, unsigned* tmo, LAS unsigned char* lds, int tid, int wave, int lane) {
    const int b = bh / NHM, hh = bh - b * NHM; const size_t tokb = (size_t)b * SEQ;
    wait_count(gtc + 64 * bh, 128u, tmo, tid);
    LAS unsigned char* Ki = lds; LAS unsigned char* Vi = lds + IMG; LAS unsigned short* list = (LAS unsigned short*)(lds + 2 * IMG); LAS int* wtot = (LAS int*)(lds + 2 * IMG + 4096);
    const int ncand = 256 * (i1 - i0), c0 = 4 * tid; int f[4] = {0, 0, 0, 0};
    u32x4 mk = {0u, 0u, 0u, 0u};
    if (c0 < ncand) { const unsigned* sp = SEL + (size_t)bh * SEQ + 256 * i0 + c0; mk = (u32x4){ld_wt(sp), ld_wt(sp + 1), ld_wt(sp + 2), ld_wt(sp + 3)}; }
    const int r = lane & 31, h = lane >> 5, qt = wave < 4 ? wave : 11 - wave;
    { LAS unsigned char* const d_[2] = {Ki, Vi}; const bf16* const s_[2] = {z + (tokb + 256 * j) * ZP + Z_MK + 64 * hh, z + (tokb + 256 * j) * ZP + Z_MV + 64 * hh}; stage256n<2>(d_, s_, ZP, tid); }
    f[0] = (mk.x >> j) & 1; f[1] = (mk.y >> j) & 1; f[2] = (mk.z >> j) & 1; f[3] = (mk.w >> j) & 1;
    const int mine = f[0] + f[1] + f[2] + f[3]; int inc = mine;
#pragma unroll
    for (int o = 1; o < 64; o <<= 1) { const int t = __shfl_up(inc, o); if (lane >= o) inc += t; }
    if (lane == 63) wtot[wave] = inc;
    __syncthreads();
    int base = 0, cnt = 0;
#pragma unroll
    for (int w = 0; w < 8; ++w) { const int t = wtot[w]; if (w < wave) base += t; cnt += t; }
    int pos = base + inc - mine;
#pragma unroll
    for (int k = 0; k < 4; ++k) if (f[k]) { list[pos] = (unsigned short)(256 * i0 + c0 + k); ++pos; }
    __syncthreads();
    const int ntl = (cnt + 255) >> 8, Tfirst = own ? -1 : 0;
    int qidx = 0; bool valid = false; unsigned mq = 0u; bf16x8 qn[4];
#define MOBA_LOADQ(Tn) do { if ((Tn) < 0) { qidx = 256 * j + 32 * qt + r; valid = true; } else { const int li_ = 256 * (Tn) + 32 * wave + r; valid = li_ < cnt; qidx = list[valid ? li_ : cnt - 1]; } \
        _Pragma("unroll") for (int s = 0; s < 4; ++s) qn[s] = *(const bf16x8*)(z + (tokb + qidx) * ZP + Z_MQ + 64 * hh + 16 * s + 8 * h); \
        mq = ld_wt(SEL + (size_t)bh * SEQ + qidx); } while (0)
    if (Tfirst < 0 || 32 * wave < cnt) MOBA_LOADQ(Tfirst);
    for (int T = Tfirst; T < ntl; ++T) {
        if (T >= 0 && 256 * T + 32 * wave >= cnt) break;
        bf16x8 qf[4];
#pragma unroll
        for (int s = 0; s < 4; ++s) qf[s] = qn[s];
        const int qcur = qidx, slot = (T < 0) ? 3 : __builtin_popcount(mq & ((1u << j) - 1u)); const bool vcur = valid;
        if (T + 1 < ntl && 256 * (T + 1) + 32 * wave < cnt) MOBA_LOADQ(T + 1);
        f32x16 o[2]; float m, l;
        attn_wave(Ki, Vi, qf, (T < 0) ? qt + 1 : 8, (T < 0) ? qt : -1, 32 * qt + r, lane, o, m, l);
        store_partial(o, m, l, OP, LSE, bh, slot, qcur, vcur, lane, lds + 2 * IMG + 8192 + wave * 3072);
    }
#undef MOBA_LOADQ
    __syncthreads();
}
__device__ __forceinline__ void ret_item(int it, const bf16* z, const bf16* PREV, bf16* mix, unsigned* scc, unsigned* tmo, LAS unsigned char* lds, int tid, int wave, int lane) {
    const int bh = it >> 5, n = it & 31, b = bh / NHM, hh = bh - b * NHM; const size_t tok0 = (size_t)b * SEQ + 256 * n;
    wait_count(scc + 64 * bh, 16u, tmo, tid);
    const float lg2 = log2f(1.0f - ex2(-5.0f - (float)hh));
    LAS unsigned char* Qi = lds; LAS unsigned char* Ki = lds + IMG; LAS unsigned char* Vi = lds + 2 * IMG; LAS unsigned char* Pi = lds + 3 * IMG;
    { const unsigned* pp_ = (const unsigned*)(PREV + (size_t)it * 4096 + (size_t)(tid >> 3) * 64 + (tid & 7) * 8);
      const u32x4 pv_ = {ld_wt(pp_), ld_wt(pp_ + 1), ld_wt(pp_ + 2), ld_wt(pp_ + 3)};
      LAS unsigned char* const d_[3] = {Qi, Ki, Vi}; const bf16* const s_[3] = {z + tok0 * ZP + Z_RQ + 64 * hh, z + tok0 * ZP + Z_RK + 64 * hh, z + tok0 * ZP + Z_RV + 64 * hh}; stage256n<3>(d_, s_, ZP, tid);
      *(LAS u32x4*)(Pi + (tid >> 3) * PIT + (tid & 7) * 16) = pv_; }
    __syncthreads();
    const int qt = wave < 4 ? wave : 11 - wave, r = lane & 31, h = lane >> 5, blk = (lane >> 4) & 1, q4 = (lane & 15) >> 2, p = lane & 3, qloc = 32 * qt + r;
    const bf16* gp = z + (tok0 + qloc) * ZP + Z_RG + 64 * hh;
    u32x2 gvv[2][4];
#pragma unroll
    for (int c = 0; c < 2; ++c)
#pragma unroll
        for (int g = 0; g < 4; ++g) gvv[c][g] = (hh < 4) ? *(const u32x2*)(gp + 32 * c + 8 * g + 4 * h) : (u32x2){0u, 0u};
    bf16x8 qf[4];
#pragma unroll
    for (int s = 0; s < 4; ++s) qf[s] = ldsrow(Qi + qloc * PIT + 32 * s + 16 * h);
    f32x16 cx[2], o[2]; cx[0] = zero16(); cx[1] = zero16(); o[0] = zero16(); o[1] = zero16();
#pragma unroll
    for (int c = 0; c < 2; ++c)
#pragma unroll
        for (int s = 0; s < 4; ++s) cx[c] = mfma32(ldsrow(Pi + (32 * c + r) * PIT + 32 * s + 16 * h), qf[s], cx[c]);
    float grel[16];
#pragma unroll
    for (int i = 0; i < 16; ++i) grel[i] = ex2((float)(r - crow(i, h)) * lg2);
    bf16x8 kf[4];
#pragma unroll
    for (int s = 0; s < 4; ++s) kf[s] = ldsrow(Ki + r * PIT + 32 * s + 16 * h);
    for (int kt = 0; kt <= qt; ++kt) {
        f32x16 x = zero16();
        asm volatile("" : "+v"(kf[0]), "+v"(kf[1]), "+v"(kf[2]), "+v"(kf[3]));
#pragma unroll
        for (int s = 0; s < 4; ++s) x = mfma32(kf[s], qf[s], x);
        const int ktn = (kt < qt) ? kt + 1 : kt;
#pragma unroll
        for (int s = 0; s < 4; ++s) kf[s] = ldsrow(Ki + (32 * ktn + r) * PIT + 32 * s + 16 * h);
        bf16x8 vf[2][2];
#pragma unroll
        for (int s2 = 0; s2 < 2; ++s2) { const int ofv = (32 * kt + 16 * s2 + 4 * h + q4) * PIT + 32 * blk + 8 * p;
#pragma unroll
            for (int c = 0; c < 2; ++c) vf[s2][c] = cat8(vtr(Vi + ofv + 64 * c), vtr(Vi + ofv + 8 * PIT + 64 * c)); }
        __builtin_amdgcn_sched_barrier(0);
        { const float ts = ex2((float)(32 * (qt - kt)) * lg2);
#pragma unroll
        for (int i = 0; i < 16; ++i) { const float wv = grel[i] * ts; x[i] = (kt < qt || r >= crow(i, h)) ? x[i] * wv : 0.f; } }
        const bf16x8 pf0 = pack8(x, 0), pf1 = pack8(x, 1);
        __builtin_amdgcn_sched_barrier(0);
        o[0] = mfma32(vf[0][0], pf0, o[0]); o[1] = mfma32(vf[0][1], pf0, o[1]); o[0] = mfma32(vf[1][0], pf1, o[0]); o[1] = mfma32(vf[1][1], pf1, o[1]);
    }
    const float wcr = ex2((float)(qloc + 1) * lg2); float ss = 0.f;
#pragma unroll
    for (int c = 0; c < 2; ++c)
#pragma unroll
        for (int i = 0; i < 16; ++i) { const float y = o[c][i] + wcr * cx[c][i]; o[c][i] = y; ss += y * y; }
    ss += __shfl_xor(ss, 32);
    const float rn = __builtin_amdgcn_rsqf(ss * (1.f / 64.f) + RMS_EPS);
    bf16* mp = mix + (tok0 + qloc) * DM + X_RET + 64 * hh;
#pragma unroll
    for (int c = 0; c < 2; ++c)
#pragma unroll
        for (int g = 0; g < 4; ++g) { const int e0 = 32 * c + 8 * g + 4 * h; const u32x2 gv = gvv[c][g]; u32x2 w;
            if (hh < 4) { w.x = pk2(silu1(bflo(gv.x)) * o[c][4 * g] * rn, silu1(bfhi(gv.x)) * o[c][4 * g + 1] * rn); w.y = pk2(silu1(bflo(gv.y)) * o[c][4 * g + 2] * rn, silu1(bfhi(gv.y)) * o[c][4 * g + 3] * rn); }
            else { w.x = pk2(o[c][4 * g] * rn, o[c][4 * g + 1] * rn); w.y = pk2(o[c][4 * g + 2] * rn, o[c][4 * g + 3] * rn); }
            *(u32x2*)(mp + e0) = w; }
    __syncthreads();
}
struct CombIn { unsigned selw; float ls[4]; u32x2 ov[4]; };
__device__ __forceinline__ void combine_load(int idx, const bf16* OP, const float* LSE, const unsigned* SEL, CombIn& c) {
    const int ch = idx & 7, th = idx >> 3, hh = th % NHM, tok = th / NHM, b = tok >> 13, s = tok & (SEQ - 1), bh = b * NHM + hh;
    c.selw = SEL[(size_t)bh * SEQ + s];
#pragma unroll
    for (int k = 0; k < 4; ++k) { c.ls[k] = LSE[((size_t)bh * 4 + k) * SEQ + s]; c.ov[k] = *(const u32x2*)((const unsigned char*)OP + (((size_t)bh * 4 + k) * SEQ + s) * 64 + 8 * ch); }
}
__device__ __forceinline__ void combine_store(int idx, const CombIn& c, bf16* mix) {
    const int ch = idx & 7, th = idx >> 3, hh = th % NHM, tok = th / NHM;
    const int ns = __builtin_popcount(c.selw); float mx = -__builtin_inff(); float ls[4];
#pragma unroll
    for (int k = 0; k < 4; ++k) { const bool on = (k == 3) || (k < ns); ls[k] = on ? c.ls[k] : -__builtin_inff(); mx = fmaxf(mx, ls[k]); }
    float a[8], wsum = 0.f;
#pragma unroll
    for (int k = 0; k < 8; ++k) a[k] = 0.f;
#pragma unroll
    for (int k = 0; k < 4; ++k) { const bool on = (k == 3) || (k < ns); const float wg = on ? ex2(ls[k] - mx) : 0.f; wsum += wg;
        u32x2 v = c.ov[k]; if (!on) v = (u32x2){0u, 0u};
        const f32x2 p0 = __builtin_amdgcn_cvt_pk_f32_fp8((int)v.x, false), p1 = __builtin_amdgcn_cvt_pk_f32_fp8((int)v.x, true), p2 = __builtin_amdgcn_cvt_pk_f32_fp8((int)v.y, false), p3 = __builtin_amdgcn_cvt_pk_f32_fp8((int)v.y, true);
        a[0] += wg * p0[0]; a[1] += wg * p0[1]; a[2] += wg * p1[0]; a[3] += wg * p1[1]; a[4] += wg * p2[0]; a[5] += wg * p2[1]; a[6] += wg * p3[0]; a[7] += wg * p3[1]; }
    const float inv = 1.0f / wsum; u32x4 w; w.x = pk2(a[0] * inv, a[1] * inv); w.y = pk2(a[2] * inv, a[3] * inv); w.z = pk2(a[4] * inv, a[5] * inv); w.w = pk2(a[6] * inv, a[7] * inv);
    *(u32x4*)(mix + (size_t)tok * DM + X_MOBA + 64 * hh + 8 * ch) = w;
}
__device__ __forceinline__ void rgate_item2(int idx0, int idx1, const bf16* z, bf16* mix) {
    u32x4 g[2], v[2]; bf16* mp[2];
#pragma unroll
    for (int k = 0; k < 2; ++k) { const int idx = k ? idx1 : idx0, ch = idx & 7, th = idx >> 3, hh = 4 + (th & 1), tok = th >> 1;
        g[k] = *(const u32x4*)(z + (size_t)tok * ZP + Z_RG + 64 * hh + 8 * ch); mp[k] = mix + (size_t)tok * DM + X_RET + 64 * hh + 8 * ch; v[k] = *(const u32x4*)mp[k]; }
#pragma unroll
    for (int k = 0; k < 2; ++k) { if (k == 1 && idx1 == idx0) break; u32x4 w;
        w.x = pk2(silu1(bflo(g[k].x)) * bflo(v[k].x), silu1(bfhi(g[k].x)) * bfhi(v[k].x)); w.y = pk2(silu1(bflo(g[k].y)) * bflo(v[k].y), silu1(bfhi(g[k].y)) * bfhi(v[k].y));
        w.z = pk2(silu1(bflo(g[k].z)) * bflo(v[k].z), silu1(bfhi(g[k].z)) * bfhi(v[k].z)); w.w = pk2(silu1(bflo(g[k].w)) * bflo(v[k].w), silu1(bfhi(g[k].w)) * bfhi(v[k].w));
        *(u32x4*)mp[k] = w; }
}
#ifndef MK_PER_PHASE
#define MK_PER_PHASE 0
#endif
constexpr int N_PHASES = 1 + DEPTH * 8;
constexpr int T_KM = NBH * NCH / 8, T_KV = T_KM + NBH * NCH / 2, T_GT = T_KV + NBH * 16, T_SC = T_GT + NBH * 2, T_CV = T_SC + 256, T_G13 = T_CV + M / 256, MIXC_LIST = NBH * 76, T_MB = T_G13 + MIXC_LIST, T_RT = T_MB + NBH * NCH, MIXC_ITEMS = T_RT + NBH;

__global__ void __launch_bounds__(512, 2) fwd(Args args) {
    extern __shared__ __attribute__((aligned(16))) unsigned char lds_raw[];
    LAS unsigned char* lds = (LAS unsigned char*)lds_raw;
    volatile LAS unsigned* MISC = (volatile LAS unsigned*)(lds + MISC_OFF);
    const int tid0 = threadIdx.x, wave0 = __builtin_amdgcn_readfirstlane(tid0 >> 6);
    const int G = gridDim.x, bid = blockIdx.x, NGW = G * 8;
    unsigned char* const ws0 = args.ws;
    unsigned* ctl = (unsigned*)(ws0 + WS_CTL);
    for (int u = tid0; u < (LDS_BYTES - LDSCTL_OFF) / 4; u += 512) ((LAS unsigned*)(lds + LDSCTL_OFF))[u] = 0u;
    __syncthreads();
    XcdBarrier bar; bar.bar = ctl + CW_BAR; bar.x = 0; bar.st = nullptr;
    if (!MK_PER_PHASE) bar = xcd_barrier_post(ctl + CW_BAR, MISC + 8);
    if (tid0 == 0) __hip_atomic_store(ctl + CW_XT + bid, xb_xcc_id() + 1u, __ATOMIC_RELAXED, __HIP_MEMORY_SCOPE_AGENT);
    int lok = 0;
    const int lo = args.ph_lo, hi = args.ph_hi; int pc = 0;
#define RUN (pc >= lo && pc < hi)
#define SEAM do { ++pc; if (!MK_PER_PHASE && pc > lo && pc < hi) xcd_barrier(bar); } while (0)
#define SEAM_LOCAL do { ++pc; if (!MK_PER_PHASE && pc > lo && pc < hi) { if (lok) xcd_local_barrier(ctl + CW_LB, bar.x, 32u, ctl + CW_TMO); else xcd_barrier(bar); } } while (0)

#define ENV unsigned sd_ = 0u; asm volatile("" : "+s"(sd_)); int tid = wave0 * 64 + (int)__builtin_amdgcn_mbcnt_hi(~0u, __builtin_amdgcn_mbcnt_lo(~0u, sd_)); asm volatile("" : "+v"(tid)); const int lane = tid & 63, wave = __builtin_amdgcn_readfirstlane(tid >> 6), gw = bid * 8 + wave; (void)lane; (void)gw; \
    GAS unsigned char* wsl = (GAS unsigned char*)ws0; asm volatile("" : "+s"(wsl)); unsigned char* ws = (unsigned char*)wsl; int zi = 0; asm volatile("" : "+s"(zi)); GAS float* xresl = (GAS float*)args.out; asm volatile("" : "+s"(xresl)); float* xres = (float*)xresl; \
    bf16* XB = (bf16*)(ws + WS_XB); bf16* Z = (bf16*)(ws + WS_Z); bf16* ACT = (bf16*)(ws + WS_ACT); bf16* MIX = (bf16*)(ws + WS_MIX); \
    bf16* OP = (bf16*)(ws + WS_OP); float* LSE = (float*)(ws + WS_LSE); unsigned* SEL = (unsigned*)(ws + WS_SEL); \
    float* RT = (float*)(ws + WS_RT); float* MT = (float*)(ws + WS_MT); float* SSQ = (float*)(ws + WS_SSQ); \
    float* KV = (float*)(ws + WS_KV); bf16* PREV = (bf16*)(ws + WS_PREV); float* KM = (float*)(ws + WS_KM); \
    LAS float* scr = (LAS float*)(lds + wave * 16384); (void)scr; (void)XB; (void)Z; (void)ACT; (void)MIX; (void)OP; (void)LSE; (void)SEL; (void)RT; (void)MT; (void)SSQ; (void)KV; (void)PREV; (void)KM; (void)xres
#define INP(k) ((const float*)(GAS const float*)args.in[(k) + zi])

#define CVT_PULL_L(hd, L_, blo, bhi) do { unsigned* cvh = (unsigned*)(ws + WS_CTL) + CW_Q + 64 * (hd); \
        for (;;) { __syncthreads(); if (tid == 0) MISC[1] = __hip_atomic_fetch_add(cvh, 1u, __ATOMIC_RELAXED, __HIP_MEMORY_SCOPE_AGENT); __syncthreads(); \
            const int bt = (blo) + (int)MISC[1]; if (bt >= (bhi)) break; \
            cvt_layer_batch(args, zi, (L_), ws + WS_W + (size_t)((L_) & 1) * WBUF_BYTES, bt, lds, wave, lane); } } while (0)
#define CVT_PULL(qi, blo, bhi) do { if (l + 1 < DEPTH) CVT_PULL_L(8 + 2 * l + (qi), l + 1, blo, bhi); } while (0)

    if (RUN) { ENV; const float* x_in = INP(0);
        CVT_PULL_L(14, 0, 0, b_layer(0));
        for (int m = gw; m < M; m += 2 * NGW) {
            const int m1 = (m + NGW < M) ? m + NGW : m;
            const f32x4* xr0 = (const f32x4*)(x_in + (size_t)m * DM) + lane; const f32x4* xr1 = (const f32x4*)(x_in + (size_t)m1 * DM) + lane; f32x4 v0[4], v1[4]; float s0[4], s1[4];
#pragma unroll
            for (int j = 0; j < 4; ++j) { v0[j] = xr0[64 * j]; v1[j] = xr1[64 * j]; }
#pragma unroll
            for (int j = 0; j < 4; ++j) { s0[j] = (v0[j][0] * v0[j][0] + v0[j][1] * v0[j][1]) + (v0[j][2] * v0[j][2] + v0[j][3] * v0[j][3]); s1[j] = (v1[j][0] * v1[j][0] + v1[j][1] * v1[j][1]) + (v1[j][2] * v1[j][2] + v1[j][3] * v1[j][3]); }
            float am0 = 0.f, am1 = 0.f;
#pragma unroll
            for (int j = 0; j < 4; ++j) { am0 = fmaxf(am0, fmaxf(fmaxf(fabsf(v0[j][0]), fabsf(v0[j][1])), fmaxf(fabsf(v0[j][2]), fabsf(v0[j][3])))); am1 = fmaxf(am1, fmaxf(fmaxf(fabsf(v1[j][0]), fabsf(v1[j][1])), fmaxf(fabsf(v1[j][2]), fabsf(v1[j][3])))); }
#pragma unroll
            for (int o = 1; o < 64; o <<= 1) {
#pragma unroll
                for (int j = 0; j < 4; ++j) { s0[j] += __shfl_xor(s0[j], o); s1[j] += __shfl_xor(s1[j], o); }
                am0 = fmaxf(am0, __shfl_xor(am0, o)); am1 = fmaxf(am1, __shfl_xor(am1, o)); }
            unsigned long long* o0 = (unsigned long long*)(XB + (size_t)m * DM) + lane; unsigned long long* o1 = (unsigned long long*)(XB + (size_t)m1 * DM) + lane;
#pragma unroll
            for (int j = 0; j < 4; ++j) { o0[64 * j] = (unsigned long long)pk2(v0[j][0], v0[j][1]) | ((unsigned long long)pk2(v0[j][2], v0[j][3]) << 32); o1[64 * j] = (unsigned long long)pk2(v1[j][0], v1[j][1]) | ((unsigned long long)pk2(v1[j][2], v1[j][3]) << 32); }
            { const float iv0 = am0 > 0.f ? 127.0f / am0 : 0.f, iv1 = am1 > 0.f ? 127.0f / am1 : 0.f; unsigned* q0 = (unsigned*)(ws + WS_X8 + (size_t)m * DM) + lane; unsigned* q1 = (unsigned*)(ws + WS_X8 + (size_t)m1 * DM) + lane;
#pragma unroll
              for (int j = 0; j < 4; ++j) { q0[64 * j] = pg8::q8x4(v0[j][0], v0[j][1], v0[j][2], v0[j][3], iv0); q1[64 * j] = pg8::q8x4(v1[j][0], v1[j][1], v1[j][2], v1[j][3], iv1); } }
            if (lane == 0) { *(f32x4*)(SSQ + (size_t)m * 4) = (f32x4){s0[0], s0[1], s0[2], s0[3]}; *(f32x4*)(SSQ + (size_t)m1 * 4) = (f32x4){s1[0], s1[1], s1[2], s1[3]};
                float* RF = (float*)(ws + WS_RF); RF[m] = __builtin_amdgcn_rsqf(((s0[0] + s0[1]) + (s0[2] + s0[3])) * (1.0f / 1024.0f) + RMS_EPS) * am0 * (1.0f / 127.0f); RF[m1] = __builtin_amdgcn_rsqf(((s1[0] + s1[1]) + (s1[2] + s1[3])) * (1.0f / 1024.0f) + RMS_EPS) * am1 * (1.0f / 127.0f); } }
        const int* pos = (const int*)INP(1);
        for (int i = bid * 512 + tid; i < M * 40; i += G * 512) { const int row = i / 40, k = i - row * 40; float c, s; sincos_acc((float)pos[row] * args.invf[k], c, s);
            float* t = (k < 32) ? RT + (size_t)row * 64 + 2 * k : MT + (size_t)row * 16 + 2 * (k - 32); *(f32x2*)t = (f32x2){c, s}; }
    }
    SEAM;
    if (!MK_PER_PHASE && lo == 0 && hi > 1) {
        int ok = (G == 256);
        if (tid0 < G) { const unsigned v = __hip_atomic_load(ctl + CW_XT + tid0, __ATOMIC_RELAXED, __HIP_MEMORY_SCOPE_AGENT), r = __hip_atomic_load(ctl + CW_XT + (tid0 & 7), __ATOMIC_RELAXED, __HIP_MEMORY_SCOPE_AGENT); ok &= (v == r) && (v != 0u); }
        unsigned seen = 0u;
#pragma unroll
        for (int q = 0; q < 8; ++q) seen |= 1u << (__hip_atomic_load(ctl + CW_XT + q, __ATOMIC_RELAXED, __HIP_MEMORY_SCOPE_AGENT) & 31u);
        ok &= (__builtin_popcount(seen) == 8);
        lok = __syncthreads_and(ok);
    }

    for (int l = 0; l < DEPTH; ++l) {
        for (int hf = 0; hf < 2; ++hf) {
            if (RUN) { ENV; unsigned char* wb = ws + WS_W + (size_t)(l & 1) * WBUF_BYTES; unsigned char* wgu = wb + (hf ? WO_GU2 : WO_GU1);
                pg8::Gemm g{(const bf16*)(ws + WS_X8), (const bf16*)wgu, M, NGU, DM / 2}; pg8::StaticOrder S; S.init(M, NGU, G, bid);
                pg8::EpiGU8 E{ACT, (const LAS float*)(lds + LDSCTL_OFF + 1024), (const LAS float*)(lds + LDSCTL_OFF + 7168)};
                { LAS float* rt_ = (LAS float*)(lds + LDSCTL_OFF + 1024); LAS float* ct_ = (LAS float*)(lds + LDSCTL_OFF + 7168); const float* RF = (const float*)(ws + WS_RF); const float* SWt = (const float*)(wgu + WO_SW);
                  pg8::Unit u_; for (int i_ = 0; S.next(i_, u_); ++i_) if (tid < 256) { rt_[i_ * 256 + tid] = RF[u_.pm * 256 + tid]; ct_[i_ * 256 + tid] = SWt[u_.pn * 256 + tid]; } __syncthreads(); }
                pg8::gemm_phase<pg8::EpiGU8, pg8::StaticOrder, true, true, true>(lds, g, S, E, tid);
                if (hf == 0) CVT_PULL(0, 0, b_early(l + 1)); else CVT_PULL(1, b_early(l + 1), b_layer(l + 1)); }
            SEAM_LOCAL;
            if (RUN) { ENV; unsigned char* wb = ws + WS_W + (size_t)(l & 1) * WBUF_BYTES; pg8::Gemm g{ACT, (const bf16*)(wb + (hf ? WO_D2 : WO_D1)), M, DM, FF}; pg8::StaticOrder S; S.init(M, DM, G, bid);
                const bool q8_ = hf == 1 && l + 1 < DEPTH, fin_ = hf == 1 && l + 1 == DEPTH;
                pg8::EpiRes E{XB, SSQ, 0.5f, 2.0f, (q8_ || (hf == 0 && l >= WIN8_FROM)) ? (signed char*)(ws + WS_X8) : nullptr, (float*)(ws + WS_RF), (float*)(ws + WS_EX), (unsigned*)(ws + WS_CTL) + CW_PC + 16 * 64 * (3 * l + (hf ? 2 : 0)), (unsigned*)(ws + WS_CTL) + CW_TMO, fin_ ? xres : nullptr, INP(17)};
                pg8::gemm_phase<pg8::EpiRes, pg8::StaticOrder, false, true>(lds, g, S, E, tid); }
            SEAM_LOCAL;
            if (hf == 0) {
                if (RUN && l < WIN8_FROM) { ENV; unsigned char* wb = ws + WS_W + (size_t)(l & 1) * WBUF_BYTES; pg8::Gemm g{XB, (const bf16*)(wb + WO_IN), M, ZN1, DM}; pg8::StaticOrder S; S.init(M, ZN1, G, bid);
                    pg8::EpiWin E{Z, (const LAS float*)(lds + LDSCTL_OFF + 1024), RT, MT};
                    { LAS float* rt_ = (LAS float*)(lds + LDSCTL_OFF + 1024); pg8::Unit u_; for (int i_ = 0; S.next(i_, u_); ++i_) if (tid < 256) rt_[i_ * 256 + tid] = pg8::row_rstd(SSQ, u_.pm * 256 + tid); __syncthreads(); }
                pg8::gemm_phase<pg8::EpiWin, pg8::StaticOrder, true, true>(lds, g, S, E, tid); }
                if (RUN && l >= WIN8_FROM) { ENV; unsigned char* wb = ws + WS_W + (size_t)(l & 1) * WBUF_BYTES; pg8::Gemm g{(const bf16*)(ws + WS_X8), (const bf16*)(wb + WO_IN8), M, ZN1, DM / 2}; pg8::StaticOrder S; S.init(M, ZN1, G, bid);
                    pg8::EpiWin8 E{Z, (const LAS float*)(lds + LDSCTL_OFF + 1024), RT, MT, (const LAS float*)(lds + LDSCTL_OFF + 7168)};
                    { LAS float* rt_ = (LAS float*)(lds + LDSCTL_OFF + 1024); LAS float* ct_ = (LAS float*)(lds + LDSCTL_OFF + 7168); const float* RF = (const float*)(ws + WS_RF); const float* SWt = (const float*)(wb + WO_SWIN);
                      pg8::Unit u_; for (int i_ = 0; S.next(i_, u_); ++i_) if (tid < 256) { rt_[i_ * 256 + tid] = RF[u_.pm * 256 + tid]; ct_[i_ * 256 + tid] = SWt[u_.pn * 256 + tid]; } __syncthreads(); }
                pg8::gemm_phase<pg8::EpiWin8, pg8::StaticOrder, true, true, true>(lds, g, S, E, tid); }
                SEAM;
                if (RUN) { ENV;
                    unsigned* head = (unsigned*)(ws + WS_CTL) + CW_Q + 64 * l;
                    unsigned nxt = (unsigned)bid;
                    for (;;) {
                        __syncthreads();
                        if (tid == 0) MISC[0] = nxt;
                        __syncthreads();
                        int it = (int)MISC[0];
                        if (it >= MIXC_ITEMS) break;
                        int tq = tid; asm volatile("" : "+v"(tq)); const int lq = tq & 63;
                        if (tid == 0) nxt = (unsigned)G + __hip_atomic_fetch_add(head, 1u, __ATOMIC_RELAXED, __HIP_MEMORY_SCOPE_AGENT);
                        unsigned* hc = (unsigned*)(ws + WS_CTL) + CW_HC + 64 * 16 * 4 * l; unsigned* kmc = hc, * kvc = hc + 64 * 16, * gtc = hc + 64 * 32, * scc = hc + 64 * 48; unsigned* tmo = (unsigned*)(ws + WS_CTL) + CW_TMO;
                        if (it < T_KM) kmean_item(it, Z, KM, kmc, lds, wave, lq);
                        else if (it < T_KV) kv_item(it - T_KM, Z, KV, kvc, lds, tq, wave, lq);
                        else if (it < T_GT) gate_item(it - T_KV, Z, KM, SEL, kmc, gtc, tmo, lds, tq, lq);
                        else if (it < T_SC) scan_item(it - T_GT, KV, PREV, kvc, scc, tmo, tq, lq);
                        else if (it < T_CV) conv_item(it - T_SC, Z, MIX, INP(8) + (size_t)l * 31 * 256, INP(9) + l * 256, INP(10) + l * 256, INP(11) + l * 256, lds, tq, wave, lq);
                        else if (it < T_G13) {
                            const int pm_ = it - T_CV;
                            if (l < WIN8_FROM) {
                            unsigned char* wb = ws + WS_W + (size_t)(l & 1) * WBUF_BYTES; pg8::Gemm g{XB, (const bf16*)(wb + WO_IN), M, ZNP, DM}; pg8::OneUnit S{pm_, ZN1 / 256};
                            pg8::EpiWin E{Z, (const LAS float*)(lds + LDSCTL_OFF + 1024), RT, MT};
                            { LAS float* rt_ = (LAS float*)(lds + LDSCTL_OFF + 1024); if (tq < 256) rt_[tq] = pg8::row_rstd(SSQ, pm_ * 256 + tq); __syncthreads(); }
                            pg8::gemm_phase<pg8::EpiWin, pg8::OneUnit, false, true>(lds, g, S, E, tq); }
                            else {
                            unsigned char* wb = ws + WS_W + (size_t)(l & 1) * WBUF_BYTES; pg8::Gemm g{(const bf16*)(ws + WS_X8), (const bf16*)(wb + WO_IN8), M, ZNP, DM / 2}; pg8::OneUnit S{pm_, ZN1 / 256};
                            pg8::EpiWin8 E{Z, (const LAS float*)(lds + LDSCTL_OFF + 1024), RT, MT, (const LAS float*)(lds + LDSCTL_OFF + 7168)};
                            { LAS float* rt_ = (LAS float*)(lds + LDSCTL_OFF + 1024); LAS float* ct_ = (LAS float*)(lds + LDSCTL_OFF + 7168);
                              if (tq < 256) { rt_[tq] = ((const float*)(ws + WS_RF))[pm_ * 256 + tq]; ct_[tq] = ((const float*)(wb + WO_SWIN))[ZN1 + tq]; } __syncthreads(); }
                            pg8::gemm_phase<pg8::EpiWin8, pg8::OneUnit, false, true, true>(lds, g, S, E, tq); } }
                        else if (it >= T_MB && it < T_RT) ret_item(it - T_MB, Z, PREV, MIX, scc, tmo, lds, tq, wave, lq);
                        else { int bh, j, i0, i1; bool own;
                            if (it < T_MB) { const int rank = (it - T_G13) / NBH; bh = (it - T_G13) - rank * NBH; i0 = 1; int rem = rank;
                                while (rem >= ((i0 - 1) >> 3) + 1) { rem -= ((i0 - 1) >> 3) + 1; ++i0; }
                                j = i0 - 1 - 8 * rem; i1 = (i0 + 8 < NCH) ? i0 + 8 : NCH; own = rem == 0; }
                            else { bh = it - T_RT; j = NCH - 1; i0 = NCH; i1 = NCH; own = true; }
                            moba_item(bh, j, own, i0, i1, Z, SEL, OP, LSE, gtc, tmo, lds, tq, wave, lq); }
                    }
                }
                SEAM;
                if (RUN) { ENV; { constexpr int NCMB = M * NHM * 8; const int st_ = G * 512;
                    for (int i = bid * 512 + tid; i < NCMB; i += 3 * st_) { CombIn c0, c1, c2; const int i1 = (i + st_ < NCMB) ? i + st_ : i, i2 = (i + 2 * st_ < NCMB) ? i + 2 * st_ : i;
                        combine_load(i, OP, LSE, SEL, c0); combine_load(i1, OP, LSE, SEL, c1); combine_load(i2, OP, LSE, SEL, c2);
                        combine_store(i, c0, MIX); combine_store(i1, c1, MIX); combine_store(i2, c2, MIX); } }
                    { constexpr int NRG = M * 2 * 8; const int st_ = G * 512; for (int i = bid * 512 + tid; i < NRG; i += 2 * st_) rgate_item2(i, (i + st_ < NRG) ? i + st_ : i, Z, MIX); } }
                SEAM;
                if (RUN) { ENV; unsigned char* wb = ws + WS_W + (size_t)(l & 1) * WBUF_BYTES; pg8::Gemm g{MIX, (const bf16*)(wb + WO_OUT), M, DM, DM}; pg8::StaticOrder S; S.init(M, DM, G, bid);
                    pg8::EpiRes E{XB, SSQ, 1.0f, 1.0f, (signed char*)(ws + WS_X8), (float*)(ws + WS_RF), (float*)(ws + WS_EX), (unsigned*)(ws + WS_CTL) + CW_PC + 16 * 64 * (3 * l + 1), (unsigned*)(ws + WS_CTL) + CW_TMO, nullptr, nullptr};
                    pg8::gemm_phase<pg8::EpiRes, pg8::StaticOrder, false, true>(lds, g, S, E, tid); }
                SEAM_LOCAL;
            }
        }
    }
#undef RUN
#undef SEAM
}

extern "C" void kernel_launch(void* const* d_in, const int* in_sizes, int n_in, void* d_out, int out_size, void* d_ws, size_t ws_size, hipStream_t stream) {
    static int grid = 0;
    if (grid == 0) {
        if (n_in != 18 || in_sizes[0] != M * DM || out_size != M * DM || ws_size < WS_END) { fprintf(stderr, "kernel_launch: unexpected problem shape (n_in %d, in0 %d, out %d, ws %zu); nothing launched\n", n_in, n_in > 0 ? in_sizes[0] : -1, out_size, ws_size); grid = -1; return; }
        int dev = 0, cus = 0, per_cu = 0;
        if (hipGetDevice(&dev) != hipSuccess || hipDeviceGetAttribute(&cus, hipDeviceAttributeMultiprocessorCount, dev) != hipSuccess) { grid = -1; return; }
        if (hipFuncSetAttribute((const void*)fwd, hipFuncAttributeMaxDynamicSharedMemorySize, LDS_BYTES) != hipSuccess) { fprintf(stderr, "kernel_launch: hipFuncSetAttribute failed\n"); grid = -1; return; }
        if (hipOccupancyMaxActiveBlocksPerMultiprocessor(&per_cu, (const void*)fwd, 512, LDS_BYTES) != hipSuccess || per_cu < 1) { fprintf(stderr, "kernel_launch: occupancy query reports %d blocks per CU\n", per_cu); }
        (void)hipGetLastError();
        grid = cus;
        if (grid != 256) fprintf(stderr, "kernel_launch: %d CUs; the N = 1024 GEMM phases assume a 256-workgroup grid\n", grid);
        if (grid > 256) grid = 256;
    }
    if (grid < 0) return;
    if (hipMemsetAsync((char*)d_ws + WS_CTL, 0, CTL_BYTES, stream) != hipSuccess) return;
    Args a{};
    for (int i = 0; i < 18; ++i) a.in[i] = (const float*)d_in[i];
    a.out = (float*)d_out; a.ws = (unsigned char*)d_ws;
    for (int i = 0; i < 32; ++i) { const float t = (float)i / 31.0f; a.invf[i] = (float)pow(10000.0, -(double)t); }
    for (int i = 0; i < 8; ++i) { const float t = (float)i / 8.0f; a.invf[32 + i] = (float)pow(500000.0, -(double)t); }
#if MK_PER_PHASE
    for (int p = 0; p < N_PHASES; ++p) { a.ph_lo = p; a.ph_hi = p + 1; hipLaunchKernelGGL(fwd, dim3(grid), dim3(512), LDS_BYTES, stream, a); }
#else
    a.ph_lo = 0; a.ph_hi = N_PHASES;
    hipLaunchKernelGGL(fwd, dim3(grid), dim3(512), LDS_BYTES, stream, a);
#endif
}
```

```cpp
#include <hip/hip_runtime.h>
#include <cstdio>
#include <cstdint>
#include <cmath>

constexpr int BATCH = 2, SEQ = 8192, DM = 1024, DEPTH = 4, HD = 64, NHM = 6;
constexpr int M = BATCH * SEQ, FF = 2816, NGU = 2 * FF, ZN = 3200, ZNP = 3328, ZP = ZNP, NCH = SEQ / 256, NBH = BATCH * NHM;
constexpr float RMS_EPS = 1e-6f;
constexpr float C2 = 0.125f * 1.4426950408889634f;
constexpr int Z_RQ = 0, Z_RK = 384, Z_MQ = 768, Z_MK = 1152, Z_RV = 1536, Z_MV = 1920, Z_CA = 2304, Z_CG = 2560, Z_RG = 2816;
constexpr int ZN1 = 3072;
constexpr int X_RET = 0, X_MOBA = 384, X_CONV = 768;

namespace pg8 {
#define PG8_LAS __attribute__((address_space(3)))
typedef unsigned short bf16_t;
typedef short bf16x8 __attribute__((ext_vector_type(8)));
typedef float f32x4 __attribute__((ext_vector_type(4)));
typedef unsigned u32x4 __attribute__((ext_vector_type(4)));
constexpr int BM = 256, BK = 64, HALF = 128, HTB = HALF * BK * 2  , STAGE_BYTES = 8 * HTB, NXCD = 8, WGM = 8;

__host__ __device__ __forceinline__ int lds_byte(int r, int c) { const int st = (r >> 4) * 2 + (c >> 5), rr = r & 15, cc = c & 31, ob = rr * 64 + cc * 2; return st * 1024 + (ob ^ (((ob >> 9) & 1) << 5)); }
__host__ __device__ __forceinline__ void stage_rc(int b, int& R, int& C) { const int st = b / 1024, sb = b % 1024, swz = sb ^ (((sb >> 9) & 1) << 5); R = (st >> 1) * 16 + swz / 64; C = (st & 1) * 32 + (swz % 64) / 2; }
__host__ __device__ __forceinline__ int perm32(int rho) { const int n = rho >> 4, i = rho & 15; return 8 * (i >> 2) + 4 * n + (i & 3); }

struct Unit { int pm, pn, ord; };
struct Gemm { const bf16_t* A; const bf16_t* Bt; int M, N, K; };

struct StaticOrder {
    int nM, nN, nwg, G, c;
    __host__ __device__ __forceinline__ void init(int M, int N, int G_, int c_) { nM = M / BM; nN = N / BM; nwg = nM * nN; G = G_; c = c_; }
    __host__ __device__ __forceinline__ bool next(int i, Unit& u) const {
        const long L = (long)i * G + c; if (L >= nwg) return false;
        int wgid = (int)L; { const int q = nwg / NXCD, r = nwg % NXCD, xcd = wgid % NXCD, off = wgid / NXCD; wgid = (xcd < r ? xcd * (q + 1) : r * (q + 1) + (xcd - r) * q) + off; }
        const int nig = WGM * nN, gid = wgid / nig, fm = gid * WGM, gsz = (nM - fm) < WGM ? (nM - fm) : WGM;
        u.pm = fm + ((wgid % nig) % gsz); u.pn = (wgid % nig) / gsz; u.ord = i; return true;
    }
    __device__ __forceinline__ void a_ready(const Unit&) const {}
    __device__ __forceinline__ void done(const Unit&) const {}
};

struct OneUnit { int pm, pn;
    __device__ __forceinline__ bool next(int i, Unit& u) const { if (i) return false; u.pm = pm; u.pn = pn; u.ord = 0; return true; }
    __device__ __forceinline__ void a_ready(const Unit&) const {}
    __device__ __forceinline__ void done(const Unit&) const {} };
__device__ __forceinline__ unsigned cvt_pk_bf16(float lo, float hi) { unsigned r; asm volatile("v_cvt_pk_bf16_f32 %0, %1, %2" : "=v"(r) : "v"(lo), "v"(hi)); return r; }
typedef float f32x2 __attribute__((ext_vector_type(2)));
typedef unsigned u32x2 __attribute__((ext_vector_type(2)));
typedef __bf16 bf16x2v __attribute__((ext_vector_type(2)));
__device__ __forceinline__ unsigned pkb(float lo, float hi) { const f32x2 v = {lo, hi}; const bf16x2v b = __builtin_convertvector(v, bf16x2v); return __builtin_bit_cast(unsigned, b); }
__device__ __forceinline__ float silu_f(float x) { return x * __builtin_amdgcn_rcpf(1.0f + __builtin_amdgcn_exp2f(-1.4426950408889634f * x)); }
__device__ __forceinline__ float row_rstd(const float* ssq, int row) { const f32x4 s = *(const f32x4*)(ssq + (size_t)row * 4); return __builtin_amdgcn_rsqf(((s[0] + s[1]) + (s[2] + s[3])) * (1.0f / 1024.0f) + RMS_EPS); }
struct EpiGU {
    static constexpr bool PERM = true, AFTER_DRAIN = false;
    bf16_t* act; const PG8_LAS float* rstab;
    __device__ __forceinline__ void operator()(const f32x4 (&acc)[2][2][4][2], const Unit& u, int wr, int wc, int fr, int fq) const {
        const int row0 = u.pm * BM + wr * 64 + fr, col0 = u.pn * HALF + wc * 32 + 8 * fq; const PG8_LAS float* T = rstab + u.ord * 256 + wr * 64 + fr;
#pragma unroll
        for (int ai = 0; ai < 2; ++ai)
#pragma unroll
            for (int m = 0; m < 4; ++m) { const int row = row0 + ai * HALF + m * 16; const float rs = T[ai * HALF + m * 16];
                const f32x4 g0 = acc[ai][0][m][0] * rs, g1 = acc[ai][0][m][1] * rs, u0 = acc[ai][1][m][0] * rs, u1 = acc[ai][1][m][1] * rs;
                u32x4 w; w.x = pkb(silu_f(g0[0]) * u0[0], silu_f(g0[1]) * u0[1]); w.y = pkb(silu_f(g0[2]) * u0[2], silu_f(g0[3]) * u0[3]);
                w.z = pkb(silu_f(g1[0]) * u1[0], silu_f(g1[1]) * u1[1]); w.w = pkb(silu_f(g1[2]) * u1[2], silu_f(g1[3]) * u1[3]);
                *(u32x4*)(act + (size_t)row * FF + col0) = w; }
    }
};
typedef int i32x4e __attribute__((ext_vector_type(4)));
__device__ __forceinline__ f32x4 cvt_i4(const f32x4 a) { const i32x4e v = __builtin_bit_cast(i32x4e, a); return __builtin_convertvector(v, f32x4); }
struct EpiGU8 {
    static constexpr bool PERM = true, AFTER_DRAIN = false;
    bf16_t* act; const PG8_LAS float* rstab; const PG8_LAS float* ctab;
    __device__ __forceinline__ void operator()(const f32x4 (&acc)[2][2][4][2], const Unit& u, int wr, int wc, int fr, int fq) const {
        const int row0 = u.pm * BM + wr * 64 + fr, col0 = u.pn * HALF + wc * 32 + 8 * fq; const PG8_LAS float* T = rstab + u.ord * 256 + wr * 64 + fr;
        const PG8_LAS float* C = ctab + u.ord * 256 + wc * 32 + 8 * fq;
        const f32x4 sg0 = *(const PG8_LAS f32x4*)C, sg1 = *(const PG8_LAS f32x4*)(C + 4), su0 = *(const PG8_LAS f32x4*)(C + HALF), su1 = *(const PG8_LAS f32x4*)(C + HALF + 4);
#pragma unroll
        for (int ai = 0; ai < 2; ++ai)
#pragma unroll
            for (int m = 0; m < 4; ++m) { const int row = row0 + ai * HALF + m * 16; const float rs = T[ai * HALF + m * 16];
                const f32x4 g0 = cvt_i4(acc[ai][0][m][0]) * (sg0 * rs), g1 = cvt_i4(acc[ai][0][m][1]) * (sg1 * rs), u0 = cvt_i4(acc[ai][1][m][0]) * (su0 * rs), u1 = cvt_i4(acc[ai][1][m][1]) * (su1 * rs);
                u32x4 w; w.x = pkb(silu_f(g0[0]) * u0[0], silu_f(g0[1]) * u0[1]); w.y = pkb(silu_f(g0[2]) * u0[2], silu_f(g0[3]) * u0[3]);
                w.z = pkb(silu_f(g1[0]) * u1[0], silu_f(g1[1]) * u1[1]); w.w = pkb(silu_f(g1[2]) * u1[2], silu_f(g1[3]) * u1[3]);
                *(u32x4*)(act + (size_t)row * FF + col0) = w; }
    }
};
struct EpiWin {
    static constexpr bool PERM = true, AFTER_DRAIN = false;
    bf16_t* z; const PG8_LAS float* rstab; const float* RT; const float* MT;
    __device__ __forceinline__ void operator()(const f32x4 (&acc)[2][2][4][2], const Unit& u, int wr, int wc, int fr, int fq) const {
        const int row0 = u.pm * BM + wr * 64 + fr; const PG8_LAS float* T = rstab + u.ord * 256 + wr * 64 + fr;
        const int hc = (wc * 32 + 8 * fq) & 63;
        const bool rot_tile = u.pn < 6, use = (u.pn < 3) || (hc < 16);
        const float* tbase = (u.pn < 3) ? RT + hc : MT + (hc & 8); const int tpitch = (u.pn < 3) ? 64 : 16;
#pragma unroll
        for (int ai = 0; ai < 2; ++ai) {
            f32x4 t0[4], t1[4];
#pragma unroll
            for (int m = 0; m < 4; ++m) { t0[m] = (f32x4){1.f, 0.f, 1.f, 0.f}; t1[m] = t0[m]; }
            if (rot_tile) {
#pragma unroll
                for (int m = 0; m < 4; ++m) { const float* tb = tbase + (size_t)(row0 + ai * HALF + m * 16) * tpitch; t0[m] = *(const f32x4*)tb; t1[m] = *(const f32x4*)(tb + 4); }
#pragma unroll
                for (int m = 0; m < 4; ++m) { asm volatile("" : "+v"(t0[m]), "+v"(t1[m]));
                    t0[m] = use ? t0[m] : (f32x4){1.f, 0.f, 1.f, 0.f}; t1[m] = use ? t1[m] : (f32x4){1.f, 0.f, 1.f, 0.f}; } }
#pragma unroll
            for (int m = 0; m < 4; ++m) { const int row = row0 + ai * HALF + m * 16; const float rs = T[ai * HALF + m * 16];
#pragma unroll
                for (int bj = 0; bj < 2; ++bj) { const int colb = (2 * u.pn + bj) * HALF + wc * 32 + 8 * fq;
                    const f32x4 a = acc[ai][bj][m][0] * rs, b = acc[ai][bj][m][1] * rs; const f32x4 c0 = t0[m], c1 = t1[m]; f32x4 v0, v1;
                    v0[0] = a[0] * c0[0] - a[1] * c0[1]; v0[1] = a[1] * c0[0] + a[0] * c0[1]; v0[2] = a[2] * c0[2] - a[3] * c0[3]; v0[3] = a[3] * c0[2] + a[2] * c0[3];
                    v1[0] = b[0] * c1[0] - b[1] * c1[1]; v1[1] = b[1] * c1[0] + b[0] * c1[1]; v1[2] = b[2] * c1[2] - b[3] * c1[3]; v1[3] = b[3] * c1[2] + b[2] * c1[3];
                    u32x4 w; w.x = pkb(v0[0], v0[1]); w.y = pkb(v0[2], v0[3]); w.z = pkb(v1[0], v1[1]); w.w = pkb(v1[2], v1[3]);
                    *(u32x4*)(z + (size_t)row * ZP + colb) = w; } } }
    }
};
struct EpiWin8 {
    static constexpr bool PERM = true, AFTER_DRAIN = false;
    bf16_t* z; const PG8_LAS float* rstab; const float* RT; const float* MT; const PG8_LAS float* ctab;
    __device__ __forceinline__ void operator()(const f32x4 (&acc)[2][2][4][2], const Unit& u, int wr, int wc, int fr, int fq) const {
        const int row0 = u.pm * BM + wr * 64 + fr; const PG8_LAS float* T = rstab + u.ord * 256 + wr * 64 + fr;
        const int hc = (wc * 32 + 8 * fq) & 63;
        const bool rot_tile = u.pn < 6, use = (u.pn < 3) || (hc < 16);
        const float* tbase = (u.pn < 3) ? RT + hc : MT + (hc & 8); const int tpitch = (u.pn < 3) ? 64 : 16;
#pragma unroll
        for (int ai = 0; ai < 2; ++ai) {
            f32x4 t0[4], t1[4];
#pragma unroll
            for (int m = 0; m < 4; ++m) { t0[m] = (f32x4){1.f, 0.f, 1.f, 0.f}; t1[m] = t0[m]; }
            if (rot_tile) {
#pragma unroll
                for (int m = 0; m < 4; ++m) { const float* tb = tbase + (size_t)(row0 + ai * HALF + m * 16) * tpitch; t0[m] = *(const f32x4*)tb; t1[m] = *(const f32x4*)(tb + 4); }
#pragma unroll
                for (int m = 0; m < 4; ++m) { asm volatile("" : "+v"(t0[m]), "+v"(t1[m]));
                    t0[m] = use ? t0[m] : (f32x4){1.f, 0.f, 1.f, 0.f}; t1[m] = use ? t1[m] : (f32x4){1.f, 0.f, 1.f, 0.f}; } }
#pragma unroll
            for (int m = 0; m < 4; ++m) { const int row = row0 + ai * HALF + m * 16; const float rs = T[ai * HALF + m * 16];
#pragma unroll
                for (int bj = 0; bj < 2; ++bj) { const int colb = (2 * u.pn + bj) * HALF + wc * 32 + 8 * fq; const PG8_LAS float* C = ctab + u.ord * 256 + bj * HALF + wc * 32 + 8 * fq;
                    const f32x4 a = cvt_i4(acc[ai][bj][m][0]) * (*(const PG8_LAS f32x4*)C * rs), b = cvt_i4(acc[ai][bj][m][1]) * (*(const PG8_LAS f32x4*)(C + 4) * rs); const f32x4 c0 = t0[m], c1 = t1[m]; f32x4 v0, v1;
                    v0[0] = a[0] * c0[0] - a[1] * c0[1]; v0[1] = a[1] * c0[0] + a[0] * c0[1]; v0[2] = a[2] * c0[2] - a[3] * c0[3]; v0[3] = a[3] * c0[2] + a[2] * c0[3];
                    v1[0] = b[0] * c1[0] - b[1] * c1[1]; v1[1] = b[1] * c1[0] + b[0] * c1[1]; v1[2] = b[2] * c1[2] - b[3] * c1[3]; v1[3] = b[3] * c1[2] + b[2] * c1[3];
                    u32x4 w; w.x = pkb(v0[0], v0[1]); w.y = pkb(v0[2], v0[3]); w.z = pkb(v1[0], v1[1]); w.w = pkb(v1[2], v1[3]);
                    *(u32x4*)(z + (size_t)row * ZP + colb) = w; } } }
    }
};
__device__ __forceinline__ unsigned q8x4(float a, float b, float c, float d, float inv) {
    const float M_ = 12582912.0f; const unsigned ya = __float_as_uint(__builtin_fmaf(a, inv, M_)), yb = __float_as_uint(__builtin_fmaf(b, inv, M_)), yc = __float_as_uint(__builtin_fmaf(c, inv, M_)), yd = __float_as_uint(__builtin_fmaf(d, inv, M_));
    return __builtin_amdgcn_perm(yb, ya, 0x0c0c0400u) | __builtin_amdgcn_perm(yd, yc, 0x04000c0cu);
}
struct EpiRes {
    static constexpr bool PERM = true, AFTER_DRAIN = true;
    bf16_t* xb; float* ssq; float alpha, ralpha;
    signed char* x8; float* rf; float* ex; unsigned* pctr; unsigned* tmo; float* fout; const float* fgain;
    __device__ __forceinline__ void init(f32x4 (&acc)[2][2][4][2], const Unit& u, int wr, int wc, int fr, int fq) const {
        const int col0 = u.pn * BM + wc * 32 + 8 * fq;
#pragma unroll
        for (int ai = 0; ai < 2; ++ai)
#pragma unroll
            for (int m = 0; m < 4; ++m)
#pragma unroll
                for (int bj = 0; bj < 2; ++bj) { const u32x4 x4 = *(const u32x4*)(xb + (size_t)(u.pm * BM + ai * HALF + wr * 64 + m * 16 + fr) * DM + col0 + bj * HALF);
                    acc[ai][bj][m][0] = (f32x4){__uint_as_float(x4.x << 16), __uint_as_float(x4.x & 0xffff0000u), __uint_as_float(x4.y << 16), __uint_as_float(x4.y & 0xffff0000u)} * ralpha;
                    acc[ai][bj][m][1] = (f32x4){__uint_as_float(x4.z << 16), __uint_as_float(x4.z & 0xffff0000u), __uint_as_float(x4.w << 16), __uint_as_float(x4.w & 0xffff0000u)} * ralpha; }
    }
    __device__ __forceinline__ void fused(f32x4 (&acc)[2][2][4][2], const Unit& u, int wr, int wc, int fr, int fq, PG8_LAS unsigned char* lds, int wid, int lane) const {
        PG8_LAS float* P = (PG8_LAS float*)lds;
        PG8_LAS float* Q = P + 1024; PG8_LAS float* IV = P + 2048;
        const bool fin = fout != nullptr, q8 = x8 != nullptr || fin; unsigned* const pc = pctr + 16 * u.pm;
        const int col0 = u.pn * BM + wc * 32 + 8 * fq;
#pragma unroll
        for (int ai = 0; ai < 2; ++ai)
#pragma unroll
            for (int m = 0; m < 4; ++m) { const int r = ai * HALF + wr * 64 + m * 16 + fr; bf16_t* xp = xb + (size_t)(u.pm * BM + r) * DM + col0; float ss = 0.f, am = 0.f;
#pragma unroll
                for (int bj = 0; bj < 2; ++bj) { const f32x4 a0 = acc[ai][bj][m][0] * alpha, a1 = acc[ai][bj][m][1] * alpha;
                    ss += ((a0[0] * a0[0] + a0[1] * a0[1]) + (a0[2] * a0[2] + a0[3] * a0[3])) + ((a1[0] * a1[0] + a1[1] * a1[1]) + (a1[2] * a1[2] + a1[3] * a1[3]));
                    am = fmaxf(am, fmaxf(fmaxf(fmaxf(fabsf(a0[0]), fabsf(a0[1])), fmaxf(fabsf(a0[2]), fabsf(a0[3]))), fmaxf(fmaxf(fabsf(a1[0]), fabsf(a1[1])), fmaxf(fabsf(a1[2]), fabsf(a1[3])))));
                    u32x4 w; w.x = pkb(a0[0], a0[1]); w.y = pkb(a0[2], a0[3]); w.z = pkb(a1[0], a1[1]); w.w = pkb(a1[2], a1[3]); if (!fin) *(u32x4*)(xp + bj * HALF) = w; }
                ss += __shfl_xor(ss, 16); ss += __shfl_xor(ss, 32); am = fmaxf(am, __shfl_xor(am, 16)); am = fmaxf(am, __shfl_xor(am, 32));
                if (fq == 0) { P[r * 4 + wc] = ss; Q[r * 4 + wc] = am; } }
        __syncthreads();
        const int tid = wid * 64 + lane;
        if (tid < 256) { const f32x4 p = *(const PG8_LAS f32x4*)(P + tid * 4); const float ts = (p[0] + p[1]) + (p[2] + p[3]); ssq[(size_t)(u.pm * BM + tid) * 4 + u.pn] = ts;
            if (q8) { const f32x4 q = *(const PG8_LAS f32x4*)(Q + tid * 4); float* e = ex + ((size_t)(u.pm * BM + tid) * 4 + u.pn) * 2;
                __hip_atomic_store(e, ts, __ATOMIC_RELAXED, __HIP_MEMORY_SCOPE_AGENT); __hip_atomic_store(e + 1, fmaxf(fmaxf(q[0], q[1]), fmaxf(q[2], q[3])), __ATOMIC_RELAXED, __HIP_MEMORY_SCOPE_AGENT); } }
        if (q8) {
            if (wid < 4) { asm volatile("s_waitcnt vmcnt(0)" ::: "memory"); if (lane == 0) __hip_atomic_fetch_add(pc, 1u, __ATOMIC_RELAXED, __HIP_MEMORY_SCOPE_AGENT); }
            if (tid == 0) { unsigned sp = 0u; while (__hip_atomic_load(pc, __ATOMIC_RELAXED, __HIP_MEMORY_SCOPE_AGENT) < 16u) { __builtin_amdgcn_s_sleep(1); if (++sp > (1u << 22)) { __hip_atomic_store(tmo, 1u, __ATOMIC_RELAXED, __HIP_MEMORY_SCOPE_AGENT); break; } } }
            __syncthreads();
            if (tid < 256) { const float* e = ex + (size_t)(u.pm * BM + tid) * 8; float s4 = 0.f, a4 = 0.f;
#pragma unroll
                for (int k = 0; k < 4; ++k) { s4 += __hip_atomic_load(e + 2 * k, __ATOMIC_RELAXED, __HIP_MEMORY_SCOPE_AGENT); a4 = fmaxf(a4, __hip_atomic_load(e + 2 * k + 1, __ATOMIC_RELAXED, __HIP_MEMORY_SCOPE_AGENT)); }
                IV[tid] = fin ? __builtin_amdgcn_rsqf(s4 * (1.0f / 1024.0f) + RMS_EPS) : (a4 > 0.f ? 127.0f / a4 : 0.f);
                if (u.pn == 0 && !fin) rf[u.pm * BM + tid] = __builtin_amdgcn_rsqf(s4 * (1.0f / 1024.0f) + RMS_EPS) * a4 * (1.0f / 127.0f); }
            __syncthreads();
            if (fin) {
                f32x4 gn[2][2];
#pragma unroll
                for (int bj = 0; bj < 2; ++bj) { gn[bj][0] = *(const f32x4*)(fgain + col0 + bj * HALF); gn[bj][1] = *(const f32x4*)(fgain + col0 + bj * HALF + 4); }
#pragma unroll
                for (int ai = 0; ai < 2; ++ai)
#pragma unroll
                    for (int m = 0; m < 4; ++m) { const int r = ai * HALF + wr * 64 + m * 16 + fr; const float rs = IV[r] * alpha; float* op = fout + (size_t)(u.pm * BM + r) * DM + col0;
#pragma unroll
                        for (int bj = 0; bj < 2; ++bj) { *(f32x4*)(op + bj * HALF) = acc[ai][bj][m][0] * rs * gn[bj][0]; *(f32x4*)(op + bj * HALF + 4) = acc[ai][bj][m][1] * rs * gn[bj][1]; } }
                return; }
#pragma unroll
            for (int ai = 0; ai < 2; ++ai)
#pragma unroll
                for (int m = 0; m < 4; ++m) { const int r = ai * HALF + wr * 64 + m * 16 + fr; const float inv = IV[r] * alpha; signed char* qp = x8 + (size_t)(u.pm * BM + r) * DM + col0;
#pragma unroll
                    for (int bj = 0; bj < 2; ++bj) { const f32x4 a0 = acc[ai][bj][m][0], a1 = acc[ai][bj][m][1]; u32x2 w; w.x = q8x4(a0[0], a0[1], a0[2], a0[3], inv); w.y = q8x4(a1[0], a1[1], a1[2], a1[3], inv); *(u32x2*)(qp + bj * HALF) = w; } }
        }
    }
};

typedef int i32x4 __attribute__((ext_vector_type(4)));
template <bool I8> __device__ __forceinline__ f32x4 mma16(const bf16x8 a, const bf16x8 b, const f32x4 c) {
    if constexpr (I8) return __builtin_bit_cast(f32x4, __builtin_amdgcn_mfma_i32_16x16x64_i8(__builtin_bit_cast(i32x4, a), __builtin_bit_cast(i32x4, b), __builtin_bit_cast(i32x4, c), 0, 0, 0));
    else return __builtin_amdgcn_mfma_f32_16x16x32_bf16(a, b, c, 0, 0, 0);
}
template <class Epi, class Sched, bool ALIGN_EPI = false, bool SP2 = false, bool I8 = false>
__device__ __forceinline__ void gemm_phase(PG8_LAS unsigned char* lds, const Gemm g, const Sched& S, const Epi& E, const int tid) {
    const int wid = __builtin_amdgcn_readfirstlane(tid >> 6), lane = tid & 63, wr = wid >> 2, wc = wid & 3, fr = lane & 15, fq = lane >> 4;
    const int K = g.K, nt = K / BK;
    unsigned voffA[2], voffB[2];
#pragma unroll
    for (int i = 0; i < 2; ++i) { int R, C; stage_rc(tid * 16 + i * 8192, R, C); const int Rb = Epi::PERM ? ((R & ~31) + perm32(R & 31)) : R;
        voffA[i] = (unsigned)(R * K + C) * 2u; voffB[i] = (unsigned)(Rb * K + C) * 2u; }
    const size_t kstep = (size_t)(BK * 2);
    const size_t hstep = (size_t)HALF * K * 2;
    const size_t tstep = 2 * hstep;
    const unsigned ldsw = (unsigned)wid * 1024u;
    const int aoff = lds_byte(wr * 64 + fr, fq * 8), boff = lds_byte(wc * 32 + fr, fq * 8);
#define PG8_SA(b, h) (((b) * 2 + (h)) * HTB)
#define PG8_SB(b, h) ((4 + (b) * 2 + (h)) * HTB)
#define PG8_STAGE(bufoff, gbase, voff) do { const char* gb_ = (const char*)(gbase); asm volatile("" : "+s"(gb_));     \
        _Pragma("unroll") for (int _i = 0; _i < 2; ++_i) { unsigned vo_ = (voff)[_i]; asm volatile("" : "+v"(vo_)); \
        __builtin_amdgcn_global_load_lds((const unsigned*)(gb_ + vo_), (PG8_LAS unsigned*)(lds + (bufoff) + ldsw + _i * 8192), 16, 0, 0); } } while (0)
#define PG8_LDA(dst, b, h) do { _Pragma("unroll") for (int m = 0; m < 4; ++m) _Pragma("unroll") for (int k = 0; k < 2; ++k) dst[m][k] = *(const PG8_LAS bf16x8*)(lds + PG8_SA(b, h) + aoff + m * 2048 + k * 1024); } while (0)
#define PG8_LDB(dst, b, h) do { _Pragma("unroll") for (int n = 0; n < 2; ++n) _Pragma("unroll") for (int k = 0; k < 2; ++k) dst[n][k] = *(const PG8_LAS bf16x8*)(lds + PG8_SB(b, h) + boff + n * 2048 + k * 1024); } while (0)
#define PG8_MMA(ai, bj, At, Bt) do { __builtin_amdgcn_s_setprio(1); _Pragma("unroll") for (int m = 0; m < 4; ++m) _Pragma("unroll") for (int n = 0; n < 2; ++n) _Pragma("unroll") for (int k = 0; k < 2; ++k) \
        acc[ai][bj][m][n] = mma16<I8>(Bt[n][k], At[m][k], acc[ai][bj][m][n]); __builtin_amdgcn_s_setprio(0); } while (0)
#define PG8_WAIT_V(n) asm volatile("s_waitcnt vmcnt(" #n ")" ::: "memory")
#define PG8_WAIT_L(n) asm volatile("s_waitcnt lgkmcnt(" #n ")" ::: "memory")
#define PG8_BAR __builtin_amdgcn_s_barrier()
#define PG8_SCHED __builtin_amdgcn_sched_barrier(0)
    Unit cur, nxt; int ui = 0;
    if (!S.next(0, cur)) return;
    f32x4 acc[2][2][4][2];
    if constexpr (Epi::AFTER_DRAIN) E.init(acc, cur, wr, wc, fr, fq);
    else {
#pragma unroll
    for (int a = 0; a < 2; ++a)
#pragma unroll
        for (int b = 0; b < 2; ++b)
#pragma unroll
            for (int m = 0; m < 4; ++m)
#pragma unroll
                for (int n = 0; n < 2; ++n) acc[a][b][m][n] = (f32x4){0.f, 0.f, 0.f, 0.f};
    }
    bf16x8 At[4][2], B0[2][2], B1[2][2];
    const char* cA = (const char*)g.A + (size_t)cur.pm * tstep; const char* cB = (const char*)g.Bt + (size_t)cur.pn * tstep;
    S.a_ready(cur);
    if constexpr (SP2) {
        PG8_STAGE(PG8_SB(0, 0), cB, voffB); PG8_STAGE(PG8_SB(0, 1), cB + hstep, voffB); PG8_STAGE(PG8_SA(0, 0), cA, voffA); PG8_STAGE(PG8_SA(0, 1), cA + hstep, voffA);
        if (wr == 1) PG8_BAR;
        PG8_WAIT_V(2); PG8_BAR;
        PG8_STAGE(PG8_SB(1, 0), cB + kstep, voffB); PG8_STAGE(PG8_SA(1, 0), cA + kstep, voffA); PG8_STAGE(PG8_SB(1, 1), cB + hstep + kstep, voffB);
        PG8_WAIT_V(6); PG8_BAR;
    } else {
        PG8_STAGE(PG8_SB(0, 0), cB, voffB); PG8_STAGE(PG8_SA(0, 0), cA, voffA); PG8_STAGE(PG8_SB(0, 1), cB + hstep, voffB); PG8_STAGE(PG8_SA(0, 1), cA + hstep, voffA);
        if (wr == 1) PG8_BAR;
        PG8_WAIT_V(4); PG8_BAR;
        PG8_STAGE(PG8_SB(1, 0), cB + kstep, voffB); PG8_STAGE(PG8_SA(1, 0), cA + kstep, voffA); PG8_STAGE(PG8_SB(1, 1), cB + hstep + kstep, voffB);
        PG8_WAIT_V(6); PG8_BAR;
    }
    for (;;) {
        const bool has_next = S.next(ui + 1, nxt);
        const char* nA = has_next ? (const char*)g.A + (size_t)nxt.pm * tstep : cA; const char* nB = has_next ? (const char*)g.Bt + (size_t)nxt.pn * tstep : cB;
        for (int t = 0; t < nt; t += 2) {
            const bool last = (t == nt - 2);
            const char* a1 = cA + (size_t)(t + 1) * kstep;
            const char* a2 = last ? nA : cA + (size_t)(t + 2) * kstep; const char* b2 = last ? nB : cB + (size_t)(t + 2) * kstep;
            const char* a3 = a2 + kstep; const char* b3 = b2 + kstep;
            if (last && has_next) S.a_ready(nxt);
            if constexpr (SP2) {
            PG8_LDB(B0, 0, 0); PG8_LDB(B1, 0, 1); PG8_SCHED; PG8_LDA(At, 0, 0); PG8_STAGE(PG8_SA(1, 1), a1 + hstep, voffA);
            PG8_WAIT_V(8); PG8_WAIT_L(0); PG8_BAR; PG8_MMA(0, 0, At, B0); PG8_MMA(0, 1, At, B1); PG8_BAR; PG8_SCHED;
            PG8_LDA(At, 0, 1); PG8_STAGE(PG8_SB(0, 0), b2, voffB); PG8_STAGE(PG8_SB(0, 1), b2 + hstep, voffB); PG8_STAGE(PG8_SA(0, 0), a2, voffA);
            PG8_WAIT_V(8); PG8_WAIT_L(0); PG8_BAR; PG8_MMA(1, 0, At, B0); PG8_MMA(1, 1, At, B1); PG8_BAR; PG8_SCHED;
            PG8_LDB(B0, 1, 0); PG8_LDB(B1, 1, 1); PG8_SCHED; PG8_LDA(At, 1, 0); PG8_STAGE(PG8_SA(0, 1), a2 + hstep, voffA);
            PG8_WAIT_V(8); PG8_WAIT_L(0); PG8_BAR; PG8_MMA(0, 0, At, B0); PG8_MMA(0, 1, At, B1); PG8_BAR; PG8_SCHED;
            PG8_LDA(At, 1, 1); PG8_STAGE(PG8_SB(1, 0), b3, voffB); PG8_STAGE(PG8_SB(1, 1), b3 + hstep, voffB); PG8_STAGE(PG8_SA(1, 0), a3, voffA);
            PG8_WAIT_V(8); PG8_WAIT_L(0); PG8_BAR; PG8_MMA(1, 0, At, B0); PG8_MMA(1, 1, At, B1); PG8_BAR; PG8_SCHED;
            } else {
            PG8_LDB(B0, 0, 0); PG8_SCHED; PG8_LDA(At, 0, 0); PG8_STAGE(PG8_SA(1, 1), a1 + hstep, voffA);
            PG8_WAIT_L(8); PG8_BAR; PG8_WAIT_L(0); PG8_MMA(0, 0, At, B0); PG8_BAR; PG8_SCHED;
            PG8_LDB(B1, 0, 1); PG8_STAGE(PG8_SB(0, 0), b2, voffB);
            PG8_BAR; PG8_WAIT_L(0); PG8_MMA(0, 1, At, B1); PG8_BAR;
            PG8_LDA(At, 0, 1); PG8_STAGE(PG8_SA(0, 0), a2, voffA);
            PG8_BAR; PG8_WAIT_L(0); PG8_MMA(1, 0, At, B0); PG8_BAR; PG8_SCHED;
            PG8_STAGE(PG8_SB(0, 1), b2 + hstep, voffB);
            PG8_WAIT_V(6); PG8_BAR; PG8_MMA(1, 1, At, B1); PG8_BAR;
            PG8_LDB(B0, 1, 0); PG8_SCHED; PG8_LDA(At, 1, 0); PG8_STAGE(PG8_SA(0, 1), a2 + hstep, voffA);
            PG8_WAIT_L(8); PG8_BAR; PG8_WAIT_L(0); PG8_MMA(0, 0, At, B0); PG8_BAR; PG8_SCHED;
            PG8_LDB(B1, 1, 1); PG8_STAGE(PG8_SB(1, 0), b3, voffB);
            PG8_BAR; PG8_WAIT_L(0); PG8_MMA(0, 1, At, B1); PG8_BAR;
            PG8_LDA(At, 1, 1); PG8_STAGE(PG8_SA(1, 0), a3, voffA);
            PG8_BAR; PG8_WAIT_L(0); PG8_MMA(1, 0, At, B0); PG8_BAR; PG8_SCHED;
            PG8_STAGE(PG8_SB(1, 1), b3 + hstep, voffB);
            PG8_WAIT_V(6); PG8_BAR; PG8_MMA(1, 1, At, B1); PG8_BAR;
            }
        }
        if constexpr (ALIGN_EPI) { if (wr == 0) PG8_BAR; }
        if constexpr (!Epi::AFTER_DRAIN) { E(acc, cur, wr, wc, fr, fq); S.done(cur); }
        if (!has_next) break;
#pragma unroll
        for (int a = 0; a < 2; ++a)
#pragma unroll
            for (int b = 0; b < 2; ++b)
#pragma unroll
                for (int m = 0; m < 4; ++m)
#pragma unroll
                    for (int n = 0; n < 2; ++n) acc[a][b][m][n] = (f32x4){0.f, 0.f, 0.f, 0.f};
        cur = nxt; cA = nA; cB = nB; ++ui;
        if constexpr (ALIGN_EPI) { if (wr == 1) PG8_BAR; }
    }
    PG8_WAIT_V(0);
    if constexpr (!ALIGN_EPI) { if (wr == 0) PG8_BAR; }
    PG8_BAR;
    if constexpr (Epi::AFTER_DRAIN) { E.fused(acc, cur, wr, wc, fr, fq, lds, wid, lane); S.done(cur); }
#undef PG8_SA
#undef PG8_SB
#undef PG8_STAGE
#undef PG8_LDA
#undef PG8_LDB
#undef PG8_MMA
#undef PG8_WAIT_V
#undef PG8_WAIT_L
#undef PG8_BAR
#undef PG8_SCHED
}
}
constexpr size_t KiB = 1024, MiB = 1u << 20;
constexpr size_t WS_CTL = 0, CTL_BYTES = 1 * MiB;
constexpr size_t WS_W = 1 * MiB, WBUF_BYTES = 42 * MiB;
constexpr size_t WO_GU1 = 0, WO_D1 = 11 * MiB, WO_IN = 16896 * KiB, WO_OUT = 23 * MiB, WO_GU2 = 25 * MiB, WO_D2 = 36 * MiB;
constexpr size_t WS_XB = 85 * MiB;
constexpr size_t WS_Z = 117 * MiB;
constexpr size_t WS_MIX = 221 * MiB;
constexpr size_t WS_ACT = 253 * MiB;
constexpr size_t WS_OP = 253 * MiB;
constexpr size_t WS_LSE = 301 * MiB;
constexpr size_t WS_SEL = 303 * MiB;
constexpr size_t WS_KV = 304 * MiB;
constexpr size_t WS_PREV = 310 * MiB;
constexpr size_t WS_KM = 313 * MiB;
constexpr size_t WS_RT = 341 * MiB, WS_MT = 345 * MiB;
constexpr size_t WS_SSQ = 346 * MiB;
constexpr size_t WS_X8 = 347 * MiB;
constexpr size_t WS_RF = 363 * MiB;
constexpr size_t WS_EX = WS_RF + 512 * KiB;
constexpr size_t WS_END = 364 * MiB;
constexpr size_t WO_IN8 = 7 * MiB, WO_SWIN = 10752 * KiB;
constexpr size_t WO_SW = 6 * MiB;
static_assert(WS_KM + 1 * MiB <= WS_ACT + 88 * MiB && WS_ACT + 88 * MiB <= WS_RT, "d_ws map");
constexpr int CW_TMO = 8, CW_XT = 1024  , CW_LB = 2048  , CW_BAR = 4096, CW_Q = 16384, CW_HC = 32768, CW_PC = 65536  ;

constexpr int RING_BYTES = 131072, LDSCTL_OFF = RING_BYTES, MISC_OFF = LDSCTL_OFF + 320, LDS_BYTES = 147456;

#define LAS __attribute__((address_space(3)))
#define GAS __attribute__((address_space(1)))
typedef unsigned short bf16;
typedef unsigned u32x4 __attribute__((ext_vector_type(4)));
typedef unsigned u32x2 __attribute__((ext_vector_type(2)));
typedef float f32x4 __attribute__((ext_vector_type(4)));
typedef float f32x2 __attribute__((ext_vector_type(2)));
typedef float f32x16 __attribute__((ext_vector_type(16)));
typedef short bf16x8 __attribute__((ext_vector_type(8)));
typedef short s16x4 __attribute__((ext_vector_type(4)));
typedef short v4i16_t __attribute__((ext_vector_type(4)));
typedef __bf16 bf16x2_t __attribute__((ext_vector_type(2)));
#define LDS_WAIT() asm volatile("s_waitcnt lgkmcnt(0)" ::: "memory")
__device__ __forceinline__ unsigned pk2(float lo, float hi) { const f32x2 v = {lo, hi}; const bf16x2_t b = __builtin_convertvector(v, bf16x2_t); return __builtin_bit_cast(unsigned, b); }
__device__ __forceinline__ float bflo(unsigned w) { return __uint_as_float(w << 16); }
__device__ __forceinline__ float bfhi(unsigned w) { return __uint_as_float(w & 0xffff0000u); }
__device__ __forceinline__ float ex2(float x) { return __builtin_amdgcn_exp2f(x); }
__device__ __forceinline__ float silu1(float x) { return x * __builtin_amdgcn_rcpf(1.0f + ex2(-1.4426950408889634f * x)); }
__device__ __forceinline__ float sigm1(float x) { return __builtin_amdgcn_rcpf(1.0f + ex2(-1.4426950408889634f * x)); }
__device__ __forceinline__ float wave_sum(float v) {
#pragma unroll
    for (int o = 1; o < 64; o <<= 1) v += __shfl_xor(v, o);
    return v;
}
__device__ __forceinline__ f32x16 mfma32(bf16x8 a, bf16x8 b, f32x16 c) { return __builtin_amdgcn_mfma_f32_32x32x16_bf16(a, b, c, 0, 0, 0); }
__device__ __forceinline__ int crow(int i, int h) { return (i & 3) + 8 * (i >> 2) + 4 * h; }
__device__ __forceinline__ s16x4 vtr(LAS const unsigned char* p) { return __builtin_bit_cast(s16x4, __builtin_amdgcn_ds_read_tr16_b64_v4i16((LAS v4i16_t*)p)); }
__device__ __forceinline__ bf16x8 cat8(s16x4 lo, s16x4 hi) { return __builtin_shufflevector(lo, hi, 0, 1, 2, 3, 4, 5, 6, 7); }
__device__ __forceinline__ bf16x8 ldsrow(LAS const unsigned char* p) { return *(const LAS bf16x8*)p; }
__device__ __forceinline__ f32x16 zero16() { f32x16 z;
#pragma unroll
    for (int i = 0; i < 16; ++i) z[i] = 0.f;
    return z; }
__device__ __forceinline__ bf16x8 pack8(const f32x16& x, int s) {
    u32x4 p; p.x = pk2(x[8 * s], x[8 * s + 1]); p.y = pk2(x[8 * s + 2], x[8 * s + 3]); p.z = pk2(x[8 * s + 4], x[8 * s + 5]); p.w = pk2(x[8 * s + 6], x[8 * s + 7]);
    return __builtin_bit_cast(bf16x8, p);
}
constexpr int PIT = 144;
constexpr int IMG = 256 * PIT;
template <int NR> __device__ __forceinline__ void stage64(LAS unsigned char* dst, const bf16* src, int gp, int tid) {
    constexpr int N = (NR * 8 + 511) / 512; u32x4 v[N];
#pragma unroll
    for (int i = 0; i < N; ++i) { const int c = tid + 512 * i, row = c >> 3, ch = c & 7; if (NR * 8 % 512 == 0 || c < NR * 8) v[i] = *(const u32x4*)(src + (size_t)row * gp + ch * 8); }
#pragma unroll
    for (int i = 0; i < N; ++i) { const int c = tid + 512 * i, row = c >> 3, ch = c & 7; if (NR * 8 % 512 == 0 || c < NR * 8) *(LAS u32x4*)(dst + row * PIT + ch * 16) = v[i]; }
}

template <int NI> __device__ __forceinline__ void stage256n(LAS unsigned char* const (&dst)[NI], const bf16* const (&src)[NI], int gp, int tid) {
    u32x4 v[NI][4];
#pragma unroll
    for (int k = 0; k < NI; ++k)
#pragma unroll
        for (int i = 0; i < 4; ++i) { const int c = tid + 512 * i, row = c >> 3, ch = c & 7; v[k][i] = *(const u32x4*)(src[k] + (size_t)row * gp + ch * 8); }
#pragma unroll
    for (int k = 0; k < NI; ++k)
#pragma unroll
        for (int i = 0; i < 4; ++i) { const int c = tid + 512 * i, row = c >> 3, ch = c & 7; *(LAS u32x4*)(dst[k] + row * PIT + ch * 16) = v[k][i]; }
}

__device__ __forceinline__ void sincos_acc(float angf, float& c, float& s) {
    const double a = (double)angf, kq = rint(a * 0.63661977236758134308), r = a - kq * 1.57079632679489661923, r2 = r * r;
    const double sn = r * (1.0 + r2 * (-1.0 / 6.0 + r2 * (1.0 / 120.0 + r2 * (-1.0 / 5040.0 + r2 * (1.0 / 362880.0 + r2 * (-1.0 / 39916800.0))))));
    const double cs = 1.0 + r2 * (-0.5 + r2 * (1.0 / 24.0 + r2 * (-1.0 / 720.0 + r2 * (1.0 / 40320.0 + r2 * (-1.0 / 3628800.0 + r2 * (1.0 / 479001600.0))))));
    const int q = ((int)kq) & 3;
    const double cc = (q == 0) ? cs : (q == 1) ? -sn : (q == 2) ? -cs : sn, ssv = (q == 0) ? sn : (q == 1) ? cs : (q == 2) ? -sn : -cs;
    c = (float)cc; s = (float)ssv;
}
__device__ __forceinline__ int cvt_tgt(int mode, int c, float& sc) {
    sc = 1.f;
    if (mode == 0) return c;
    if (mode == 1) return 256 * (c >> 7) + (c & 127);
    if (mode == 2) return 256 * (c >> 7) + 128 + (c & 127);
    if (c < 768) { const int sec = c >= 384, w = c - 384 * sec, hh = w >> 6, o = w & 63; if (sec) sc = 0.125f; return (sec ? Z_RK : Z_RQ) + hh * 64 + (o < 32 ? 2 * o : 2 * (o - 32) + 1); }
    if (c < 1152) return Z_RV + (c - 768);
    if (c < 1536) return Z_RG + (c - 1152);
    if (c < 2304) { const int sec = c >= 1920, w = c - 1536 - 384 * sec, hh = w >> 6, o = w & 63; if (!sec) sc = C2; return (sec ? Z_MK : Z_MQ) + hh * 64 + (o < 8 ? 2 * o : o < 16 ? 2 * (o - 8) + 1 : o); }
    if (c < 2688) return Z_MV + (c - 2304);
    if (c < 2944) return Z_CA + (c - 2688);
    return Z_CG + (c - 2944);
}
__device__ __forceinline__ void cvt_item(const float* W, const float* gain, bf16* dst, int K, int NS, int mode, int item, LAS float* scr, int lane) {
    const int nblk = NS >> 5, kb = item / nblk, nb = item - kb * nblk, k0 = kb << 6, c0 = nb << 5;
    const int ksub = lane >> 3, n4 = lane & 7;
    f32x4 v[8]; float gv[8];
#pragma unroll
    for (int i = 0; i < 8; ++i) v[i] = *(const f32x4*)(W + (size_t)(k0 + ksub + 8 * i) * NS + c0 + 4 * n4);
#pragma unroll
    for (int i = 0; i < 8; ++i) gv[i] = gain ? gain[k0 + ksub + 8 * i] : 1.f;
    float sc; (void)cvt_tgt(mode, c0, sc);
#pragma unroll
    for (int i = 0; i < 8; ++i) { const float g = gv[i] * sc; LAS float* s = scr + (ksub + 8 * i) * 33 + 4 * n4; s[0] = v[i][0] * g; s[1] = v[i][1] * g; s[2] = v[i][2] * g; s[3] = v[i][3] * g; }
    LDS_WAIT(); asm volatile("" ::: "memory");
    const int c = lane & 7;
#pragma unroll
    for (int j = 0; j < 4; ++j) { const int n = (lane >> 3) + 8 * j; const LAS float* s = scr + (8 * c) * 33 + n; float dummy;
        u32x4 o; o.x = pk2(s[0 * 33], s[1 * 33]); o.y = pk2(s[2 * 33], s[3 * 33]); o.z = pk2(s[4 * 33], s[5 * 33]); o.w = pk2(s[6 * 33], s[7 * 33]);
        *(u32x4*)(dst + (size_t)cvt_tgt(mode, c0 + n, dummy) * K + k0 + 8 * c) = o; }
    LDS_WAIT(); asm volatile("" ::: "memory");
}
__device__ __forceinline__ void cvt_q8_batch(const float* W, const float* gain, signed char* dst, float* SWt, int NS, int mode, int nb, LAS unsigned char* lds, int wave, int lane) {
    LAS float* scr = (LAS float*)(lds + wave * 16384); LAS float* red = (LAS float*)(lds + wave * 16384 + 12288);
    const int c0 = nb << 5, ksub = lane >> 3, n4 = lane & 7;
    f32x4 v[2][8]; float gv[2][8];
#pragma unroll
    for (int h = 0; h < 2; ++h)
#pragma unroll
        for (int i = 0; i < 8; ++i) v[h][i] = *(const f32x4*)(W + (size_t)(64 * (wave + 8 * h) + ksub + 8 * i) * NS + c0 + 4 * n4);
#pragma unroll
    for (int h = 0; h < 2; ++h)
#pragma unroll
        for (int i = 0; i < 8; ++i) gv[h][i] = gain[64 * (wave + 8 * h) + ksub + 8 * i];
    float sc0; (void)cvt_tgt(mode, c0, sc0);
    f32x4 am = {0.f, 0.f, 0.f, 0.f};
#pragma unroll
    for (int h = 0; h < 2; ++h)
#pragma unroll
        for (int i = 0; i < 8; ++i) { v[h][i] = v[h][i] * (gv[h][i] * sc0);
#pragma unroll
            for (int e = 0; e < 4; ++e) am[e] = fmaxf(am[e], fabsf(v[h][i][e])); }
#pragma unroll
    for (int o = 8; o < 64; o <<= 1)
#pragma unroll
        for (int e = 0; e < 4; ++e) am[e] = fmaxf(am[e], __shfl_xor(am[e], o));
    if (lane < 8) *(LAS f32x4*)(red + 4 * n4) = am;
    __syncthreads();
    f32x4 cm = {0.f, 0.f, 0.f, 0.f};
#pragma unroll
    for (int w = 0; w < 8; ++w) { const f32x4 t = *(const LAS f32x4*)(lds + w * 16384 + 12288 + 16 * n4);
#pragma unroll
        for (int e = 0; e < 4; ++e) cm[e] = fmaxf(cm[e], t[e]); }
    f32x4 inv;
#pragma unroll
    for (int e = 0; e < 4; ++e) inv[e] = cm[e] > 0.f ? 127.0f / cm[e] : 0.f;
    float dummy;
#pragma unroll
    for (int h = 0; h < 2; ++h) {
#pragma unroll
        for (int i = 0; i < 8; ++i) { LAS float* s = scr + (ksub + 8 * i) * 33 + 4 * n4;
#pragma unroll
            for (int e = 0; e < 4; ++e) s[e] = __builtin_rintf(v[h][i][e] * inv[e]); }
        LDS_WAIT(); asm volatile("" ::: "memory");
        const int c = lane & 7;
#pragma unroll
        for (int j = 0; j < 4; ++j) { const int n = (lane >> 3) + 8 * j; const LAS float* s = scr + (8 * c) * 33 + n; unsigned q[8];
#pragma unroll
            for (int t = 0; t < 8; ++t) q[t] = (unsigned)(int)s[t * 33] & 0xffu;
            u32x2 o; o.x = q[0] | (q[1] << 8) | (q[2] << 16) | (q[3] << 24); o.y = q[4] | (q[5] << 8) | (q[6] << 16) | (q[7] << 24);
            *(u32x2*)(dst + (size_t)cvt_tgt(mode, c0 + n, dummy) * DM + 64 * (wave + 8 * h) + 8 * c) = o; }
        LDS_WAIT(); asm volatile("" ::: "memory");
    }
    if (wave == 0 && lane < 8) {
#pragma unroll
        for (int e = 0; e < 4; ++e) SWt[cvt_tgt(mode, c0 + 4 * n4 + e, dummy)] = cm[e] * (1.0f / 127.0f); }
}
constexpr int I_D = (FF / 64) * (DM / 32), I_IN = (DM / 64) * (ZN / 32), I_OUT = (DM / 64) * (DM / 32);
constexpr int B_G = FF / 32, B_D = I_D / 8, B_IN = I_IN / 8, B_IN8 = ZN / 32, B_OUT = I_OUT / 8;
static_assert(I_D % 8 == 0 && I_IN % 8 == 0 && I_OUT % 8 == 0, "whole batches");
constexpr int WIN8_FROM = 0;
__host__ __device__ constexpr int b_in(int l) { return l >= WIN8_FROM ? B_IN8 : B_IN; }
constexpr int B_EARLY0 = 2 * B_G + B_D, B_LATE = 2 * B_G + B_D + B_OUT;
__host__ __device__ constexpr int b_early(int l) { return B_EARLY0 + b_in(l); }
__host__ __device__ constexpr int b_layer(int l) { return b_early(l) + B_LATE; }
struct Args { const float* in[18]; float* out; unsigned char* ws; float invf[40]; int ph_lo, ph_hi; };
#define AIN(k) ((const float*)(GAS const float*)A.in[(k) + zi])
__device__ __forceinline__ void cvt_layer_batch(const Args& A, int zi, int l, unsigned char* wb, int bt, LAS unsigned char* lds, int wave, int lane) {
    const size_t lgu = (size_t)l * DM * FF, lw = (size_t)l * DM; LAS float* scr = (LAS float*)(lds + wave * 16384);
    int r = bt;
    if (r < B_G) { cvt_q8_batch(AIN(3) + lgu, AIN(2) + lw, (signed char*)(wb + WO_GU1), (float*)(wb + WO_GU1 + WO_SW), FF, 1, r, lds, wave, lane); return; } r -= B_G;
    if (r < B_G) { cvt_q8_batch(AIN(4) + lgu, AIN(2) + lw, (signed char*)(wb + WO_GU1), (float*)(wb + WO_GU1 + WO_SW), FF, 2, r, lds, wave, lane); return; } r -= B_G;
    if (r < B_D) { cvt_item(AIN(5) + lgu, nullptr, (bf16*)(wb + WO_D1), FF, DM, 0, 8 * r + wave, scr, lane); return; } r -= B_D;
    if (r < b_in(l)) { if (l >= WIN8_FROM) cvt_q8_batch(AIN(7) + (size_t)l * DM * ZN, AIN(6) + lw, (signed char*)(wb + WO_IN8), (float*)(wb + WO_SWIN), ZN, 3, r, lds, wave, lane);
        else cvt_item(AIN(7) + (size_t)l * DM * ZN, AIN(6) + lw, (bf16*)(wb + WO_IN), DM, ZN, 3, 8 * r + wave, scr, lane); return; } r -= b_in(l);
    if (r < B_G) { cvt_q8_batch(AIN(14) + lgu, AIN(13) + lw, (signed char*)(wb + WO_GU2), (float*)(wb + WO_GU2 + WO_SW), FF, 1, r, lds, wave, lane); return; } r -= B_G;
    if (r < B_G) { cvt_q8_batch(AIN(15) + lgu, AIN(13) + lw, (signed char*)(wb + WO_GU2), (float*)(wb + WO_GU2 + WO_SW), FF, 2, r, lds, wave, lane); return; } r -= B_G;
    if (r < B_D) { cvt_item(AIN(16) + lgu, nullptr, (bf16*)(wb + WO_D2), FF, DM, 0, 8 * r + wave, scr, lane); return; } r -= B_D;
    cvt_item(AIN(12) + (size_t)l * DM * DM, nullptr, (bf16*)(wb + WO_OUT), DM, DM, 0, 8 * r + wave, scr, lane);
}
#define XB_TMO      128
#define XB_XCNT(j)  (256  + 64 * (j))
#define XB_XSUB(j)  (1280 + 64 * (j))
#define XB_XGEN(j)  (2304 + 64 * (j))
#define XB_TOP      3328
#define XB_TOPGEN   3392
#define XCD_BAR_WORDS 3456
#define XB_SPIN_CAP (1u << 18)

__device__ __forceinline__ unsigned xb_ld(unsigned* p)              { return __hip_atomic_load(p, __ATOMIC_RELAXED, __HIP_MEMORY_SCOPE_AGENT); }
__device__ __forceinline__ unsigned xb_add(unsigned* p, unsigned v) { return __hip_atomic_fetch_add(p, v, __ATOMIC_RELAXED, __HIP_MEMORY_SCOPE_AGENT); }
__device__ __forceinline__ unsigned xb_xcc_id() { return (unsigned)__builtin_amdgcn_s_getreg((3 << 11) | 20) & 0xFu; }
#define XB_SPIN(cond, bar) do { unsigned _sp = 0; while (cond) { __builtin_amdgcn_s_sleep(1); \
    if ((++_sp & 255u) == 0u) { if (xb_ld(&(bar)[XB_TMO])) break; if (_sp > XB_SPIN_CAP) { atomicAdd(&(bar)[XB_TMO], 1u); break; } } } } while (0)

struct XcdBarrier {
    unsigned* bar; unsigned x;
    volatile LAS unsigned* st;
};

__device__ __forceinline__ XcdBarrier xcd_barrier_post(unsigned* bar, volatile LAS unsigned* st) {
    XcdBarrier b; b.bar = bar; b.x = xb_xcc_id(); b.st = st;
    if (threadIdx.x == 0) (void)xb_add(&bar[XB_XCNT(b.x)], 1u);
    return b;
}
__device__ __forceinline__ void xcd_barrier_complete(unsigned* bar, unsigned x, unsigned& nloc, unsigned& nx) {
    const unsigned G = gridDim.x * gridDim.y * gridDim.z;
    unsigned sum, cnt, mine, sp = 0u;
    for (;;) {
        sum = 0u; cnt = 0u; mine = 0u;
#pragma unroll
        for (unsigned j = 0; j < 16; ++j) { const unsigned c = xb_ld(&bar[XB_XCNT(j)]); sum += c; cnt += (c > 0u) ? 1u : 0u; mine = (j == x) ? c : mine; }
        if (sum == G) break;
        __builtin_amdgcn_s_sleep(1);
        if ((++sp & 255u) == 0u) { if (xb_ld(&bar[XB_TMO])) break; if (sp > XB_SPIN_CAP) { atomicAdd(&bar[XB_TMO], 1u); break; } }
    }
    nloc = mine > 0u ? mine : 1u; nx = cnt > 0u ? cnt : 1u;
}

__device__ __forceinline__ void xcd_barrier(const XcdBarrier& b) {
    asm volatile("s_waitcnt vmcnt(0)" ::: "memory");
    __syncthreads();
    if (threadIdx.x == 0) {
        unsigned* bar = b.bar;
        __builtin_amdgcn_s_waitcnt(0);
        unsigned nloc = b.st[0], nx = b.st[1];
        if (nloc == 0u) { xcd_barrier_complete(bar, b.x, nloc, nx); b.st[0] = nloc; b.st[1] = nx; }
        const unsigned old = xb_add(&bar[XB_XSUB(b.x)], 1u);
        const unsigned gen = old / nloc;
        if (old + 1u == (gen + 1u) * nloc) {
            __builtin_amdgcn_fence(__ATOMIC_RELEASE, "agent");
            asm volatile("s_waitcnt vmcnt(0)" ::: "memory");
            const unsigned og = xb_add(&bar[XB_TOP], 1u);
            const unsigned tg = og / nx;
            if (og + 1u == (tg + 1u) * nx) xb_add(&bar[XB_TOPGEN], 1u);
            else XB_SPIN(xb_ld(&bar[XB_TOPGEN]) == tg, bar);
            __builtin_amdgcn_fence(__ATOMIC_ACQUIRE, "agent");
            xb_add(&bar[XB_XGEN(b.x)], 1u);
            asm volatile("s_waitcnt vmcnt(0)" ::: "memory");
        } else {
            XB_SPIN(xb_ld(&bar[XB_XGEN(b.x)]) == gen, bar);
            __builtin_amdgcn_fence(__ATOMIC_ACQUIRE, "agent");
            asm volatile("s_waitcnt vmcnt(0)" ::: "memory");
        }
    }
    __syncthreads();
}
__device__ __forceinline__ void xcd_local_barrier(unsigned* lb, unsigned x, unsigned nloc, unsigned* tmo) {
    asm volatile("s_waitcnt vmcnt(0)" ::: "memory");
    __syncthreads();
    if (threadIdx.x == 0) {
        __builtin_amdgcn_s_waitcnt(0);
        const unsigned old = xb_add(&lb[64 * x], 1u), gen = old / nloc;
        if (old + 1u == (gen + 1u) * nloc) xb_add(&lb[64 * (16 + x)], 1u);
        else { unsigned sp = 0u; while (xb_ld(&lb[64 * (16 + x)]) == gen) { __builtin_amdgcn_s_sleep(1); if (++sp > (1u << 22)) { __hip_atomic_store(tmo, 1u, __ATOMIC_RELAXED, __HIP_MEMORY_SCOPE_AGENT); break; } } }
        __builtin_amdgcn_fence(__ATOMIC_ACQUIRE, "agent");
        asm volatile("s_waitcnt vmcnt(0)" ::: "memory");
    }
    __syncthreads();
}
__device__ __forceinline__ void conv_item(int it, const bf16* z, bf16* mix, const float* cw, const float* cb, const float* lg, const float* lb, LAS unsigned char* lds, int tid, int wave, int lane) {
    LAS float* U = (LAS float*)lds;
    const int t0 = it * 64, s0 = t0 & (SEQ - 1);
    u32x4 av[6], gv[6];
#pragma unroll
    for (int i = 0; i < 6; ++i) { const int c = tid + 512 * i, row = c >> 5, ch = c & 31; av[i] = (u32x4){0u, 0u, 0u, 0u}; gv[i] = av[i];
        if (c < 94 * 32 && s0 - 30 + row >= 0) { const bf16* zr = z + (size_t)(t0 - 30 + row) * ZP; av[i] = *(const u32x4*)(zr + Z_CA + 8 * ch); gv[i] = *(const u32x4*)(zr + Z_CG + 8 * ch); } }
#pragma unroll
    for (int i = 0; i < 6; ++i) { const int c = tid + 512 * i, row = c >> 5, ch = c & 31; const u32x4 a = av[i], g = gv[i]; f32x4 o0, o1;
        o0[0] = bflo(a.x) * sigm1(bflo(g.x)); o0[1] = bfhi(a.x) * sigm1(bfhi(g.x)); o0[2] = bflo(a.y) * sigm1(bflo(g.y)); o0[3] = bfhi(a.y) * sigm1(bfhi(g.y));
        o1[0] = bflo(a.z) * sigm1(bflo(g.z)); o1[1] = bfhi(a.z) * sigm1(bfhi(g.z)); o1[2] = bflo(a.w) * sigm1(bflo(g.w)); o1[3] = bfhi(a.w) * sigm1(bfhi(g.w));
        if (c < 94 * 32) { *(LAS f32x4*)(U + row * 256 + 8 * ch) = o0; *(LAS f32x4*)(U + row * 256 + 8 * ch + 4) = o1; } }
    __syncthreads();
    const int g = wave & 3, half = wave >> 2, c = 64 * g + lane;
    float w[31];
#pragma unroll
    for (int j = 0; j < 31; ++j) w[j] = cw[j * 256 + c];
    const float bias = cb[c], gg = lg[c], bb = lb[c];
    float uw[62];
#pragma unroll
    for (int i = 0; i < 62; ++i) uw[i] = U[(32 * half + i) * 256 + c];
#pragma unroll
    for (int tb = 0; tb < 32; tb += 4) {
        float y[4], mu[4], var[4];
#pragma unroll
        for (int k = 0; k < 4; ++k) { y[k] = bias;
#pragma unroll
            for (int j = 0; j < 31; ++j) y[k] += w[j] * uw[tb + k + j]; }
#pragma unroll
        for (int k = 0; k < 4; ++k) mu[k] = y[k];
#pragma unroll
        for (int o = 1; o < 64; o <<= 1) {
#pragma unroll
            for (int k = 0; k < 4; ++k) mu[k] += __shfl_xor(mu[k], o); }
#pragma unroll
        for (int k = 0; k < 4; ++k) { mu[k] *= (1.f / 64.f); y[k] -= mu[k]; var[k] = y[k] * y[k]; }
#pragma unroll
        for (int o = 1; o < 64; o <<= 1) {
#pragma unroll
            for (int k = 0; k < 4; ++k) var[k] += __shfl_xor(var[k], o); }
#pragma unroll
        for (int k = 0; k < 4; ++k) { const float yn = y[k] * __builtin_amdgcn_rsqf(var[k] * (1.f / 64.f) + RMS_EPS) * gg + bb;
            mix[(size_t)(t0 + 32 * half + tb + k) * DM + X_CONV + c] = (bf16)(pk2(silu1(yn), 0.f) & 0xffffu); }
    }
    __syncthreads();
}
#define RLX_AGENT __ATOMIC_RELAXED, __HIP_MEMORY_SCOPE_AGENT
__device__ __forceinline__ void st_wt(float* p, float v) { __hip_atomic_store(p, v, RLX_AGENT); }
__device__ __forceinline__ void st_wt(unsigned* p, unsigned v) { __hip_atomic_store(p, v, RLX_AGENT); }
__device__ __forceinline__ void st_wt(unsigned long long* p, unsigned long long v) { __hip_atomic_store(p, v, RLX_AGENT); }
__device__ __forceinline__ float ld_wt(const float* p) { return __hip_atomic_load(p, RLX_AGENT); }
__device__ __forceinline__ unsigned ld_wt(const unsigned* p) { return __hip_atomic_load(p, RLX_AGENT); }
__device__ __forceinline__ unsigned long long ld_wt(const unsigned long long* p) { return __hip_atomic_load(p, RLX_AGENT); }
__device__ __forceinline__ void publish_wave(unsigned* ctr, int lane) { asm volatile("s_waitcnt vmcnt(0)" ::: "memory"); if (lane == 0) __hip_atomic_fetch_add(ctr, 1u, RLX_AGENT); }
__device__ __forceinline__ void wait_count(unsigned* ctr, unsigned need, unsigned* tmo, int tid) {
    if (tid == 0) { unsigned sp = 0u;
        while (__hip_atomic_load(ctr, RLX_AGENT) < need) { __builtin_amdgcn_s_sleep(2); if (++sp > (1u << 20)) { __hip_atomic_store(tmo, 1u, RLX_AGENT); break; } } }
    __syncthreads();
}
__device__ __forceinline__ void kv_item(int it2, const bf16* z, float* KV, unsigned* kvc, LAS unsigned char* lds, int tid, int wave, int lane) {
    const int team = wave >> 2, it = 2 * it2 + team, tt = tid & 255;
    const int bh = it >> 5, n = it & 31, b = bh / NHM, hh = bh - b * NHM; const size_t tok0 = (size_t)b * SEQ + 256 * n;
    const float lg2 = log2f(1.0f - ex2(-5.0f - (float)hh));
    LAS unsigned char* Ki = lds + team * 65536; LAS unsigned char* Vw = Ki + 32768;
    { u32x4 kk[8], vv[8];
#pragma unroll
    for (int i = 0; i < 8; ++i) { const int c = tt + 256 * i, row = c >> 3, ch = c & 7; kk[i] = *(const u32x4*)(z + (tok0 + row) * ZP + Z_RK + 64 * hh + ch * 8); vv[i] = *(const u32x4*)(z + (tok0 + row) * ZP + Z_RV + 64 * hh + ch * 8); }
#pragma unroll
    for (int i = 0; i < 8; ++i) { const int c = tt + 256 * i, row = c >> 3, ch = c & 7; const u32x4 v = vv[i];
        const float wg = ex2((float)(255 - row) * lg2); u32x4 o;
        o.x = pk2(bflo(v.x) * wg, bfhi(v.x) * wg); o.y = pk2(bflo(v.y) * wg, bfhi(v.y) * wg); o.z = pk2(bflo(v.z) * wg, bfhi(v.z) * wg); o.w = pk2(bflo(v.w) * wg, bfhi(v.w) * wg);
        *(LAS u32x4*)(Ki + row * 128 + ch * 16) = kk[i]; *(LAS u32x4*)(Vw + row * 128 + ch * 16) = o; } }
    __syncthreads();
    const int tl = wave & 3, ce = tl >> 1, cd = tl & 1, r = lane & 31, h = lane >> 5, blk = (lane >> 4) & 1, q4 = (lane & 15) >> 2, p = lane & 3;
    f32x16 acc = zero16();
#pragma unroll
    for (int kk = 0; kk < 16; ++kk) { const int rowa = 16 * kk + 8 * h + q4; const int ofa = rowa * 128 + 32 * blk + 8 * p;
        const bf16x8 a = cat8(vtr(Vw + ofa + 64 * ce), vtr(Vw + ofa + 4 * 128 + 64 * ce));
        const bf16x8 bb = cat8(vtr(Ki + ofa + 64 * cd), vtr(Ki + ofa + 4 * 128 + 64 * cd));
        acc = mfma32(a, bb, acc); }
    float* o = KV + (size_t)it * 4096;
#pragma unroll
    for (int i = 0; i < 16; ++i) st_wt(o + (32 * ce + crow(i, h)) * 64 + 32 * cd + r, acc[i]);
    publish_wave(kvc + 64 * bh, lane);
    __syncthreads();
}
__device__ __forceinline__ void kmean_item(int it8, const bf16* z, float* KM, unsigned* kmc, LAS unsigned char* lds, int wave, int lane) {
    const int it = 8 * it8 + wave, bh = it >> 5, j = it & 31, b = bh / NHM, hh = bh - b * NHM; const size_t tok0 = (size_t)b * SEQ + 256 * j;
    LAS float* S = (LAS float*)(lds + wave * 2048);
    const int g = lane >> 3, ch = lane & 7; float a[8];
#pragma unroll
    for (int k = 0; k < 8; ++k) a[k] = 0.f;
#pragma unroll
    for (int q = 0; q < 4; ++q) { u32x4 v[8];
#pragma unroll
        for (int i = 0; i < 8; ++i) v[i] = *(const u32x4*)(z + (tok0 + g + 8 * (8 * q + i)) * ZP + Z_MK + 64 * hh + ch * 8);
#pragma unroll
        for (int i = 0; i < 8; ++i) { a[0] += bflo(v[i].x); a[1] += bfhi(v[i].x); a[2] += bflo(v[i].y); a[3] += bfhi(v[i].y); a[4] += bflo(v[i].z); a[5] += bfhi(v[i].z); a[6] += bflo(v[i].w); a[7] += bfhi(v[i].w); } }
    *(LAS f32x4*)(S + g * 64 + ch * 8) = (f32x4){a[0], a[1], a[2], a[3]}; *(LAS f32x4*)(S + g * 64 + ch * 8 + 4) = (f32x4){a[4], a[5], a[6], a[7]};
    LDS_WAIT(); asm volatile("" ::: "memory");
    float s = 0.f;
#pragma unroll
    for (int q = 0; q < 8; ++q) s += S[q * 64 + lane];
    st_wt(KM + (size_t)it * 64 + lane, s * (1.f / 256.f)); publish_wave(kmc + 64 * bh, lane);
    LDS_WAIT(); asm volatile("" ::: "memory");
}
__device__ __forceinline__ void scan_item(int it, const float* KV, bf16* PREV, unsigned* kvc, unsigned* scc, unsigned* tmo, int tid, int lane) {
    const int bh = it >> 1, part = it & 1, hh = bh % NHM; const int idx = part * 2048 + 4 * tid;
    wait_count(kvc + 64 * bh, 128u, tmo, tid);
    const float g256 = ex2(256.0f * log2f(1.0f - ex2(-5.0f - (float)hh)));
    float k0[NCH], k1[NCH], k2[NCH], k3[NCH];
#pragma unroll
    for (int n = 0; n < NCH; ++n) { const float* p = KV + ((size_t)bh * NCH + n) * 4096 + idx; k0[n] = ld_wt(p); k1[n] = ld_wt(p + 1); k2[n] = ld_wt(p + 2); k3[n] = ld_wt(p + 3); }
    float s0 = 0.f, s1 = 0.f, s2 = 0.f, s3 = 0.f;
#pragma unroll
    for (int n = 0; n < NCH; ++n) { st_wt((unsigned long long*)(PREV + ((size_t)bh * NCH + n) * 4096 + idx), (unsigned long long)pk2(s0, s1) | ((unsigned long long)pk2(s2, s3) << 32));
        s0 = s0 * g256 + k0[n]; s1 = s1 * g256 + k1[n]; s2 = s2 * g256 + k2[n]; s3 = s3 * g256 + k3[n]; }
    publish_wave(scc + 64 * bh, lane);
}
__device__ __forceinline__ void gate_item(int it, const bf16* z, const float* KM, unsigned* SEL, unsigned* kmc, unsigned* gtc, unsigned* tmo, LAS unsigned char* lds, int tid, int lane) {
    const int bh = it >> 4, ip = it & 15, b = bh / NHM, hh = bh - b * NHM;
    wait_count(kmc + 64 * bh, 32u, tmo, tid);
    LAS float* km = (LAS float*)lds;
#pragma unroll
    for (int i = 0; i < 4; ++i) km[tid + 512 * i] = ld_wt(KM + (size_t)bh * 2048 + tid + 512 * i);
    __syncthreads();
    const int i = 2 * ip + (tid >> 8), s = 256 * i + (tid & 255);
    const bf16* qp = z + ((size_t)b * SEQ + s) * ZP + Z_MQ + 64 * hh;
    float q[64];
#pragma unroll
    for (int c = 0; c < 8; ++c) { const u32x4 v = *(const u32x4*)(qp + 8 * c);
        q[8 * c] = bflo(v.x); q[8 * c + 1] = bfhi(v.x); q[8 * c + 2] = bflo(v.y); q[8 * c + 3] = bfhi(v.y); q[8 * c + 4] = bflo(v.z); q[8 * c + 5] = bfhi(v.z); q[8 * c + 6] = bflo(v.w); q[8 * c + 7] = bfhi(v.w); }
    const float ninf = -__builtin_inff();
    float v0 = ninf, v1 = ninf, v2 = ninf; int i0 = 0, i1 = 0, i2 = 0;
    for (int j = 0; j < i; ++j) { float g = 0.f;
#pragma unroll
        for (int d = 0; d < 64; d += 4) { const f32x4 k4 = *(const LAS f32x4*)(km + j * 64 + d); g += q[d] * k4[0] + q[d + 1] * k4[1] + q[d + 2] * k4[2] + q[d + 3] * k4[3]; }
        if (g > v0) { v2 = v1; i2 = i1; v1 = v0; i1 = i0; v0 = g; i0 = j; }
        else if (g > v1) { v2 = v1; i2 = i1; v1 = g; i1 = j; }
        else if (g > v2) { v2 = g; i2 = j; } }
    unsigned mask = 0u;
    if (i > 0) mask |= 1u << i0;
    if (i > 1) mask |= 1u << i1;
    if (i > 2) mask |= 1u << i2;
    st_wt(SEL + (size_t)bh * SEQ + s, mask);
    publish_wave(gtc + 64 * bh, lane);
    __syncthreads();
}
__device__ __forceinline__ void attn_wave(LAS const unsigned char* Ki, LAS const unsigned char* Vi, const bf16x8 (&qf)[4], int nkt, int diag, int qloc, int lane, f32x16 (&o)[2], float& m, float& l) {
    const int r = lane & 31, h = lane >> 5, blk = (lane >> 4) & 1, q4 = (lane & 15) >> 2, p = lane & 3;
    o[0] = zero16(); o[1] = zero16(); l = 0.f; m = 0.f;
    f32x16 negm = zero16();
    bf16x8 kf[4];
#pragma unroll
    for (int s = 0; s < 4; ++s) kf[s] = ldsrow(Ki + r * PIT + 32 * s + 16 * h);
    for (int kt = 0; kt < nkt; ++kt) {
        f32x16 x = negm;
        asm volatile("" : "+v"(kf[0]), "+v"(kf[1]), "+v"(kf[2]), "+v"(kf[3]));
#pragma unroll
        for (int s = 0; s < 4; ++s) x = mfma32(kf[s], qf[s], x);
        const int ktn = (kt + 1 < nkt) ? kt + 1 : kt;
#pragma unroll
        for (int s = 0; s < 4; ++s) kf[s] = ldsrow(Ki + (32 * ktn + r) * PIT + 32 * s + 16 * h);
        bf16x8 vf[2][2];
#pragma unroll
        for (int s2 = 0; s2 < 2; ++s2) { const int ofv = (32 * kt + 16 * s2 + 4 * h + q4) * PIT + 32 * blk + 8 * p;
#pragma unroll
            for (int c = 0; c < 2; ++c) vf[s2][c] = cat8(vtr(Vi + ofv + 64 * c), vtr(Vi + ofv + 8 * PIT + 64 * c)); }
        __builtin_amdgcn_sched_barrier(0);
        if (kt == diag) {
#pragma unroll
            for (int i = 0; i < 16; ++i) if (32 * kt + crow(i, h) > qloc) x[i] = -__builtin_inff(); }
        float tm = x[0];
#pragma unroll
        for (int i = 1; i < 16; ++i) tm = fmaxf(tm, x[i]);
        tm = fmaxf(tm, __shfl_xor(tm, 32));
        if (kt == 0) { m = tm;
#pragma unroll
            for (int i = 0; i < 16; ++i) { x[i] -= tm; negm[i] = -tm; } }
        else if (__any(tm > 8.0f)) {
            const float dm = fmaxf(tm, 0.f), sc = ex2(-dm);
            l *= sc; o[0] = o[0] * sc; o[1] = o[1] * sc; m += dm;
#pragma unroll
            for (int i = 0; i < 16; ++i) { x[i] -= dm; negm[i] = -m; } }
#pragma unroll
        for (int i = 0; i < 16; ++i) { x[i] = ex2(x[i]); l += x[i]; }
        const bf16x8 pf0 = pack8(x, 0), pf1 = pack8(x, 1);
        __builtin_amdgcn_sched_barrier(0);
        o[0] = mfma32(vf[0][0], pf0, o[0]); o[1] = mfma32(vf[0][1], pf0, o[1]); o[0] = mfma32(vf[1][0], pf1, o[0]); o[1] = mfma32(vf[1][1], pf1, o[1]);
    }
}
__device__ __forceinline__ void store_partial(const f32x16 (&o)[2], float m, float l, bf16* OP, float* LSE, int bh, int slot, int qidx, bool valid, int lane, LAS unsigned char* ot) {
    const int r = lane & 31, h = lane >> 5; const float lt = l + __shfl_xor(l, 32), inv = 1.0f / lt;
    LAS int* rowdst = (LAS int*)(ot + 32 * 80);
    const int dst = valid ? (bh * 4 + slot) * SEQ + qidx : -1;
    if (h == 0) rowdst[r] = dst;
#pragma unroll
    for (int c = 0; c < 2; ++c)
#pragma unroll
        for (int g = 0; g < 4; ++g) { int w = __builtin_amdgcn_cvt_pk_fp8_f32(o[c][4 * g] * inv, o[c][4 * g + 1] * inv, 0, false); w = __builtin_amdgcn_cvt_pk_fp8_f32(o[c][4 * g + 2] * inv, o[c][4 * g + 3] * inv, w, true);
            *(LAS int*)(ot + r * 80 + 32 * c + 8 * g + 4 * h) = w; }
    if (valid && h == 0) LSE[(size_t)dst] = m + log2f(lt);
    LDS_WAIT(); asm volatile("" ::: "memory");
    u32x4 v[2]; int d[2];
#pragma unroll
    for (int k = 0; k < 2; ++k) { const int row = 16 * k + (lane >> 2); v[k] = *(const LAS u32x4*)(ot + row * 80 + (lane & 3) * 16); d[k] = rowdst[row]; }
#pragma unroll
    for (int k = 0; k < 2; ++k) if (d[k] >= 0) *(u32x4*)((unsigned char*)OP + (size_t)d[k] * 64 + 16 * (lane & 3)) = v[k];
    LDS_WAIT(); asm volatile("" ::: "memory");
}
__device__ __forceinline__ void moba_item(int bh, int j, bool own, int i0, int i1, const bf16* z, const unsigned* SEL, bf16* OP, float* LSE, unsigned* gtc, unsigned* tmo, LAS unsigned char* lds, int tid, int wave, int lane) {
    const int b = bh / NHM, hh = bh - b * NHM; const size_t tokb = (size_t)b * SEQ;
    wait_count(gtc + 64 * bh, 128u, tmo, tid);
    LAS unsigned char* Ki = lds; LAS unsigned char* Vi = lds + IMG; LAS unsigned short* list = (LAS unsigned short*)(lds + 2 * IMG); LAS int* wtot = (LAS int*)(lds + 2 * IMG + 4096);
    const int ncand = 256 * (i1 - i0), c0 = 4 * tid; int f[4] = {0, 0, 0, 0};
    u32x4 mk = {0u, 0u, 0u, 0u};
    if (c0 < ncand) { const unsigned* sp = SEL + (size_t)bh * SEQ + 256 * i0 + c0; mk = (u32x4){ld_wt(sp), ld_wt(sp + 1), ld_wt(sp + 2), ld_wt(sp + 3)}; }
    const int r = lane & 31, h = lane >> 5, qt = wave < 4 ? wave : 11 - wave;
    { LAS unsigned char* const d_[2] = {Ki, Vi}; const bf16* const s_[2] = {z + (tokb + 256 * j) * ZP + Z_MK + 64 * hh, z + (tokb + 256 * j) * ZP + Z_MV + 64 * hh}; stage256n<2>(d_, s_, ZP, tid); }
    f[0] = (mk.x >> j) & 1; f[1] = (mk.y >> j) & 1; f[2] = (mk.z >> j) & 1; f[3] = (mk.w >> j) & 1;
    const int mine = f[0] + f[1] + f[2] + f[3]; int inc = mine;
#pragma unroll
    for (int o = 1; o < 64; o <<= 1) { const int t = __shfl_up(inc, o); if (lane >= o) inc += t; }
    if (lane == 63) wtot[wave] = inc;
    __syncthreads();
    int base = 0, cnt = 0;
#pragma unroll
    for (int w = 0; w < 8; ++w) { const int t = wtot[w]; if (w < wave) base += t; cnt += t; }
    int pos = base + inc - mine;
#pragma unroll
    for (int k = 0; k < 4; ++k) if (f[k]) { list[pos] = (unsigned short)(256 * i0 + c0 + k); ++pos; }
    __syncthreads();
    const int ntl = (cnt + 255) >> 8, Tfirst = own ? -1 : 0;
    int qidx = 0; bool valid = false; unsigned mq = 0u; bf16x8 qn[4];
#define MOBA_LOADQ(Tn) do { if ((Tn) < 0) { qidx = 256 * j + 32 * qt + r; valid = true; } else { const int li_ = 256 * (Tn) + 32 * wave + r; valid = li_ < cnt; qidx = list[valid ? li_ : cnt - 1]; } \
        _Pragma("unroll") for (int s = 0; s < 4; ++s) qn[s] = *(const bf16x8*)(z + (tokb + qidx) * ZP + Z_MQ + 64 * hh + 16 * s + 8 * h); \
        mq = ld_wt(SEL + (size_t)bh * SEQ + qidx); } while (0)
    if (Tfirst < 0 || 32 * wave < cnt) MOBA_LOADQ(Tfirst);
    for (int T = Tfirst; T < ntl; ++T) {
        if (T >= 0 && 256 * T + 32 * wave >= cnt) break;
        bf16x8 qf[4];
#pragma unroll
        for (int s = 0; s < 4; ++s) qf[s] = qn[s];
        const int qcur = qidx, slot = (T < 0) ? 3 : __builtin_popcount(mq & ((1u << j) - 1u)); const bool vcur = valid;
        if (T + 1 < ntl && 256 * (T + 1) + 32 * wave < cnt) MOBA_LOADQ(T + 1);
        f32x16 o[2]; float m, l;
        attn_wave(Ki, Vi, qf, (T < 0) ? qt + 1 : 8, (T < 0) ? qt : -1, 32 * qt + r, lane, o, m, l);
        store_partial(o, m, l, OP, LSE, bh, slot, qcur, vcur, lane, lds + 2 * IMG + 8192 + wave * 3072);
    }
#undef MOBA_LOADQ
    __syncthreads();
}
__device__ __forceinline__ void ret_item(int it, const bf16* z, const bf16* PREV, bf16* mix, unsigned* scc, unsigned* tmo, LAS unsigned char* lds, int tid, int wave, int lane) {
    const int bh = it >> 5, n = it & 31, b = bh / NHM, hh = bh - b * NHM; const size_t tok0 = (size_t)b * SEQ + 256 * n;
    wait_count(scc + 64 * bh, 16u, tmo, tid);
    const float lg2 = log2f(1.0f - ex2(-5.0f - (float)hh));
    LAS unsigned char* Qi = lds; LAS unsigned char* Ki = lds + IMG; LAS unsigned char* Vi = lds + 2 * IMG; LAS unsigned char* Pi = lds + 3 * IMG;
    { const unsigned* pp_ = (const unsigned*)(PREV + (size_t)it * 4096 + (size_t)(tid >> 3) * 64 + (tid & 7) * 8);
      const u32x4 pv_ = {ld_wt(pp_), ld_wt(pp_ + 1), ld_wt(pp_ + 2), ld_wt(pp_ + 3)};
      LAS unsigned char* const d_[3] = {Qi, Ki, Vi}; const bf16* const s_[3] = {z + tok0 * ZP + Z_RQ + 64 * hh, z + tok0 * ZP + Z_RK + 64 * hh, z + tok0 * ZP + Z_RV + 64 * hh}; stage256n<3>(d_, s_, ZP, tid);
      *(LAS u32x4*)(Pi + (tid >> 3) * PIT + (tid & 7) * 16) = pv_; }
    __syncthreads();
    const int qt = wave < 4 ? wave : 11 - wave, r = lane & 31, h = lane >> 5, blk = (lane >> 4) & 1, q4 = (lane & 15) >> 2, p = lane & 3, qloc = 32 * qt + r;
    const bf16* gp = z + (tok0 + qloc) * ZP + Z_RG + 64 * hh;
    u32x2 gvv[2][4];
#pragma unroll
    for (int c = 0; c < 2; ++c)
#pragma unroll
        for (int g = 0; g < 4; ++g) gvv[c][g] = (hh < 4) ? *(const u32x2*)(gp + 32 * c + 8 * g + 4 * h) : (u32x2){0u, 0u};
    bf16x8 qf[4];
#pragma unroll
    for (int s = 0; s < 4; ++s) qf[s] = ldsrow(Qi + qloc * PIT + 32 * s + 16 * h);
    f32x16 cx[2], o[2]; cx[0] = zero16(); cx[1] = zero16(); o[0] = zero16(); o[1] = zero16();
#pragma unroll
    for (int c = 0; c < 2; ++c)
#pragma unroll
        for (int s = 0; s < 4; ++s) cx[c] = mfma32(ldsrow(Pi + (32 * c + r) * PIT + 32 * s + 16 * h), qf[s], cx[c]);
    float grel[16];
#pragma unroll
    for (int i = 0; i < 16; ++i) grel[i] = ex2((float)(r - crow(i, h)) * lg2);
    bf16x8 kf[4];
#pragma unroll
    for (int s = 0; s < 4; ++s) kf[s] = ldsrow(Ki + r * PIT + 32 * s + 16 * h);
    for (int kt = 0; kt <= qt; ++kt) {
        f32x16 x = zero16();
        asm volatile("" : "+v"(kf[0]), "+v"(kf[1]), "+v"(kf[2]), "+v"(kf[3]));
#pragma unroll
        for (int s = 0; s < 4; ++s) x = mfma32(kf[s], qf[s], x);
        const int ktn = (kt < qt) ? kt + 1 : kt;
#pragma unroll
        for (int s = 0; s < 4; ++s) kf[s] = ldsrow(Ki + (32 * ktn + r) * PIT + 32 * s + 16 * h);
        bf16x8 vf[2][2];
#pragma unroll
        for (int s2 = 0; s2 < 2; ++s2) { const int ofv = (32 * kt + 16 * s2 + 4 * h + q4) * PIT + 32 * blk + 8 * p;
#pragma unroll
            for (int c = 0; c < 2; ++c) vf[s2][c] = cat8(vtr(Vi + ofv + 64 * c), vtr(Vi + ofv + 8 * PIT + 64 * c)); }
        __builtin_amdgcn_sched_barrier(0);
        { const float ts = ex2((float)(32 * (qt - kt)) * lg2);
#pragma unroll
        for (int i = 0; i < 16; ++i) { const float wv = grel[i] * ts; x[i] = (kt < qt || r >= crow(i, h)) ? x[i] * wv : 0.f; } }
        const bf16x8 pf0 = pack8(x, 0), pf1 = pack8(x, 1);
        __builtin_amdgcn_sched_barrier(0);
        o[0] = mfma32(vf[0][0], pf0, o[0]); o[1] = mfma32(vf[0][1], pf0, o[1]); o[0] = mfma32(vf[1][0], pf1, o[0]); o[1] = mfma32(vf[1][1], pf1, o[1]);
    }
    const float wcr = ex2((float)(qloc + 1) * lg2); float ss = 0.f;
#pragma unroll
    for (int c = 0; c < 2; ++c)
#pragma unroll
        for (int i = 0; i < 16; ++i) { const float y = o[c][i] + wcr * cx[c][i]; o[c][i] = y; ss += y * y; }
    ss += __shfl_xor(ss, 32);
    const float rn = __builtin_amdgcn_rsqf(ss * (1.f / 64.f) + RMS_EPS);
    bf16* mp = mix + (tok0 + qloc) * DM + X_RET + 64 * hh;
#pragma unroll
    for (int c = 0; c < 2; ++c)
#pragma unroll
        for (int g = 0; g < 4; ++g) { const int e0 = 32 * c + 8 * g + 4 * h; const u32x2 gv = gvv[c][g]; u32x2 w;
            if (hh < 4) { w.x = pk2(silu1(bflo(gv.x)) * o[c][4 * g] * rn, silu1(bfhi(gv.x)) * o[c][4 * g + 1] * rn); w.y = pk2(silu1(bflo(gv.y)) * o[c][4 * g + 2] * rn, silu1(bfhi(gv.y)) * o[c][4 * g + 3] * rn); }
            else { w.x = pk2(o[c][4 * g] * rn, o[c][4 * g + 1] * rn); w.y = pk2(o[c][4 * g + 2] * rn, o[c][4 * g + 3] * rn); }
            *(u32x2*)(mp + e0) = w; }
    __syncthreads();
}
struct CombIn { unsigned selw; float ls[4]; u32x2 ov[4]; };
__device__ __forceinline__ void combine_load(int idx, const bf16* OP, const float* LSE, const unsigned* SEL, CombIn& c) {
    const int ch = idx & 7, th = idx >> 3, hh = th % NHM, tok = th / NHM, b = tok >> 13, s = tok & (SEQ - 1), bh = b * NHM + hh;
    c.selw = SEL[(size_t)bh * SEQ + s];
#pragma unroll
    for (int k = 0; k < 4; ++k) { c.ls[k] = LSE[((size_t)bh * 4 + k) * SEQ + s]; c.ov[k] = *(const u32x2*)((const unsigned char*)OP + (((size_t)bh * 4 + k) * SEQ + s) * 64 + 8 * ch); }
}
__device__ __forceinline__ void combine_store(int idx, const CombIn& c, bf16* mix) {
    const int ch = idx & 7, th = idx >> 3, hh = th % NHM, tok = th / NHM;
    const int ns = __builtin_popcount(c.selw); float mx = -__builtin_inff(); float ls[4];
#pragma unroll
    for (int k = 0; k < 4; ++k) { const bool on = (k == 3) || (k < ns); ls[k] = on ? c.ls[k] : -__builtin_inff(); mx = fmaxf(mx, ls[k]); }
    float a[8], wsum = 0.f;
#pragma unroll
    for (int k = 0; k < 8; ++k) a[k] = 0.f;
#pragma unroll
    for (int k = 0; k < 4; ++k) { const bool on = (k == 3) || (k < ns); const float wg = on ? ex2(ls[k] - mx) : 0.f; wsum += wg;
        u32x2 v = c.ov[k]; if (!on) v = (u32x2){0u, 0u};
        const f32x2 p0 = __builtin_amdgcn_cvt_pk_f32_fp8((int)v.x, false), p1 = __builtin_amdgcn_cvt_pk_f32_fp8((int)v.x, true), p2 = __builtin_amdgcn_cvt_pk_f32_fp8((int)v.y, false), p3 = __builtin_amdgcn_cvt_pk_f32_fp8((int)v.y, true);
        a[0] += wg * p0[0]; a[1] += wg * p0[1]; a[2] += wg * p1[0]; a[3] += wg * p1[1]; a[4] += wg * p2[0]; a[5] += wg * p2[1]; a[6] += wg * p3[0]; a[7] += wg * p3[1]; }
    const float inv = 1.0f / wsum; u32x4 w; w.x = pk2(a[0] * inv, a[1] * inv); w.y = pk2(a[2] * inv, a[3] * inv); w.z = pk2(a[4] * inv, a[5] * inv); w.w = pk2(a[6] * inv, a[7] * inv);
    *(u32x4*)(mix + (size_t)tok * DM + X_MOBA + 64 * hh + 8 * ch) = w;
}
__device__ __forceinline__ void rgate_item2(int idx0, int idx1, const bf16* z, bf16* mix) {
    u32x4 g[2], v[2]; bf16* mp[2];
#pragma unroll
    for (int k = 0; k < 2; ++k) { const int idx = k ? idx1 : idx0, ch = idx & 7, th = idx >> 3, hh = 4 + (th & 1), tok = th >> 1;
        g[k] = *(const u32x4*)(z + (size_t)tok * ZP + Z_RG + 64 * hh + 8 * ch); mp[k] = mix + (size_t)tok * DM + X_RET + 64 * hh + 8 * ch; v[k] = *(const u32x4*)mp[k]; }
#pragma unroll
    for (int k = 0; k < 2; ++k) { if (k == 1 && idx1 == idx0) break; u32x4 w;
        w.x = pk2(silu1(bflo(g[k].x)) * bflo(v[k].x), silu1(bfhi(g[k].x)) * bfhi(v[k].x)); w.y = pk2(silu1(bflo(g[k].y)) * bflo(v[k].y), silu1(bfhi(g[k].y)) * bfhi(v[k].y));
        w.z = pk2(silu1(bflo(g[k].z)) * bflo(v[k].z), silu1(bfhi(g[k].z)) * bfhi(v[k].z)); w.w = pk2(silu1(bflo(g[k].w)) * bflo(v[k].w), silu1(bfhi(g[k].w)) * bfhi(v[k].w));
        *(u32x4*)mp[k] = w; }
}
#ifndef MK_PER_PHASE
#define MK_PER_PHASE 0
#endif
constexpr int N_PHASES = 1 + DEPTH * 8;
constexpr int T_KM = NBH * NCH / 8, T_KV = T_KM + NBH * NCH / 2, T_GT = T_KV + NBH * 16, T_SC = T_GT + NBH * 2, T_CV = T_SC + 256, T_G13 = T_CV + M / 256, MIXC_LIST = NBH * 76, T_MB = T_G13 + MIXC_LIST, T_RT = T_MB + NBH * NCH, MIXC_ITEMS = T_RT + NBH;

__global__ void __launch_bounds__(512, 2) fwd(Args args) {
    extern __shared__ __attribute__((aligned(16))) unsigned char lds_raw[];
    LAS unsigned char* lds = (LAS unsigned char*)lds_raw;
    volatile LAS unsigned* MISC = (volatile LAS unsigned*)(lds + MISC_OFF);
    const int tid0 = threadIdx.x, wave0 = __builtin_amdgcn_readfirstlane(tid0 >> 6);
    const int G = gridDim.x, bid = blockIdx.x, NGW = G * 8;
    unsigned char* const ws0 = args.ws;
    unsigned* ctl = (unsigned*)(ws0 + WS_CTL);
    for (int u = tid0; u < (LDS_BYTES - LDSCTL_OFF) / 4; u += 512) ((LAS unsigned*)(lds + LDSCTL_OFF))[u] = 0u;
    __syncthreads();
    XcdBarrier bar; bar.bar = ctl + CW_BAR; bar.x = 0; bar.st = nullptr;
    if (!MK_PER_PHASE) bar = xcd_barrier_post(ctl + CW_BAR, MISC + 8);
    if (tid0 == 0) __hip_atomic_store(ctl + CW_XT + bid, xb_xcc_id() + 1u, __ATOMIC_RELAXED, __HIP_MEMORY_SCOPE_AGENT);
    int lok = 0;
    const int lo = args.ph_lo, hi = args.ph_hi; int pc = 0;
#define RUN (pc >= lo && pc < hi)
#define SEAM do { ++pc; if (!MK_PER_PHASE && pc > lo && pc < hi) xcd_barrier(bar); } while (0)
#define SEAM_LOCAL do { ++pc; if (!MK_PER_PHASE && pc > lo && pc < hi) { if (lok) xcd_local_barrier(ctl + CW_LB, bar.x, 32u, ctl + CW_TMO); else xcd_barrier(bar); } } while (0)

#define ENV unsigned sd_ = 0u; asm volatile("" : "+s"(sd_)); int tid = wave0 * 64 + (int)__builtin_amdgcn_mbcnt_hi(~0u, __builtin_amdgcn_mbcnt_lo(~0u, sd_)); asm volatile("" : "+v"(tid)); const int lane = tid & 63, wave = __builtin_amdgcn_readfirstlane(tid >> 6), gw = bid * 8 + wave; (void)lane; (void)gw; \
    GAS unsigned char* wsl = (GAS unsigned char*)ws0; asm volatile("" : "+s"(wsl)); unsigned char* ws = (unsigned char*)wsl; int zi = 0; asm volatile("" : "+s"(zi)); GAS float* xresl = (GAS float*)args.out; asm volatile("" : "+s"(xresl)); float* xres = (float*)xresl; \
    bf16* XB = (bf16*)(ws + WS_XB); bf16* Z = (bf16*)(ws + WS_Z); bf16* ACT = (bf16*)(ws + WS_ACT); bf16* MIX = (bf16*)(ws + WS_MIX); \
    bf16* OP = (bf16*)(ws + WS_OP); float* LSE = (float*)(ws + WS_LSE); unsigned* SEL = (unsigned*)(ws + WS_SEL); \
    float* RT = (float*)(ws + WS_RT); float* MT = (float*)(ws + WS_MT); float* SSQ = (float*)(ws + WS_SSQ); \
    float* KV = (float*)(ws + WS_KV); bf16* PREV = (bf16*)(ws + WS_PREV); float* KM = (float*)(ws + WS_KM); \
    LAS float* scr = (LAS float*)(lds + wave * 16384); (void)scr; (void)XB; (void)Z; (void)ACT; (void)MIX; (void)OP; (void)LSE; (void)SEL; (void)RT; (void)MT; (void)SSQ; (void)KV; (void)PREV; (void)KM; (void)xres
#define INP(k) ((const float*)(GAS const float*)args.in[(k) + zi])

#define CVT_PULL_L(hd, L_, blo, bhi) do { unsigned* cvh = (unsigned*)(ws + WS_CTL) + CW_Q + 64 * (hd); \
        for (;;) { __syncthreads(); if (tid == 0) MISC[1] = __hip_atomic_fetch_add(cvh, 1u, __ATOMIC_RELAXED, __HIP_MEMORY_SCOPE_AGENT); __syncthreads(); \
            const int bt = (blo) + (int)MISC[1]; if (bt >= (bhi)) break; \
            cvt_layer_batch(args, zi, (L_), ws + WS_W + (size_t)((L_) & 1) * WBUF_BYTES, bt, lds, wave, lane); } } while (0)
#define CVT_PULL(qi, blo, bhi) do { if (l + 1 < DEPTH) CVT_PULL_L(8 + 2 * l + (qi), l + 1, blo, bhi); } while (0)

    if (RUN) { ENV; const float* x_in = INP(0);
        CVT_PULL_L(14, 0, 0, b_layer(0));
        for (int m = gw; m < M; m += 2 * NGW) {
            const int m1 = (m + NGW < M) ? m + NGW : m;
            const f32x4* xr0 = (const f32x4*)(x_in + (size_t)m * DM) + lane; const f32x4* xr1 = (const f32x4*)(x_in + (size_t)m1 * DM) + lane; f32x4 v0[4], v1[4]; float s0[4], s1[4];
#pragma unroll
            for (int j = 0; j < 4; ++j) { v0[j] = xr0[64 * j]; v1[j] = xr1[64 * j]; }
#pragma unroll
            for (int j = 0; j < 4; ++j) { s0[j] = (v0[j][0] * v0[j][0] + v0[j][1] * v0[j][1]) + (v0[j][2] * v0[j][2] + v0[j][3] * v0[j][3]); s1[j] = (v1[j][0] * v1[j][0] + v1[j][1] * v1[j][1]) + (v1[j][2] * v1[j][2] + v1[j][3] * v1[j][3]); }
            float am0 = 0.f, am1 = 0.f;
#pragma unroll
            for (int j = 0; j < 4; ++j) { am0 = fmaxf(am0, fmaxf(fmaxf(fabsf(v0[j][0]), fabsf(v0[j][1])), fmaxf(fabsf(v0[j][2]), fabsf(v0[j][3])))); am1 = fmaxf(am1, fmaxf(fmaxf(fabsf(v1[j][0]), fabsf(v1[j][1])), fmaxf(fabsf(v1[j][2]), fabsf(v1[j][3])))); }
#pragma unroll
            for (int o = 1; o < 64; o <<= 1) {
#pragma unroll
                for (int j = 0; j < 4; ++j) { s0[j] += __shfl_xor(s0[j], o); s1[j] += __shfl_xor(s1[j], o); }
                am0 = fmaxf(am0, __shfl_xor(am0, o)); am1 = fmaxf(am1, __shfl_xor(am1, o)); }
            unsigned long long* o0 = (unsigned long long*)(XB + (size_t)m * DM) + lane; unsigned long long* o1 = (unsigned long long*)(XB + (size_t)m1 * DM) + lane;
#pragma unroll
            for (int j = 0; j < 4; ++j) { o0[64 * j] = (unsigned long long)pk2(v0[j][0], v0[j][1]) | ((unsigned long long)pk2(v0[j][2], v0[j][3]) << 32); o1[64 * j] = (unsigned long long)pk2(v1[j][0], v1[j][1]) | ((unsigned long long)pk2(v1[j][2], v1[j][3]) << 32); }
            { const float iv0 = am0 > 0.f ? 127.0f / am0 : 0.f, iv1 = am1 > 0.f ? 127.0f / am1 : 0.f; unsigned* q0 = (unsigned*)(ws + WS_X8 + (size_t)m * DM) + lane; unsigned* q1 = (unsigned*)(ws + WS_X8 + (size_t)m1 * DM) + lane;
#pragma unroll
              for (int j = 0; j < 4; ++j) { q0[64 * j] = pg8::q8x4(v0[j][0], v0[j][1], v0[j][2], v0[j][3], iv0); q1[64 * j] = pg8::q8x4(v1[j][0], v1[j][1], v1[j][2], v1[j][3], iv1); } }
            if (lane == 0) { *(f32x4*)(SSQ + (size_t)m * 4) = (f32x4){s0[0], s0[1], s0[2], s0[3]}; *(f32x4*)(SSQ + (size_t)m1 * 4) = (f32x4){s1[0], s1[1], s1[2], s1[3]};
                float* RF = (float*)(ws + WS_RF); RF[m] = __builtin_amdgcn_rsqf(((s0[0] + s0[1]) + (s0[2] + s0[3])) * (1.0f / 1024.0f) + RMS_EPS) * am0 * (1.0f / 127.0f); RF[m1] = __builtin_amdgcn_rsqf(((s1[0] + s1[1]) + (s1[2] + s1[3])) * (1.0f / 1024.0f) + RMS_EPS) * am1 * (1.0f / 127.0f); } }
        const int* pos = (const int*)INP(1);
        for (int i = bid * 512 + tid; i < M * 40; i += G * 512) { const int row = i / 40, k = i - row * 40; float c, s; sincos_acc((float)pos[row] * args.invf[k], c, s);
            float* t = (k < 32) ? RT + (size_t)row * 64 + 2 * k : MT + (size_t)row * 16 + 2 * (k - 32); *(f32x2*)t = (f32x2){c, s}; }
    }
    SEAM;
    if (!MK_PER_PHASE && lo == 0 && hi > 1) {
        int ok = (G == 256);
        if (tid0 < G) { const unsigned v = __hip_atomic_load(ctl + CW_XT + tid0, __ATOMIC_RELAXED, __HIP_MEMORY_SCOPE_AGENT), r = __hip_atomic_load(ctl + CW_XT + (tid0 & 7), __ATOMIC_RELAXED, __HIP_MEMORY_SCOPE_AGENT); ok &= (v == r) && (v != 0u); }
        unsigned seen = 0u;
#pragma unroll
        for (int q = 0; q < 8; ++q) seen |= 1u << (__hip_atomic_load(ctl + CW_XT + q, __ATOMIC_RELAXED, __HIP_MEMORY_SCOPE_AGENT) & 31u);
        ok &= (__builtin_popcount(seen) == 8);
        lok = __syncthreads_and(ok);
    }

    for (int l = 0; l < DEPTH; ++l) {
        for (int hf = 0; hf < 2; ++hf) {
            if (RUN) { ENV; unsigned char* wb = ws + WS_W + (size_t)(l & 1) * WBUF_BYTES; unsigned char* wgu = wb + (hf ? WO_GU2 : WO_GU1);
                pg8::Gemm g{(const bf16*)(ws + WS_X8), (const bf16*)wgu, M, NGU, DM / 2}; pg8::StaticOrder S; S.init(M, NGU, G, bid);
                pg8::EpiGU8 E{ACT, (const LAS float*)(lds + LDSCTL_OFF + 1024), (const LAS float*)(lds + LDSCTL_OFF + 7168)};
                { LAS float* rt_ = (LAS float*)(lds + LDSCTL_OFF + 1024); LAS float* ct_ = (LAS float*)(lds + LDSCTL_OFF + 7168); const float* RF = (const float*)(ws + WS_RF); const float* SWt = (const float*)(wgu + WO_SW);
                  pg8::Unit u_; for (int i_ = 0; S.next(i_, u_); ++i_) if (tid < 256) { rt_[i_ * 256 + tid] = RF[u_.pm * 256 + tid]; ct_[i_ * 256 + tid] = SWt[u_.pn * 256 + tid]; } __syncthreads(); }
                pg8::gemm_phase<pg8::EpiGU8, pg8::StaticOrder, true, true, true>(lds, g, S, E, tid);
                if (hf == 0) CVT_PULL(0, 0, b_early(l + 1)); else CVT_PULL(1, b_early(l + 1), b_layer(l + 1)); }
            SEAM_LOCAL;
            if (RUN) { ENV; unsigned char* wb = ws + WS_W + (size_t)(l & 1) * WBUF_BYTES; pg8::Gemm g{ACT, (const bf16*)(wb + (hf ? WO_D2 : WO_D1)), M, DM, FF}; pg8::StaticOrder S; S.init(M, DM, G, bid);
                const bool q8_ = hf == 1 && l + 1 < DEPTH, fin_ = hf == 1 && l + 1 == DEPTH;
                pg8::EpiRes E{XB, SSQ, 0.5f, 2.0f, (q8_ || (hf == 0 && l >= WIN8_FROM)) ? (signed char*)(ws + WS_X8) : nullptr, (float*)(ws + WS_RF), (float*)(ws + WS_EX), (unsigned*)(ws + WS_CTL) + CW_PC + 16 * 64 * (3 * l + (hf ? 2 : 0)), (unsigned*)(ws + WS_CTL) + CW_TMO, fin_ ? xres : nullptr, INP(17)};
                pg8::gemm_phase<pg8::EpiRes, pg8::StaticOrder, false, true>(lds, g, S, E, tid); }
            SEAM_LOCAL;
            if (hf == 0) {
                if (RUN && l < WIN8_FROM) { ENV; unsigned char* wb = ws + WS_W + (size_t)(l & 1) * WBUF_BYTES; pg8::Gemm g{XB, (const bf16*)(wb + WO_IN), M, ZN1, DM}; pg8::StaticOrder S; S.init(M, ZN1, G, bid);
                    pg8::EpiWin E{Z, (const LAS float*)(lds + LDSCTL_OFF + 1024), RT, MT};
                    { LAS float* rt_ = (LAS float*)(lds + LDSCTL_OFF + 1024); pg8::Unit u_; for (int i_ = 0; S.next(i_, u_); ++i_) if (tid < 256) rt_[i_ * 256 + tid] = pg8::row_rstd(SSQ, u_.pm * 256 + tid); __syncthreads(); }
                pg8::gemm_phase<pg8::EpiWin, pg8::StaticOrder, true, true>(lds, g, S, E, tid); }
                if (RUN && l >= WIN8_FROM) { ENV; unsigned char* wb = ws + WS_W + (size_t)(l & 1) * WBUF_BYTES; pg8::Gemm g{(const bf16*)(ws + WS_X8), (const bf16*)(wb + WO_IN8), M, ZN1, DM / 2}; pg8::StaticOrder S; S.init(M, ZN1, G, bid);
                    pg8::EpiWin8 E{Z, (const LAS float*)(lds + LDSCTL_OFF + 1024), RT, MT, (const LAS float*)(lds + LDSCTL_OFF + 7168)};
                    { LAS float* rt_ = (LAS float*)(lds + LDSCTL_OFF + 1024); LAS float* ct_ = (LAS float*)(lds + LDSCTL_OFF + 7168); const float* RF = (const float*)(ws + WS_RF); const float* SWt = (const float*)(wb + WO_SWIN);
                      pg8::Unit u_; for (int i_ = 0; S.next(i_, u_); ++i_) if (tid < 256) { rt_[i_ * 256 + tid] = RF[u_.pm * 256 + tid]; ct_[i_ * 256 + tid] = SWt[u_.pn * 256 + tid]; } __syncthreads(); }
                pg8::gemm_phase<pg8::EpiWin8, pg8::StaticOrder, true, true, true>(lds, g, S, E, tid); }
                SEAM;
                if (RUN) { ENV;
                    unsigned* head = (unsigned*)(ws + WS_CTL) + CW_Q + 64 * l;
                    unsigned nxt = (unsigned)bid;
                    for (;;) {
                        __syncthreads();
                        if (tid == 0) MISC[0] = nxt;
                        __syncthreads();
                        int it = (int)MISC[0];
                        if (it >= MIXC_ITEMS) break;
                        int tq = tid; asm volatile("" : "+v"(tq)); const int lq = tq & 63;
                        if (tid == 0) nxt = (unsigned)G + __hip_atomic_fetch_add(head, 1u, __ATOMIC_RELAXED, __HIP_MEMORY_SCOPE_AGENT);
                        unsigned* hc = (unsigned*)(ws + WS_CTL) + CW_HC + 64 * 16 * 4 * l; unsigned* kmc = hc, * kvc = hc + 64 * 16, * gtc = hc + 64 * 32, * scc = hc + 64 * 48; unsigned* tmo = (unsigned*)(ws + WS_CTL) + CW_TMO;
                        if (it < T_KM) kmean_item(it, Z, KM, kmc, lds, wave, lq);
                        else if (it < T_KV) kv_item(it - T_KM, Z, KV, kvc, lds, tq, wave, lq);
                        else if (it < T_GT) gate_item(it - T_KV, Z, KM, SEL, kmc, gtc, tmo, lds, tq, lq);
                        else if (it < T_SC) scan_item(it - T_GT, KV, PREV, kvc, scc, tmo, tq, lq);
                        else if (it < T_CV) conv_item(it - T_SC, Z, MIX, INP(8) + (size_t)l * 31 * 256, INP(9) + l * 256, INP(10) + l * 256, INP(11) + l * 256, lds, tq, wave, lq);
                        else if (it < T_G13) {
                            const int pm_ = it - T_CV;
                            if (l < WIN8_FROM) {
                            unsigned char* wb = ws + WS_W + (size_t)(l & 1) * WBUF_BYTES; pg8::Gemm g{XB, (const bf16*)(wb + WO_IN), M, ZNP, DM}; pg8::OneUnit S{pm_, ZN1 / 256};
                            pg8::EpiWin E{Z, (const LAS float*)(lds + LDSCTL_OFF + 1024), RT, MT};
                            { LAS float* rt_ = (LAS float*)(lds + LDSCTL_OFF + 1024); if (tq < 256) rt_[tq] = pg8::row_rstd(SSQ, pm_ * 256 + tq); __syncthreads(); }
                            pg8::gemm_phase<pg8::EpiWin, pg8::OneUnit, false, true>(lds, g, S, E, tq); }
                            else {
                            unsigned char* wb = ws + WS_W + (size_t)(l & 1) * WBUF_BYTES; pg8::Gemm g{(const bf16*)(ws + WS_X8), (const bf16*)(wb + WO_IN8), M, ZNP, DM / 2}; pg8::OneUnit S{pm_, ZN1 / 256};
                            pg8::EpiWin8 E{Z, (const LAS float*)(lds + LDSCTL_OFF + 1024), RT, MT, (const LAS float*)(lds + LDSCTL_OFF + 7168)};
                            { LAS float* rt_ = (LAS float*)(lds + LDSCTL_OFF + 1024); LAS float* ct_ = (LAS float*)(lds + LDSCTL_OFF + 7168);
                              if (tq < 256) { rt_[tq] = ((const float*)(ws + WS_RF))[pm_ * 256 + tq]; ct_[tq] = ((const float*)(wb + WO_SWIN))[ZN1 + tq]; } __syncthreads(); }
                            pg8::gemm_phase<pg8::EpiWin8, pg8::OneUnit, false, true, true>(lds, g, S, E, tq); } }
                        else if (it >= T_MB && it < T_RT) ret_item(it - T_MB, Z, PREV, MIX, scc, tmo, lds, tq, wave, lq);
                        else { int bh, j, i0, i1; bool own;
                            if (it < T_MB) { const int rank = (it - T_G13) / NBH; bh = (it - T_G13) - rank * NBH; i0 = 1; int rem = rank;
                                while (rem >= ((i0 - 1) >> 3) + 1) { rem -= ((i0 - 1) >> 3) + 1; ++i0; }
                                j = i0 - 1 - 8 * rem; i1 = (i0 + 8 < NCH) ? i0 + 8 : NCH; own = rem == 0; }
                            else { bh = it - T_RT; j = NCH - 1; i0 = NCH; i1 = NCH; own = true; }
                            moba_item(bh, j, own, i0, i1, Z, SEL, OP, LSE, gtc, tmo, lds, tq, wave, lq); }
                    }
                }
                SEAM;
                if (RUN) { ENV; { constexpr int NCMB = M * NHM * 8; const int st_ = G * 512;
                    for (int i = bid * 512 + tid; i < NCMB; i += 3 * st_) { CombIn c0, c1, c2; const int i1 = (i + st_ < NCMB) ? i + st_ : i, i2 = (i + 2 * st_ < NCMB) ? i + 2 * st_ : i;
                        combine_load(i, OP, LSE, SEL, c0); combine_load(i1, OP, LSE, SEL, c1); combine_load(i2, OP, LSE, SEL, c2);
                        combine_store(i, c0, MIX); combine_store(i1, c1, MIX); combine_store(i2, c2, MIX); } }
                    { constexpr int NRG = M * 2 * 8; const int st_ = G * 512; for (int i = bid * 512 + tid; i < NRG; i += 2 * st_) rgate_item2(i, (i + st_ < NRG) ? i + st_ : i, Z, MIX); } }
                SEAM;
                if (RUN) { ENV; unsigned char* wb = ws + WS_W + (size_t)(l & 1) * WBUF_BYTES; pg8::Gemm g{MIX, (const bf16*)(wb + WO_OUT), M, DM, DM}; pg8::StaticOrder S; S.init(M, DM, G, bid);
                    pg8::EpiRes E{XB, SSQ, 1.0f, 1.0f, (signed char*)(ws + WS_X8), (float*)(ws + WS_RF), (float*)(ws + WS_EX), (unsigned*)(ws + WS_CTL) + CW_PC + 16 * 64 * (3 * l + 1), (unsigned*)(ws + WS_CTL) + CW_TMO, nullptr, nullptr};
                    pg8::gemm_phase<pg8::EpiRes, pg8::StaticOrder, false, true>(lds, g, S, E, tid); }
                SEAM_LOCAL;
            }
        }
    }
#undef RUN
#undef SEAM
}

extern "C" void kernel_launch(void* const* d_in, const int* in_sizes, int n_in, void* d_out, int out_size, void* d_ws, size_t ws_size, hipStream_t stream) {
    static int grid = 0;
    if (grid == 0) {
        if (n_in != 18 || in_sizes[0] != M * DM || out_size != M * DM || ws_size < WS_END) { fprintf(stderr, "kernel_launch: unexpected problem shape (n_in %d, in0 %d, out %d, ws %zu); nothing launched\n", n_in, n_in > 0 ? in_sizes[0] : -1, out_size, ws_size); grid = -1; return; }
        int dev = 0, cus = 0, per_cu = 0;
        if (hipGetDevice(&dev) != hipSuccess || hipDeviceGetAttribute(&cus, hipDeviceAttributeMultiprocessorCount, dev) != hipSuccess) { grid = -1; return; }
        if (hipFuncSetAttribute((const void*)fwd, hipFuncAttributeMaxDynamicSharedMemorySize, LDS_BYTES) != hipSuccess) { fprintf(stderr, "kernel_launch: hipFuncSetAttribute failed\n"); grid = -1; return; }
        if (hipOccupancyMaxActiveBlocksPerMultiprocessor(&per_cu, (const void*)fwd, 512, LDS_BYTES) != hipSuccess || per_cu < 1) { fprintf(stderr, "kernel_launch: occupancy query reports %d blocks per CU\n", per_cu); }
        (void)hipGetLastError();
        grid = cus;
        if (grid != 256) fprintf(stderr, "kernel_launch: %d CUs; the N = 1024 GEMM phases assume a 256-workgroup grid\n", grid);
        if (grid > 256) grid = 256;
    }
    if (grid < 0) return;
    if (hipMemsetAsync((char*)d_ws + WS_CTL, 0, CTL_BYTES, stream) != hipSuccess) return;
    Args a{};
    for (int i = 0; i < 18; ++i) a.in[i] = (const float*)d_in[i];
    a.out = (float*)d_out; a.ws = (unsigned char*)d_ws;
    for (int i = 0; i < 32; ++i) { const float t = (float)i / 31.0f; a.invf[i] = (float)pow(10000.0, -(double)t); }
    for (int i = 0; i < 8; ++i) { const float t = (float)i / 8.0f; a.invf[32 + i] = (float)pow(500000.0, -(double)t); }
#if MK_PER_PHASE
    for (int p = 0; p < N_PHASES; ++p) { a.ph_lo = p; a.ph_hi = p + 1; hipLaunchKernelGGL(fwd, dim3(grid), dim3(512), LDS_BYTES, stream, a); }
#else
    a.ph_lo = 0; a.ph_hi = N_PHASES;
    hipLaunchKernelGGL(fwd, dim3(grid), dim3(512), LDS_BYTES, stream, a);
#endif
}
```
